# Optimizing an MI355X kernel written in HIP

```python
import math
import jax, jax.numpy as jnp
from jax import lax
import numpy as np

D_MODEL = 1024
BATCH = 16
SEQ = 2048
DEPTH = 2

RET_HEADS = 4
RET_DK = 128
RET_DV = 256
RET_CHUNK = 128
ROPE_BASE = 10000.0
GN_EPS = 1e-5
DIFF_HEADS = 8
DIFF_DH = 64
DIFF_QBLOCK = 128
DIFF_EPS = 1e-5
DIL_PATTERNS = ((128, 1), (512, 4), (2048, 16))
N_DIL = len(DIL_PATTERNS)
DIL_HEADS = 4
DIL_DH = 128
DIL_BLOCK = 128
REL_BUCKETS = 32
REL_MAX_DIST = 128
N_BIAS_HEADS = DIFF_HEADS + N_DIL * DIL_HEADS
N_BRANCHES = 3
FFN_HIDDEN = -(-8 * D_MODEL // (3 * 256)) * 256
RMS_EPS = 1e-6
NEG_INF = -1e30
IN_SPLITS = ((RET_HEADS * RET_DK,) * 2 + (RET_HEADS * RET_DV,) * 2 + (DIFF_HEADS * 2 * DIFF_DH,) * 3
             + (DIL_HEADS * DIL_DH,) * (3 * N_DIL) + (N_BRANCHES * D_MODEL,))
IN_WIDTH = sum(IN_SPLITS)

kernel_name = "hybrid_retention_diffattn_dilated_block"


def rmsnorm(x, g, eps=RMS_EPS):
    xf = x.astype(jnp.float32)
    y = xf * lax.rsqrt(jnp.mean(xf * xf, axis=-1, keepdims=True) + eps)
    return (y * g.astype(jnp.float32)).astype(x.dtype)


def rel_bucket(dist):
    n = jnp.maximum(dist, 0)
    exact = REL_BUCKETS // 2
    log_ratio = jnp.log(jnp.maximum(n, exact).astype(jnp.float32) / exact) / math.log(REL_MAX_DIST / exact)
    large = jnp.minimum(exact + (log_ratio * (REL_BUCKETS - exact)).astype(jnp.int32), REL_BUCKETS - 1)
    return jnp.where(n < exact, n, large)


def rotary(x, pos):
    half = x.shape[-1] // 2
    inv = ROPE_BASE ** (-jnp.arange(half, dtype=jnp.float32) / half)
    ang = pos[:, None] * inv[None, :]
    cos, sin = jnp.cos(ang)[:, None, :], jnp.sin(ang)[:, None, :]
    x1, x2 = x[..., :half], x[..., half:]
    return jnp.concatenate([x1 * cos - x2 * sin, x1 * sin + x2 * cos], axis=-1)


def retention(q, k, v, g, gn_gain):
    b, S = q.shape[0], q.shape[1]
    H, dk, dv, c = RET_HEADS, RET_DK, RET_DV, RET_CHUNK
    n = S // c
    pos = jnp.arange(S, dtype=jnp.float32)
    q = rotary(q, pos).reshape(b, n, c, H, dk)
    k = (rotary(k, pos) * (dk ** -0.5)).reshape(b, n, c, H, dk)
    vv = v.reshape(b, n, c, H, dv)
    log_gamma = jnp.log1p(-jnp.exp2(-5.0 - jnp.arange(H, dtype=jnp.float32)))
    i = jnp.arange(c, dtype=jnp.float32)
    rel = i[:, None] - i[None, :]
    decay = jnp.where(rel >= 0, jnp.exp(log_gamma[:, None, None] * jnp.maximum(rel, 0.0)), 0.0)
    scores = jnp.einsum('bnihd,bnjhd->bnhij', q, k) * decay
    y_intra = jnp.einsum('bnhij,bnjhe->bnihe', scores, vv)
    k_to_end = jnp.exp((c - 1.0 - i)[:, None] * log_gamma[None, :])
    kv = jnp.einsum('bnjhd,bnjhe->nbhde', k * k_to_end[:, :, None], vv).astype(jnp.float32)
    chunk_decay = jnp.exp(c * log_gamma)[:, None, None]

    def step(state, kv_n):
        return state * chunk_decay + kv_n, state

    _, state_prev = lax.scan(step, jnp.zeros(kv.shape[1:], jnp.float32), kv)
    q_from_start = jnp.exp((i + 1.0)[:, None] * log_gamma[None, :])
    y_cross = jnp.einsum('bnihd,nbhde->bnihe', q * q_from_start[:, :, None], state_prev)
    y = (y_intra + y_cross).reshape(b, S, H, dv).astype(jnp.float32)
    mu = jnp.mean(y, axis=-1, keepdims=True)
    var = jnp.mean(jnp.square(y - mu), axis=-1, keepdims=True)
    y = ((y - mu) * lax.rsqrt(var + GN_EPS)).reshape(b, S, H * dv) * gn_gain.astype(jnp.float32)
    return (jax.nn.silu(g.astype(jnp.float32)) * y).astype(v.dtype)


def diff_attention(q, k, v, lam_params, lam_init, subln_gain, bias_table):
    b, S, H, _, dh = q.shape
    QB = DIFF_QBLOCK
    nb = S // QB
    lp = lam_params.astype(jnp.float32)
    lam = jnp.exp(jnp.sum(lp[0] * lp[1])) - jnp.exp(jnp.sum(lp[2] * lp[3])) + lam_init
    q_blocks = jnp.moveaxis(q.reshape(b, nb, QB, H, 2, dh), 1, 0)
    k_pos = jnp.arange(S)
    vf = v.astype(jnp.float32)

    def one_block(args):
        qblk, blk = args
        dist = (blk * QB + jnp.arange(QB))[:, None] - k_pos[None, :]
        bias = jnp.moveaxis(bias_table[rel_bucket(dist)].astype(jnp.float32), -1, 0)
        bias = jnp.where(dist >= 0, bias, NEG_INF)
        s = jnp.einsum('bqhmd,bkhmd->bhmqk', qblk, k).astype(jnp.float32) * (dh ** -0.5) + bias[:, None]
        p = jax.nn.softmax(s, axis=-1)
        a = p[:, :, 0] - lam * p[:, :, 1]
        return jnp.einsum('bhqk,bkhe->bqhe', a, vf)

    o = lax.map(one_block, (q_blocks, jnp.arange(nb)))
    o = jnp.moveaxis(o, 0, 1).reshape(b, S, H, 2 * dh)
    o = rmsnorm(o, subln_gain, DIFF_EPS) * (1.0 - lam_init)
    return o.reshape(b, S, H * 2 * dh).astype(v.dtype)


def dilated_group(q, k, v, window, dilation, bias_table):
    b, S, H, dh = q.shape
    L = DIL_BLOCK
    n_sub = S // dilation
    nb = -(-n_sub // L)
    n_pad = nb * L

    def to_sub(t):
        t = jnp.swapaxes(t.reshape(b, n_sub, dilation, H, dh), 1, 2)
        return jnp.pad(t, ((0, 0), (0, 0), (0, n_pad - n_sub), (0, 0), (0, 0)))

    def kv_band(t):
        prev = jnp.pad(t, ((0, 0), (0, 0), (L, 0), (0, 0), (0, 0)))[:, :, :n_pad]
        return jnp.concatenate([prev.reshape(b, dilation, nb, L, H, dh),
                                t.reshape(b, dilation, nb, L, H, dh)], axis=3)

    qb = to_sub(q).reshape(b, dilation, nb, L, H, dh)
    kb = kv_band(to_sub(k))
    vb = kv_band(to_sub(v)).astype(jnp.float32)
    qi = jnp.arange(L)
    kj = jnp.arange(2 * L)
    m = qi[:, None] + L - kj[None, :]
    key_sub = (jnp.arange(nb) * L)[:, None] - L + kj[None, :]
    mask = ((m >= 0) & (m <= window // dilation))[None] & (key_sub >= 0)[:, None, :]
    bias = jnp.transpose(bias_table[rel_bucket(m * dilation)], (2, 0, 1)).astype(jnp.float32)
    s = jnp.einsum('bdnqhe,bdnkhe->bdnhqk', qb, kb).astype(jnp.float32) * (dh ** -0.5) + bias
    s = jnp.where(mask[:, None], s, NEG_INF)
    mx = jnp.max(s, axis=-1, keepdims=True)
    p = jnp.exp(s - mx)
    den = jnp.sum(p, axis=-1)
    num = jnp.einsum('bdnhqk,bdnkhe->bdnqhe', p, vb)

    def from_sub(t):
        t = t.reshape((b, dilation, n_pad) + t.shape[4:])[:, :, :n_sub]
        return jnp.swapaxes(t, 1, 2).reshape((b, S) + t.shape[3:])

    return (from_sub(num), from_sub(jnp.swapaxes(mx[..., 0], 3, 4)), from_sub(jnp.swapaxes(den, 3, 4)))


def dilated_attention(parts, bias_table):
    b, S = parts[0].shape[0], parts[0].shape[1]
    nums, mxs, dens = [], [], []
    for gi, (window, dilation) in enumerate(DIL_PATTERNS):
        q, k, v = [t.reshape(b, S, DIL_HEADS, DIL_DH) for t in parts[3 * gi:3 * gi + 3]]
        num, mx, den = dilated_group(q, k, v, window, dilation,
                                     bias_table[:, gi * DIL_HEADS:(gi + 1) * DIL_HEADS])
        nums.append(num)
        mxs.append(mx)
        dens.append(den)
    num, mx, den = jnp.stack(nums), jnp.stack(mxs), jnp.stack(dens)
    wgt = jnp.exp(mx - jnp.max(mx, axis=0, keepdims=True))
    o = jnp.sum(wgt[..., None] * num, axis=0) / jnp.sum(wgt * den, axis=0)[..., None]
    return o.reshape(b, S, DIL_HEADS * DIL_DH).astype(parts[0].dtype)


def setup_inputs(seed: int = 0) -> dict:
    key = jax.random.key(seed)
    ks = jax.random.split(key, 16)

    def nrm(k, shape, scale):
        return jax.random.normal(k, shape, jnp.float32) * scale

    return {
        "x": nrm(ks[0], (BATCH, SEQ, D_MODEL), 1.0),
        "w_in": nrm(ks[1], (DEPTH, D_MODEL, IN_WIDTH), D_MODEL ** -0.5),
        "w_branch_ret": nrm(ks[2], (DEPTH, RET_HEADS * RET_DV, D_MODEL), (RET_HEADS * RET_DV) ** -0.5),
        "w_branch_diff": nrm(ks[3], (DEPTH, DIFF_HEADS * 2 * DIFF_DH, D_MODEL), (DIFF_HEADS * 2 * DIFF_DH) ** -0.5),
        "w_branch_dil": nrm(ks[4], (DEPTH, DIL_HEADS * DIL_DH, D_MODEL), (DIL_HEADS * DIL_DH) ** -0.5),
        "w_out": nrm(ks[5], (DEPTH, D_MODEL, D_MODEL), D_MODEL ** -0.5),
        "norm_mix": 1.0 + nrm(ks[6], (DEPTH, D_MODEL), 0.02),
        "norm_ffn": 1.0 + nrm(ks[7], (DEPTH, D_MODEL), 0.02),
        "ret_gn_gain": 1.0 + nrm(ks[8], (DEPTH, RET_HEADS * RET_DV), 0.02),
        "diff_lambda": nrm(ks[9], (DEPTH, 4, DIFF_DH), 0.1),
        "diff_subln_gain": 1.0 + nrm(ks[10], (DEPTH, 2 * DIFF_DH), 0.02),
        "rel_bias": nrm(ks[11], (REL_BUCKETS, N_BIAS_HEADS), 0.2),
        "w_ffn_gate": nrm(ks[12], (DEPTH, D_MODEL, FFN_HIDDEN), D_MODEL ** -0.5),
        "w_ffn_up": nrm(ks[13], (DEPTH, D_MODEL, FFN_HIDDEN), D_MODEL ** -0.5),
        "w_ffn_down": nrm(ks[14], (DEPTH, FFN_HIDDEN, D_MODEL), FFN_HIDDEN ** -0.5),
        "norm_final": 1.0 + nrm(ks[15], (D_MODEL,), 0.02),
    }


def reference(x, w_in, w_branch_ret, w_branch_diff, w_branch_dil, w_out, norm_mix, norm_ffn,
              ret_gn_gain, diff_lambda, diff_subln_gain, rel_bias, w_ffn_gate, w_ffn_up, w_ffn_down,
              norm_final):
    b, S, _ = x.shape
    cuts = np.cumsum(IN_SPLITS)[:-1].tolist()
    for l in range(DEPTH):
        h = rmsnorm(x, norm_mix[l])
        parts = jnp.split(h @ w_in[l], cuts, axis=-1)
        rq, rk, rv, rg = parts[0:4]
        dq, dkk, dvv = parts[4:7]
        dil_parts = parts[7:7 + 3 * N_DIL]
        gates = jax.nn.sigmoid(parts[-1].astype(jnp.float32)).reshape(b, S, N_BRANCHES, D_MODEL).astype(x.dtype)
        y_ret = retention(rq.reshape(b, S, RET_HEADS, RET_DK), rk.reshape(b, S, RET_HEADS, RET_DK),
                          rv, rg, ret_gn_gain[l])
        lam_init = 0.8 - 0.6 * math.exp(-0.3 * l)
        y_diff = diff_attention(dq.reshape(b, S, DIFF_HEADS, 2, DIFF_DH), dkk.reshape(b, S, DIFF_HEADS, 2, DIFF_DH),
                                dvv.reshape(b, S, DIFF_HEADS, 2 * DIFF_DH), diff_lambda[l], lam_init,
                                diff_subln_gain[l], rel_bias[:, :DIFF_HEADS])
        y_dil = dilated_attention(dil_parts, rel_bias[:, DIFF_HEADS:])
        merged = (gates[:, :, 0] * (y_ret @ w_branch_ret[l])
                  + gates[:, :, 1] * (y_diff @ w_branch_diff[l])
                  + gates[:, :, 2] * (y_dil @ w_branch_dil[l]))
        x = x + merged @ w_out[l]
        h = rmsnorm(x, norm_ffn[l])
        x = x + (jax.nn.silu(h @ w_ffn_gate[l]) * (h @ w_ffn_up[l])) @ w_ffn_down[l]
    return rmsnorm(x, norm_final)
```

```cpp
#include <hip/hip_runtime.h>
#include <cstdio>
#include <cstdint>

#ifndef MK_PER_PHASE
#define MK_PER_PHASE 0
#endif


#ifndef EN_ALL
#define EN_ALL 1
#endif
#ifndef EN_CONV
#define EN_CONV EN_ALL
#endif
#ifndef EN_IN
#define EN_IN EN_ALL
#endif
#ifndef EN_RET
#define EN_RET EN_ALL
#endif
#ifndef EN_DIFF
#define EN_DIFF EN_ALL
#endif
#ifndef EN_DIL
#define EN_DIL EN_ALL
#endif
#ifndef EN_MERGE
#define EN_MERGE EN_ALL
#endif
#ifndef EN_OUT
#define EN_OUT EN_ALL
#endif
#ifndef EN_UP
#define EN_UP EN_ALL
#endif
#ifndef EN_DOWN
#define EN_DOWN EN_ALL
#endif
#ifndef EN_FIN
#define EN_FIN EN_ALL
#endif
#define GAS __attribute__((address_space(1)))
#define LAS __attribute__((address_space(3)))
typedef unsigned short bf16;
typedef unsigned short bf16_t;
typedef short bf16x8 __attribute__((ext_vector_type(8)));
typedef float f32x4 __attribute__((ext_vector_type(4)));
typedef float f32x2 __attribute__((ext_vector_type(2)));
typedef unsigned u32x4 __attribute__((ext_vector_type(4)));
typedef unsigned u32x2 __attribute__((ext_vector_type(2)));

constexpr int BATCH = 16, SEQ = 2048, D = 1024, M = BATCH * SEQ, DEPTH = 2;
constexpr int IN_W = 13824, FFN = 2816;
constexpr int C_RET = 0, C_DIFF = 3072, C_DIL = 6144, C_GATE = 10752;
constexpr int N_RET = 3072, N_DIFF = 3072, N_DILG = 1536, N_GATE = 3072;
constexpr int YW = 2560;
constexpr int NWAVES = 8;

constexpr size_t MiB = 1u << 20;
constexpr size_t WS_CTL = 0, CTL_ZERO_BYTES = 1 * MiB;
constexpr size_t WS_CS = 1 * MiB;
constexpr size_t WS_BLUT = 2 * MiB;
constexpr size_t WS_RSS = 3 * MiB;
constexpr size_t WS_WIN = 8 * MiB;
constexpr size_t WS_WBR = 35 * MiB;
constexpr size_t WS_WOUT = 40 * MiB;
constexpr size_t WS_WGU = 42 * MiB;
constexpr size_t WS_WDN = 53 * MiB;
constexpr size_t WS_XB = 60 * MiB;
constexpr size_t WS_Y = 124 * MiB;
constexpr size_t WS_S = 284 * MiB;
constexpr size_t WS_XB2 = 300 * MiB;
constexpr size_t WS_HID = 124 * MiB;
constexpr size_t WS_DILP = WS_S + 96 * MiB;
constexpr size_t WS_DILS = WS_DILP + 64 * MiB;
constexpr size_t WS_END = 512 * MiB;

constexpr int CW_TMO = 0;
constexpr int CW_BAR = 4096;

constexpr int RING_OFF = 0, RING_BYTES = 131072;
constexpr int LDSCTL_OFF = RING_BYTES, MISC_OFF = LDSCTL_OFF + 320;
constexpr int LDS_BYTES = 147456;

typedef GAS unsigned gu32;
#define RLX_AGENT __ATOMIC_RELAXED, __HIP_MEMORY_SCOPE_AGENT
#define LDS_WAIT() asm volatile("s_waitcnt lgkmcnt(0)" ::: "memory")
#define VM_WAIT() asm volatile("s_waitcnt vmcnt(0)" ::: "memory")

__device__ __forceinline__ unsigned f2bf(float f) { unsigned u = __builtin_bit_cast(unsigned, f); return (u + 0x7fffu + ((u >> 16) & 1u)) >> 16; }
__device__ __forceinline__ unsigned pk2(float lo, float hi) { return f2bf(lo) | (f2bf(hi) << 16); }
__device__ __forceinline__ float bflo(unsigned w) { return __builtin_bit_cast(float, w << 16); }
__device__ __forceinline__ float bfhi(unsigned w) { return __builtin_bit_cast(float, w & 0xffff0000u); }
__device__ __forceinline__ float wave_sum(float v) {
#pragma unroll
    for (int o = 1; o < 64; o <<= 1) v += __shfl_xor(v, o);
    return v;
}
__device__ __forceinline__ float wave_max(float v) {
#pragma unroll
    for (int o = 1; o < 64; o <<= 1) v = fmaxf(v, __shfl_xor(v, o));
    return v;
}
__device__ __forceinline__ float rdlane(float v, int j) { return __builtin_bit_cast(float, __builtin_amdgcn_readlane(__builtin_bit_cast(int, v), j)); }
__device__ __forceinline__ float sigmoidf_(float x) { return 1.0f / (1.0f + __expf(-x)); }

__device__ const double ROPE_INV[64] = {1.0,0.8659643233600653,0.7498942093324559,0.6493816315762113,0.5623413251903491,0.4869675251658631,0.4216965034285822,0.3651741272548377,0.31622776601683794,0.27384196342643613,0.23713737056616552,0.2053525026457146,0.1778279410038923,0.1539926526059492,0.1333521432163324,0.11547819846894582,0.1,0.08659643233600653,0.07498942093324558,0.06493816315762113,0.05623413251903491,0.04869675251658631,0.042169650342858224,0.03651741272548377,0.03162277660168379,0.027384196342643614,0.023713737056616554,0.02053525026457146,0.01778279410038923,0.01539926526059492,0.01333521432163324,0.011547819846894581,0.01,0.008659643233600654,0.007498942093324558,0.006493816315762113,0.005623413251903491,0.004869675251658631,0.004216965034285823,0.003651741272548377,0.0031622776601683794,0.0027384196342643613,0.0023713737056616554,0.002053525026457146,0.0017782794100389228,0.001539926526059492,0.001333521432163324,0.0011547819846894581,0.001,0.0008659643233600654,0.0007498942093324559,0.0006493816315762113,0.0005623413251903491,0.0004869675251658631,0.00042169650342858224,0.0003651741272548377,0.00031622776601683794,0.0002738419634264361,0.00023713737056616554,0.0002053525026457146,0.00017782794100389227,0.0001539926526059492,0.0001333521432163324,0.00011547819846894582};
__device__ const unsigned char REL_BUCKET[128] = {0,1,2,3,4,5,6,7,8,9,10,11,12,13,14,15,16,16,16,17,17,18,18,18,19,19,19,20,20,20,20,21,21,21,21,22,22,22,22,22,23,23,23,23,23,23,24,24,24,24,24,24,25,25,25,25,25,25,25,26,26,26,26,26,26,26,26,27,27,27,27,27,27,27,27,27,27,28,28,28,28,28,28,28,28,28,28,29,29,29,29,29,29,29,29,29,29,29,29,30,30,30,30,30,30,30,30,30,30,30,30,30,30,31,31,31,31,31,31,31,31,31,31,31,31,31,31,31};

namespace pg8 {
#define PG8_LAS __attribute__((address_space(3)))
constexpr int BM = 256, BK = 64, HALF = 128, HTB = HALF * BK * 2, STAGE_BYTES = 8 * HTB, NXCD = 8, WGM = 8;
__host__ __device__ __forceinline__ int lds_byte(int r, int c) { const int st = (r >> 4) * 2 + (c >> 5), rr = r & 15, cc = c & 31, ob = rr * 64 + cc * 2; return st * 1024 + (ob ^ (((ob >> 9) & 1) << 5)); }
__host__ __device__ __forceinline__ void stage_rc(int b, int& R, int& C) { const int st = b / 1024, sb = b % 1024, swz = sb ^ (((sb >> 9) & 1) << 5); R = (st >> 1) * 16 + swz / 64; C = (st & 1) * 32 + (swz % 64) / 2; }
__host__ __device__ __forceinline__ int perm32(int rho) { const int n = rho >> 4, i = rho & 15; return 8 * (i >> 2) + 4 * n + (i & 3); }

struct Unit { int pm, pn, seg; };
struct Gemm { const bf16_t* A; const bf16_t* Bt; int lda, ldb, M, N, K; };

struct StaticOrder {
    int nM, nN, nwg, G, c;
    __device__ void init(int M_, int N_, int G_, int c_) { nM = M_ / BM; nN = N_ / BM; nwg = nM * nN; G = G_; c = c_; }
    __device__ __forceinline__ bool tile(int i, Unit& u) const {
        const long L = (long)i * G + c; if (L >= nwg) return false;
        int wgid = (int)L; { const int q = nwg / NXCD, r = nwg % NXCD, xcd = wgid % NXCD, off = wgid / NXCD; wgid = (xcd < r ? xcd * (q + 1) : r * (q + 1) + (xcd - r) * q) + off; }
        const int nig = WGM * nN, gid = wgid / nig, fm = gid * WGM, gsz = (nM - fm) < WGM ? (nM - fm) : WGM;
        u.pm = fm + ((wgid % nig) % gsz); u.pn = (wgid % nig) / gsz; return true;
    }
    __device__ __forceinline__ bool next(int i, Unit& u) const { u.seg = 0; return tile(i, u); }
    __device__ __forceinline__ const char* abase(const Gemm& g, const Unit& u) const { return (const char*)g.A + (size_t)u.pm * BM * g.lda * 2; }
    __device__ __forceinline__ const char* bbase(const Gemm& g, const Unit& u) const { return (const char*)g.Bt + (size_t)u.pn * BM * g.ldb * 2; }
    __device__ __forceinline__ int nt(const Gemm& g, const Unit&) const { return g.K / BK; }
};
struct SegOrder : StaticOrder {
    __device__ __forceinline__ bool next(int i, Unit& u) const { u.seg = i % 3; return tile(i / 3, u); }
    __device__ __forceinline__ const char* abase(const Gemm& g, const Unit& u) const { return (const char*)g.A + (size_t)u.pm * BM * g.lda * 2 + (size_t)u.seg * 2048; }
    __device__ __forceinline__ const char* bbase(const Gemm& g, const Unit& u) const { return (const char*)g.Bt + (size_t)u.pn * BM * g.ldb * 2 + (size_t)u.seg * 2048; }
    __device__ __forceinline__ int nt(const Gemm&, const Unit& u) const { return u.seg < 2 ? 16 : 8; }
};

__device__ __forceinline__ unsigned cvt_pk_bf16(float lo, float hi) { unsigned r; asm volatile("v_cvt_pk_bf16_f32 %0, %1, %2" : "=v"(r) : "v"(lo), "v"(hi)); return r; }

__device__ __forceinline__ float row_rstd(const float* rss, int row) {
    const f32x4* rp = (const f32x4*)(rss + (size_t)row * 16);
    const f32x4 a = rp[0], b = rp[1], c = rp[2], d = rp[3];
    const float ss = (((a[0] + a[1]) + (a[2] + a[3])) + ((b[0] + b[1]) + (b[2] + b[3]))) + (((c[0] + c[1]) + (c[2] + c[3])) + ((d[0] + d[1]) + (d[2] + d[3])));
    return 1.0f / sqrtf(ss * (1.0f / 1024.0f) + 1e-6f);
}

struct EpiIn {
    static constexpr bool PERM = true, AFTER_DRAIN = false;
    bf16_t* O; int ldc; const float* rss; const float* cs; int mode;
    __device__ __forceinline__ void operator()(const f32x4 (&acc)[2][2][4][2], const Unit& u, int wr, int wc, int fr, int fq) const {
        const int row0 = u.pm * BM + wr * 64 + fr, col0 = u.pn * BM + wc * 32 + 8 * fq;
        const bool rot = (mode == 1) && (u.pn < 4);
        const float ksc = (u.pn >= 2) ? 0.08838834764831845f : 1.0f;
#pragma unroll
        for (int ai = 0; ai < 2; ++ai)
#pragma unroll
            for (int m = 0; m < 4; ++m) {
                const int row = row0 + ai * HALF + m * 16;
                const float rs = row_rstd(rss, row);
                bf16_t* rowp = O + (size_t)row * ldc + col0;
                f32x4 c01 = (f32x4){1.f, 0.f, 1.f, 0.f}, c23 = c01;
                if (rot) { const f32x4* cp = (const f32x4*)(cs + ((size_t)(row & (SEQ - 1)) * 64 + 16 * wc + 4 * fq) * 2); c01 = cp[0]; c23 = cp[1]; }
#pragma unroll
                for (int bj = 0; bj < 2; ++bj) {
                    f32x4 v0 = acc[ai][bj][m][0] * rs, v1 = acc[ai][bj][m][1] * rs;
                    if (rot) {
                        f32x4 w0, w1;
                        w0[0] = v0[0] * c01[0] - v0[1] * c01[1]; w0[1] = v0[0] * c01[1] + v0[1] * c01[0];
                        w0[2] = v0[2] * c01[2] - v0[3] * c01[3]; w0[3] = v0[2] * c01[3] + v0[3] * c01[2];
                        w1[0] = v1[0] * c23[0] - v1[1] * c23[1]; w1[1] = v1[0] * c23[1] + v1[1] * c23[0];
                        w1[2] = v1[2] * c23[2] - v1[3] * c23[3]; w1[3] = v1[2] * c23[3] + v1[3] * c23[2];
                        v0 = w0 * ksc; v1 = w1 * ksc;
                    } else if (mode == 2) {
#pragma unroll
                        for (int j = 0; j < 4; ++j) { v0[j] = sigmoidf_(v0[j]); v1[j] = sigmoidf_(v1[j]); }
                    }
                    u32x4 w; w.x = cvt_pk_bf16(v0[0], v0[1]); w.y = cvt_pk_bf16(v0[2], v0[3]); w.z = cvt_pk_bf16(v1[0], v1[1]); w.w = cvt_pk_bf16(v1[2], v1[3]);
                    *(u32x4*)(rowp + bj * HALF) = w;
                }
            }
    }
};
struct EpiMerge {
    static constexpr bool PERM = true, AFTER_DRAIN = false;
    bf16_t* O; const bf16_t* Gt;
    __device__ __forceinline__ void operator()(const f32x4 (&acc)[2][2][4][2], const Unit& u, int wr, int wc, int fr, int fq) const {
        const int row0 = u.pm * BM + wr * 64 + fr, col0 = u.pn * BM + wc * 32 + 8 * fq;
#pragma unroll
        for (int ai = 0; ai < 2; ++ai)
#pragma unroll
            for (int m = 0; m < 4; ++m) {
                const int row = row0 + ai * HALF + m * 16;
#pragma unroll
                for (int bj = 0; bj < 2; ++bj) {
                    const int col = col0 + bj * HALF;
                    const u32x4 g = *(const u32x4*)(Gt + (size_t)row * N_GATE + u.seg * 1024 + col);
                    f32x4 v0 = acc[ai][bj][m][0], v1 = acc[ai][bj][m][1];
                    v0[0] *= bflo(g.x); v0[1] *= bfhi(g.x); v0[2] *= bflo(g.y); v0[3] *= bfhi(g.y);
                    v1[0] *= bflo(g.z); v1[1] *= bfhi(g.z); v1[2] *= bflo(g.w); v1[3] *= bfhi(g.w);
                    bf16_t* op = O + (size_t)row * D + col;
                    if (u.seg > 0) {
                        const u32x4 p = *(const u32x4*)op;
                        v0[0] += bflo(p.x); v0[1] += bfhi(p.x); v0[2] += bflo(p.y); v0[3] += bfhi(p.y);
                        v1[0] += bflo(p.z); v1[1] += bfhi(p.z); v1[2] += bflo(p.w); v1[3] += bfhi(p.w);
                    }
                    u32x4 w; w.x = cvt_pk_bf16(v0[0], v0[1]); w.y = cvt_pk_bf16(v0[2], v0[3]); w.z = cvt_pk_bf16(v1[0], v1[1]); w.w = cvt_pk_bf16(v1[2], v1[3]);
                    *(u32x4*)op = w;
                }
            }
    }
};
struct EpiRes {
    static constexpr bool PERM = false, AFTER_DRAIN = false;
    const float* res; float* xo; bf16_t* xb; float* rss;
    __device__ __forceinline__ void operator()(const f32x4 (&acc)[2][2][4][2], const Unit& u, int wr, int wc, int fr, int fq) const {
        const int row0 = u.pm * BM + wr * 64 + fr, col0 = u.pn * BM + wc * 32 + 4 * fq;
#pragma unroll
        for (int ai = 0; ai < 2; ++ai)
#pragma unroll
            for (int m = 0; m < 4; ++m) {
                const int row = row0 + ai * HALF + m * 16; float ss = 0.f;
#pragma unroll
                for (int bj = 0; bj < 2; ++bj)
#pragma unroll
                    for (int n = 0; n < 2; ++n) {
                        const size_t off = (size_t)row * D + col0 + bj * HALF + n * 16;
                        const f32x4 v = acc[ai][bj][m][n] + *(const f32x4*)(res + off);
                        *(f32x4*)(xo + off) = v;
                        ss += (v[0] * v[0] + v[1] * v[1]) + (v[2] * v[2] + v[3] * v[3]);
                        u32x2 w; w.x = cvt_pk_bf16(v[0], v[1]); w.y = cvt_pk_bf16(v[2], v[3]);
                        *(u32x2*)(xb + off) = w;
                    }
                ss += __shfl_xor(ss, 16); ss += __shfl_xor(ss, 32);
                if (fq == 0) rss[(size_t)row * 16 + u.pn * 4 + wc] = ss;
            }
    }
};
struct EpiSwiGLU {
    static constexpr bool PERM = true, AFTER_DRAIN = false;
    bf16_t* H; const float* rss;
    __device__ __forceinline__ void operator()(const f32x4 (&acc)[2][2][4][2], const Unit& u, int wr, int wc, int fr, int fq) const {
        const int row0 = u.pm * BM + wr * 64 + fr, col0 = u.pn * HALF + wc * 32 + 8 * fq;
#pragma unroll
        for (int ai = 0; ai < 2; ++ai)
#pragma unroll
            for (int m = 0; m < 4; ++m) {
                const int row = row0 + ai * HALF + m * 16;
                const float rs = row_rstd(rss, row);
                f32x4 h0, h1;
#pragma unroll
                for (int j = 0; j < 4; ++j) {
                    const float g0 = acc[ai][0][m][0][j] * rs, g1 = acc[ai][0][m][1][j] * rs;
                    h0[j] = g0 * sigmoidf_(g0) * (acc[ai][1][m][0][j] * rs);
                    h1[j] = g1 * sigmoidf_(g1) * (acc[ai][1][m][1][j] * rs);
                }
                u32x4 w; w.x = cvt_pk_bf16(h0[0], h0[1]); w.y = cvt_pk_bf16(h0[2], h0[3]); w.z = cvt_pk_bf16(h1[0], h1[1]); w.w = cvt_pk_bf16(h1[2], h1[3]);
                *(u32x4*)(H + (size_t)row * FFN + col0) = w;
            }
    }
};

template <class Epi, class Sched, bool ALIGN_EPI>
__device__ __forceinline__ void gemm_phase(PG8_LAS unsigned char* lds, const Gemm g, const Sched& S, const Epi& E) {
    int tid_ = threadIdx.x; asm volatile("" : "+v"(tid_));
    const int tid = tid_, wid = __builtin_amdgcn_readfirstlane(tid >> 6), lane = tid & 63, wr = wid >> 2, wc = wid & 3, fr = lane & 15, fq = lane >> 4;
    unsigned voffA[2], voffB[2];
#pragma unroll
    for (int i = 0; i < 2; ++i) { int R, C; stage_rc(tid * 16 + i * 8192, R, C); const int Rb = Epi::PERM ? ((R & ~31) + perm32(R & 31)) : R;
        voffA[i] = (unsigned)(R * g.lda + C) * 2u; voffB[i] = (unsigned)(Rb * g.ldb + C) * 2u; }
    const size_t kstep = (size_t)(BK * 2);
    const size_t hstepA = (size_t)HALF * g.lda * 2, hstepB = (size_t)HALF * g.ldb * 2;
    const unsigned ldsw = (unsigned)wid * 1024u;
    const int aoff = lds_byte(wr * 64 + fr, fq * 8), boff = lds_byte(wc * 32 + fr, fq * 8);
#define PG8_SA(b, h) (((b) * 2 + (h)) * HTB)
#define PG8_SB(b, h) ((4 + (b) * 2 + (h)) * HTB)
#define PG8_STAGE(bufoff, gbase, voff) do { _Pragma("unroll") for (int _i = 0; _i < 2; ++_i) \
        __builtin_amdgcn_global_load_lds((const unsigned*)((const char*)(gbase) + (voff)[_i]), (PG8_LAS unsigned*)(lds + (bufoff) + ldsw + _i * 8192), 16, 0, 0); } while (0)
#define PG8_LDA(dst, b, h) do { _Pragma("unroll") for (int m = 0; m < 4; ++m) _Pragma("unroll") for (int k = 0; k < 2; ++k) dst[m][k] = *(const PG8_LAS bf16x8*)(lds + PG8_SA(b, h) + aoff + m * 2048 + k * 1024); } while (0)
#define PG8_LDB(dst, b, h) do { _Pragma("unroll") for (int n = 0; n < 2; ++n) _Pragma("unroll") for (int k = 0; k < 2; ++k) dst[n][k] = *(const PG8_LAS bf16x8*)(lds + PG8_SB(b, h) + boff + n * 2048 + k * 1024); } while (0)
#define PG8_MMA(ai, bj, At, Bt) do { __builtin_amdgcn_s_setprio(1); _Pragma("unroll") for (int m = 0; m < 4; ++m) _Pragma("unroll") for (int n = 0; n < 2; ++n) _Pragma("unroll") for (int k = 0; k < 2; ++k) \
        acc[ai][bj][m][n] = __builtin_amdgcn_mfma_f32_16x16x32_bf16(Bt[n][k], At[m][k], acc[ai][bj][m][n], 0, 0, 0); __builtin_amdgcn_s_setprio(0); } while (0)
#define PG8_WAIT_V(n) asm volatile("s_waitcnt vmcnt(" #n ")" ::: "memory")
#define PG8_WAIT_L(n) asm volatile("s_waitcnt lgkmcnt(" #n ")" ::: "memory")
#define PG8_BAR __builtin_amdgcn_s_barrier()
#define PG8_SCHED __builtin_amdgcn_sched_barrier(0)
    Unit cur, nxt; int ui = 0;
    if (!S.next(0, cur)) return;
    f32x4 acc[2][2][4][2];
#pragma unroll
    for (int a = 0; a < 2; ++a)
#pragma unroll
        for (int b = 0; b < 2; ++b)
#pragma unroll
            for (int m = 0; m < 4; ++m)
#pragma unroll
                for (int n = 0; n < 2; ++n) acc[a][b][m][n] = (f32x4){0.f, 0.f, 0.f, 0.f};
    bf16x8 At[4][2], B0[2][2], B1[2][2];
    const char* cA = S.abase(g, cur); const char* cB = S.bbase(g, cur);
    PG8_STAGE(PG8_SB(0, 0), cB, voffB); PG8_STAGE(PG8_SB(0, 1), cB + hstepB, voffB); PG8_STAGE(PG8_SA(0, 0), cA, voffA); PG8_STAGE(PG8_SA(0, 1), cA + hstepA, voffA);
    if (wr == 1) PG8_BAR;
    PG8_WAIT_V(2); PG8_BAR;
    PG8_STAGE(PG8_SB(1, 0), cB + kstep, voffB); PG8_STAGE(PG8_SA(1, 0), cA + kstep, voffA); PG8_STAGE(PG8_SB(1, 1), cB + hstepB + kstep, voffB);
    PG8_WAIT_V(6); PG8_BAR;
    for (;;) {
        const bool has_next = S.next(ui + 1, nxt);
        const int nt = S.nt(g, cur);
        const char* nA = has_next ? S.abase(g, nxt) : cA; const char* nB = has_next ? S.bbase(g, nxt) : cB;
        for (int t = 0; t < nt; t += 2) {
            const bool last = (t == nt - 2);
            const char* a1 = cA + (size_t)(t + 1) * kstep;
            const char* a2 = last ? nA : cA + (size_t)(t + 2) * kstep; const char* b2 = last ? nB : cB + (size_t)(t + 2) * kstep;
            const char* a3 = a2 + kstep; const char* b3 = b2 + kstep;
            PG8_LDB(B0, 0, 0); PG8_LDB(B1, 0, 1); PG8_SCHED; PG8_LDA(At, 0, 0); PG8_STAGE(PG8_SA(1, 1), a1 + hstepA, voffA);
            PG8_WAIT_V(8); PG8_WAIT_L(0); PG8_BAR; PG8_MMA(0, 0, At, B0); PG8_MMA(0, 1, At, B1); PG8_BAR; PG8_SCHED;
            PG8_LDA(At, 0, 1); PG8_STAGE(PG8_SB(0, 0), b2, voffB); PG8_STAGE(PG8_SB(0, 1), b2 + hstepB, voffB); PG8_STAGE(PG8_SA(0, 0), a2, voffA);
            PG8_WAIT_V(8); PG8_WAIT_L(0); PG8_BAR; PG8_MMA(1, 0, At, B0); PG8_MMA(1, 1, At, B1); PG8_BAR; PG8_SCHED;
            PG8_LDB(B0, 1, 0); PG8_LDB(B1, 1, 1); PG8_SCHED; PG8_LDA(At, 1, 0); PG8_STAGE(PG8_SA(0, 1), a2 + hstepA, voffA);
            PG8_WAIT_V(8); PG8_WAIT_L(0); PG8_BAR; PG8_MMA(0, 0, At, B0); PG8_MMA(0, 1, At, B1); PG8_BAR; PG8_SCHED;
            PG8_LDA(At, 1, 1); PG8_STAGE(PG8_SB(1, 0), b3, voffB); PG8_STAGE(PG8_SB(1, 1), b3 + hstepB, voffB); PG8_STAGE(PG8_SA(1, 0), a3, voffA);
            PG8_WAIT_V(8); PG8_WAIT_L(0); PG8_BAR; PG8_MMA(1, 0, At, B0); PG8_MMA(1, 1, At, B1); PG8_BAR; PG8_SCHED;
        }
        if constexpr (ALIGN_EPI) { if (wr == 0) PG8_BAR; }
        E(acc, cur, wr, wc, fr, fq);
        if (!has_next) break;
#pragma unroll
        for (int a = 0; a < 2; ++a)
#pragma unroll
            for (int b = 0; b < 2; ++b)
#pragma unroll
                for (int m = 0; m < 4; ++m)
#pragma unroll
                    for (int n = 0; n < 2; ++n) acc[a][b][m][n] = (f32x4){0.f, 0.f, 0.f, 0.f};
        cur = nxt; cA = nA; cB = nB; ++ui;
        if constexpr (ALIGN_EPI) { if (wr == 1) PG8_BAR; }
    }
    PG8_WAIT_V(0);
    if constexpr (!ALIGN_EPI) { if (wr == 0) PG8_BAR; }
    PG8_BAR;
#undef PG8_SA
#undef PG8_SB
#undef PG8_STAGE
#undef PG8_LDA
#undef PG8_LDB
#undef PG8_MMA
#undef PG8_WAIT_V
#undef PG8_WAIT_L
#undef PG8_BAR
#undef PG8_SCHED
}
}

#define XB_TMO      128
#define XB_XCNT(j)  (256  + 64 * (j))
#define XB_XSUB(j)  (1280 + 64 * (j))
#define XB_XGEN(j)  (2304 + 64 * (j))
#define XB_TOP      3328
#define XB_TOPGEN   3392
#define XCD_BAR_WORDS 3456
#define XB_SPIN_CAP (1u << 18)

__device__ __forceinline__ unsigned xb_ld(unsigned* p)              { return __hip_atomic_load(p, __ATOMIC_RELAXED, __HIP_MEMORY_SCOPE_AGENT); }
__device__ __forceinline__ unsigned xb_add(unsigned* p, unsigned v) { return __hip_atomic_fetch_add(p, v, __ATOMIC_RELAXED, __HIP_MEMORY_SCOPE_AGENT); }
__device__ __forceinline__ unsigned xb_xcc_id() { return (unsigned)__builtin_amdgcn_s_getreg((3 << 11) | 20) & 0xFu; }
#define XB_SPIN(cond, bar) do { unsigned _sp = 0; while (cond) { __builtin_amdgcn_s_sleep(1); \
    if ((++_sp & 255u) == 0u) { if (xb_ld(&(bar)[XB_TMO])) break; if (_sp > XB_SPIN_CAP) { atomicAdd(&(bar)[XB_TMO], 1u); break; } } } } while (0)

struct XcdBarrier { unsigned* bar; unsigned x; volatile LAS unsigned* st; };

__device__ __forceinline__ XcdBarrier xcd_barrier_post(unsigned* bar, volatile LAS unsigned* st) {
    XcdBarrier b; b.bar = bar; b.x = xb_xcc_id(); b.st = st;
    if (threadIdx.x == 0) (void)xb_add(&bar[XB_XCNT(b.x)], 1u);
    return b;
}
__device__ __forceinline__ void xcd_barrier_complete(unsigned* bar, unsigned x, unsigned& nloc, unsigned& nx) {
    const unsigned G = gridDim.x * gridDim.y * gridDim.z;
    unsigned sum, cnt, mine, sp = 0u;
    for (;;) {
        sum = 0u; cnt = 0u; mine = 0u;
#pragma unroll
        for (unsigned j = 0; j < 16; ++j) { const unsigned c = xb_ld(&bar[XB_XCNT(j)]); sum += c; cnt += (c > 0u) ? 1u : 0u; mine = (j == x) ? c : mine; }
        if (sum == G) break;
        __builtin_amdgcn_s_sleep(1);
        if ((++sp & 255u) == 0u) { if (xb_ld(&bar[XB_TMO])) break; if (sp > XB_SPIN_CAP) { atomicAdd(&bar[XB_TMO], 1u); break; } }
    }
    nloc = mine > 0u ? mine : 1u; nx = cnt > 0u ? cnt : 1u;
}
__device__ __forceinline__ void xcd_barrier(const XcdBarrier& b) {
    asm volatile("s_waitcnt vmcnt(0)" ::: "memory");
    __syncthreads();
    if (threadIdx.x == 0) {
        unsigned* bar = b.bar;
        __builtin_amdgcn_s_waitcnt(0);
        unsigned nloc = b.st[0], nx = b.st[1];
        if (nloc == 0u) { xcd_barrier_complete(bar, b.x, nloc, nx); b.st[0] = nloc; b.st[1] = nx; }
        const unsigned old = xb_add(&bar[XB_XSUB(b.x)], 1u);
        const unsigned gen = old / nloc;
        if (old + 1u == (gen + 1u) * nloc) {
            __builtin_amdgcn_fence(__ATOMIC_RELEASE, "agent");
            asm volatile("s_waitcnt vmcnt(0)" ::: "memory");
            const unsigned og = xb_add(&bar[XB_TOP], 1u);
            const unsigned tg = og / nx;
            if (og + 1u == (tg + 1u) * nx) xb_add(&bar[XB_TOPGEN], 1u);
            else XB_SPIN(xb_ld(&bar[XB_TOPGEN]) == tg, bar);
            __builtin_amdgcn_fence(__ATOMIC_ACQUIRE, "agent");
            xb_add(&bar[XB_XGEN(b.x)], 1u);
            asm volatile("s_waitcnt vmcnt(0)" ::: "memory");
        } else {
            XB_SPIN(xb_ld(&bar[XB_XGEN(b.x)]) == gen, bar);
            __builtin_amdgcn_fence(__ATOMIC_ACQUIRE, "agent");
            asm volatile("s_waitcnt vmcnt(0)" ::: "memory");
        }
    }
    __syncthreads();
}

struct Frame {
    LAS unsigned char* lds;
    volatile LAS unsigned* MISC;
    gu32* ctl;
    int wave;
    int vcu, G;
};

__device__ __forceinline__ int dst_row(int map, int n) {
    if (map == 1) { if (n < 1024) { const int d = n & 127; return (n & ~127) + 2 * (d & 63) + (d >> 6); } return n; }
    if (map == 2) return (n >> 7) * 256 + (n & 127);
    if (map == 3) return (n >> 7) * 256 + 128 + (n & 127);
    return n;
}
__device__ __forceinline__ void tr_item(const float* W, int N, bf16* WT, int ldw, int koff, int map, const float* gain, LAS float* scr, int item, int lane) {
    const int nblk = N / 32, kb = item / nblk, nb = item % nblk, k0 = 64 * kb, n0 = 32 * nb;
#pragma unroll 8
    for (int i = 0; i < 32; ++i) { const int kk = 2 * i + (lane >> 5); float v = W[(size_t)(k0 + kk) * N + n0 + (lane & 31)]; if (gain) v *= gain[k0 + kk]; scr[kk * 33 + (lane & 31)] = v; }
    LDS_WAIT(); asm volatile("" ::: "memory");
    const int c = lane & 7;
#pragma unroll
    for (int j = 0; j < 4; ++j) { const int n = (lane >> 3) + 8 * j; const LAS float* s = scr + (8 * c) * 33 + n;
        u32x4 o; o.x = pk2(s[0 * 33], s[1 * 33]); o.y = pk2(s[2 * 33], s[3 * 33]); o.z = pk2(s[4 * 33], s[5 * 33]); o.w = pk2(s[6 * 33], s[7 * 33]);
        *(u32x4*)(WT + (size_t)dst_row(map, n0 + n) * ldw + koff + k0 + 8 * c) = o; }
    LDS_WAIT(); asm volatile("" ::: "memory");
}

struct Args {
    const float* x; const float* w_in; const float* w_br_ret; const float* w_br_diff; const float* w_br_dil; const float* w_out;
    const float* norm_mix; const float* norm_ffn; const float* gn_gain; const float* diff_lambda; const float* subln; const float* rel_bias;
    const float* w_gate; const float* w_up; const float* w_down; const float* norm_final;
    float* out; unsigned char* ws; int ph_lo, ph_hi;
};

__device__ __forceinline__ void phase_convert(Frame& F, const Args& a, int l) {
    int tid = threadIdx.x; asm volatile("" : "+v"(tid));
    const int lane = tid & 63;
    LAS float* scr = (LAS float*)(F.lds + RING_OFF + F.wave * 16384);
    const int gw = F.vcu * NWAVES + F.wave, NGW = F.G * NWAVES;
    unsigned char* ws = a.ws;
    constexpr int I_IN = 16 * (IN_W / 32), I_BR = 16 * 32, I_BL = 8 * 32, I_O = 16 * 32, I_G = 16 * (FFN / 32), I_D = (FFN / 64) * 32;
    constexpr int NITEMS = I_IN + 2 * I_BR + I_BL + I_O + 2 * I_G + I_D;
    for (int it = gw; it < NITEMS; it += NGW) {
        int r = it; const float* W; int N; bf16* WT; int ldw, koff = 0, map = 0; const float* gain = nullptr;
        if (r < I_IN) { W = a.w_in + (size_t)l * D * IN_W; N = IN_W; WT = (bf16*)(ws + WS_WIN); ldw = D; map = 1; gain = a.norm_mix + l * D; }
        else if ((r -= I_IN) < I_BR) { W = a.w_br_ret + (size_t)l * 1024 * D; N = D; WT = (bf16*)(ws + WS_WBR); ldw = YW; }
        else if ((r -= I_BR) < I_BR) { W = a.w_br_diff + (size_t)l * 1024 * D; N = D; WT = (bf16*)(ws + WS_WBR); ldw = YW; koff = 1024; }
        else if ((r -= I_BR) < I_BL) { W = a.w_br_dil + (size_t)l * 512 * D; N = D; WT = (bf16*)(ws + WS_WBR); ldw = YW; koff = 2048; }
        else if ((r -= I_BL) < I_O) { W = a.w_out + (size_t)l * D * D; N = D; WT = (bf16*)(ws + WS_WOUT); ldw = D; }
        else if ((r -= I_O) < I_G) { W = a.w_gate + (size_t)l * D * FFN; N = FFN; WT = (bf16*)(ws + WS_WGU); ldw = D; map = 2; gain = a.norm_ffn + l * D; }
        else if ((r -= I_G) < I_G) { W = a.w_up + (size_t)l * D * FFN; N = FFN; WT = (bf16*)(ws + WS_WGU); ldw = D; map = 3; gain = a.norm_ffn + l * D; }
        else { r -= I_G; W = a.w_down + (size_t)l * FFN * D; N = D; WT = (bf16*)(ws + WS_WDN); ldw = FFN; }
        tr_item(W, N, WT, ldw, koff, map, gain, scr, r, lane);
    }
    if (l == 0) {
        bf16* XB = (bf16*)(ws + WS_XB); float* rss = (float*)(ws + WS_RSS);
        for (int m = gw; m < M; m += NGW) {
            const f32x4* xr = (const f32x4*)(a.x + (size_t)m * D) + lane;
            u32x2* o8 = (u32x2*)(XB + (size_t)m * D) + lane;
            float s = 0.f;
#pragma unroll
            for (int j = 0; j < 4; ++j) { const f32x4 v = xr[64 * j]; s += (v[0] * v[0] + v[1] * v[1]) + (v[2] * v[2] + v[3] * v[3]); u32x2 w; w.x = pk2(v[0], v[1]); w.y = pk2(v[2], v[3]); o8[64 * j] = w; }
            s = wave_sum(s);
            if (lane < 16) rss[(size_t)m * 16 + lane] = (lane == 0) ? s : 0.f;
        }
        float* cs = (float*)(ws + WS_CS);
        const int gt = F.vcu * NWAVES * 64 + tid, NT = F.G * NWAVES * 64;
        for (int idx = gt; idx < SEQ * 64; idx += NT) {
            const int pos = idx >> 6, i = idx & 63;
            const double t = (double)pos * ROPE_INV[i] * 0.15915494309189535;
            const double fr = t - floor(t);
            const float f = (float)fr;
            cs[2 * idx] = __builtin_amdgcn_cosf(f); cs[2 * idx + 1] = __builtin_amdgcn_sinf(f);
        }
        float* blut = (float*)(ws + WS_BLUT);
        for (int idx = gt; idx < 20 * 128; idx += NT) { const int h = idx >> 7, dist = idx & 127; blut[idx] = a.rel_bias[REL_BUCKET[dist] * 20 + h]; }
    }
}

__device__ __forceinline__ float dot8(const u32x4 a, const u32x4 b, float acc) {
    acc += bflo(a.x) * bflo(b.x); acc += bfhi(a.x) * bfhi(b.x); acc += bflo(a.y) * bflo(b.y); acc += bfhi(a.y) * bfhi(b.y);
    acc += bflo(a.z) * bflo(b.z); acc += bfhi(a.z) * bfhi(b.z); acc += bflo(a.w) * bflo(b.w); acc += bfhi(a.w) * bfhi(b.w);
    return acc;
}

__device__ __forceinline__ void naive_ret(Frame& F, const bf16* R, const float* gn_gain, bf16* Y) {
    LAS unsigned* qs = (LAS unsigned*)(F.lds + RING_OFF + F.wave * 1024);
    int lane_ = threadIdx.x & 63; asm volatile("" : "+v"(lane_));
    const int gw = F.vcu * NWAVES + F.wave, NGW = F.G * NWAVES, lane = lane_;
    for (int it = gw; it < M * 4; it += NGW) {
        const int bh = it & 63, t = it >> 6, b = bh >> 2, h = bh & 3;
        const size_t row = (size_t)b * SEQ + t;
        LDS_WAIT();
        qs[lane] = *(const unsigned*)(R + row * N_RET + h * 128 + 2 * lane);
        LDS_WAIT(); asm volatile("" ::: "memory");
        const float l2g = log2f(1.0f - exp2f(-5.0f - (float)h));
        float y0 = 0.f, y1 = 0.f, y2 = 0.f, y3 = 0.f;
        for (int s0 = 0; s0 <= t; s0 += 64) {
            const int s = s0 + lane; const bool valid = s <= t; const int sc = valid ? s : t;
            const u32x4* kr = (const u32x4*)(R + ((size_t)b * SEQ + sc) * N_RET + 512 + h * 128);
            float dot = 0.f;
#pragma unroll
            for (int d8 = 0; d8 < 16; ++d8) { const u32x4 q8 = *(const LAS u32x4*)(qs + d8 * 4); dot = dot8(q8, kr[d8], dot); }
            const float w = valid ? dot * exp2f((float)(t - s) * l2g) : 0.f;
            const int ns = (t - s0 + 1) < 64 ? (t - s0 + 1) : 64;
            const bf16* vb = R + ((size_t)b * SEQ + s0) * N_RET + 1024 + h * 256 + 4 * lane;
            for (int j = 0; j < ns; ++j) {
                const float wj = rdlane(w, j);
                const u32x2 v = *(const u32x2*)(vb + (size_t)j * N_RET);
                y0 += wj * bflo(v.x); y1 += wj * bfhi(v.x); y2 += wj * bflo(v.y); y3 += wj * bfhi(v.y);
            }
        }
        const float mean = wave_sum((y0 + y1) + (y2 + y3)) * (1.0f / 256.0f);
        const float d0 = y0 - mean, d1 = y1 - mean, d2 = y2 - mean, d3 = y3 - mean;
        const float var = wave_sum((d0 * d0 + d1 * d1) + (d2 * d2 + d3 * d3)) * (1.0f / 256.0f);
        const float rstd = 1.0f / sqrtf(var + 1e-5f);
        const f32x4 gg = *(const f32x4*)(gn_gain + h * 256 + 4 * lane);
        const u32x2 gv = *(const u32x2*)(R + row * N_RET + 2048 + h * 256 + 4 * lane);
        const float g0 = bflo(gv.x), g1 = bfhi(gv.x), g2 = bflo(gv.y), g3 = bfhi(gv.y);
        const float o0 = d0 * rstd * gg[0] * (g0 * sigmoidf_(g0)), o1 = d1 * rstd * gg[1] * (g1 * sigmoidf_(g1));
        const float o2 = d2 * rstd * gg[2] * (g2 * sigmoidf_(g2)), o3 = d3 * rstd * gg[3] * (g3 * sigmoidf_(g3));
        u32x2 w; w.x = pk2(o0, o1); w.y = pk2(o2, o3);
        *(u32x2*)(Y + row * YW + h * 256 + 4 * lane) = w;
    }
}

__device__ __forceinline__ void naive_diff(Frame& F, const bf16* Sd, const float* lamp, float lam_init, const float* subln, const float* blut, bf16* Y) {
    LAS unsigned* qs = (LAS unsigned*)(F.lds + RING_OFF + F.wave * 1024);
    int lane_ = threadIdx.x & 63; asm volatile("" : "+v"(lane_));
    const int gw = F.vcu * NWAVES + F.wave, NGW = F.G * NWAVES, lane = lane_;
    const float lam = __expf(wave_sum(lamp[lane] * lamp[64 + lane])) - __expf(wave_sum(lamp[128 + lane] * lamp[192 + lane])) + lam_init;
    for (int it = gw; it < M * 8; it += NGW) {
        const int bh = it & 127, t = it >> 7, b = bh >> 3, h = bh & 7;
        const size_t row = (size_t)b * SEQ + t;
        LDS_WAIT();
        qs[lane] = *(const unsigned*)(Sd + row * N_DIFF + h * 128 + 2 * lane);
        LDS_WAIT(); asm volatile("" ::: "memory");
        float om0[2], om1[2];
#pragma unroll
        for (int mm = 0; mm < 2; ++mm) {
            float mrun = -3.0e38f, l = 0.f, o0 = 0.f, o1 = 0.f;
            for (int s0 = 0; s0 <= t; s0 += 64) {
                const int s = s0 + lane; const bool valid = s <= t; const int sc = valid ? s : t;
                const u32x4* kr = (const u32x4*)(Sd + ((size_t)b * SEQ + sc) * N_DIFF + 1024 + h * 128 + mm * 64);
                float dot = 0.f;
#pragma unroll
                for (int d8 = 0; d8 < 8; ++d8) { const u32x4 q8 = *(const LAS u32x4*)(qs + mm * 32 + d8 * 4); dot = dot8(q8, kr[d8], dot); }
                const int dist = (t - sc) < 127 ? (t - sc) : 127;
                const float scv = valid ? dot * 0.125f + blut[h * 128 + dist] : -3.0e38f;
                const float mnew = fmaxf(mrun, wave_max(scv));
                const float alpha = __expf(mrun - mnew);
                const float p = valid ? __expf(scv - mnew) : 0.f;
                l = l * alpha + wave_sum(p); o0 *= alpha; o1 *= alpha; mrun = mnew;
                const int ns = (t - s0 + 1) < 64 ? (t - s0 + 1) : 64;
                const bf16* vb = Sd + ((size_t)b * SEQ + s0) * N_DIFF + 2048 + h * 128 + 2 * lane;
                for (int j = 0; j < ns; ++j) {
                    const float pj = rdlane(p, j);
                    const unsigned v = *(const unsigned*)(vb + (size_t)j * N_DIFF);
                    o0 += pj * bflo(v); o1 += pj * bfhi(v);
                }
            }
            om0[mm] = o0 / l; om1[mm] = o1 / l;
        }
        const float a0 = om0[0] - lam * om0[1], a1 = om1[0] - lam * om1[1];
        const float ms = wave_sum(a0 * a0 + a1 * a1) * (1.0f / 128.0f);
        const float rs = (1.0f / sqrtf(ms + 1e-5f)) * (1.0f - lam_init);
        *(unsigned*)(Y + row * YW + 1024 + h * 128 + 2 * lane) = pk2(a0 * rs * subln[2 * lane], a1 * rs * subln[2 * lane + 1]);
    }
}

__device__ __forceinline__ void naive_dil(Frame& F, const bf16* Sl, int g, const float* blut, float* Pn, float* Ps, bf16* Y) {
    LAS unsigned* qs = (LAS unsigned*)(F.lds + RING_OFF + F.wave * 1024);
    int lane_ = threadIdx.x & 63; asm volatile("" : "+v"(lane_));
    const int gw = F.vcu * NWAVES + F.wave, NGW = F.G * NWAVES, lane = lane_;
    const int dl = (g == 0) ? 1 : (g == 1 ? 4 : 16);
    for (int it = gw; it < M * 4; it += NGW) {
        const int bh = it & 63, t = it >> 6, b = bh >> 2, h = bh & 3;
        const size_t row = (size_t)b * SEQ + t;
        LDS_WAIT();
        qs[lane] = *(const unsigned*)(Sl + row * N_DILG + h * 128 + 2 * lane);
        LDS_WAIT(); asm volatile("" ::: "memory");
        float sc[3];
#pragma unroll
        for (int tl = 0; tl < 3; ++tl) {
            const int mi = tl * 64 + lane; const int kp = t - mi * dl; const bool valid = (mi <= 128) && (kp >= 0);
            const u32x4* kr = (const u32x4*)(Sl + ((size_t)b * SEQ + (valid ? kp : t)) * N_DILG + 512 + h * 128);
            float dot = 0.f;
#pragma unroll
            for (int d8 = 0; d8 < 16; ++d8) { const u32x4 q8 = *(const LAS u32x4*)(qs + d8 * 4); dot = dot8(q8, kr[d8], dot); }
            const int dist = (mi * dl) < 127 ? (mi * dl) : 127;
            sc[tl] = valid ? dot * 0.08838834764831845f + blut[(8 + g * 4 + h) * 128 + dist] : -3.0e38f;
        }
        float mx = wave_max(fmaxf(fmaxf(sc[0], sc[1]), sc[2]));
        float p[3], den = 0.f;
#pragma unroll
        for (int tl = 0; tl < 3; ++tl) { p[tl] = (sc[tl] > -1.0e38f) ? __expf(sc[tl] - mx) : 0.f; den += p[tl]; }
        den = wave_sum(den);
        float n0 = 0.f, n1 = 0.f;
#pragma unroll
        for (int tl = 0; tl < 3; ++tl) {
            for (int j = 0; j < 64; ++j) {
                const int mi = tl * 64 + j; const int kp = t - mi * dl;
                if (mi > 128 || kp < 0) break;
                const float pj = rdlane(p[tl], j);
                const unsigned v = *(const unsigned*)(Sl + ((size_t)b * SEQ + kp) * N_DILG + 1024 + h * 128 + 2 * lane);
                n0 += pj * bflo(v); n1 += pj * bfhi(v);
            }
        }
        float* pn = Pn + (row * 4 + h) * 128 + 2 * lane; float* ps = Ps + (row * 4 + h) * 2;
        if (g > 0) {
            const f32x2 q = *(const f32x2*)pn; const float pm = ps[0], pd = ps[1];
            const float mnew = fmaxf(mx, pm), ea = __expf(mx - mnew), eb = __expf(pm - mnew);
            n0 = ea * n0 + eb * q[0]; n1 = ea * n1 + eb * q[1]; den = ea * den + eb * pd; mx = mnew;
        }
        if (g < 2) { *(f32x2*)pn = (f32x2){n0, n1}; if (lane == 0) { ps[0] = mx; ps[1] = den; } }
        else { const float inv = 1.0f / den; *(unsigned*)(Y + row * YW + 2048 + h * 128 + 2 * lane) = pk2(n0 * inv, n1 * inv); }
    }
}

__device__ __forceinline__ void phase_final(Frame& F, float* out, const float* gain) {
    int lane = threadIdx.x & 63; asm volatile("" : "+v"(lane));
    const int gw = F.vcu * NWAVES + F.wave, NGW = F.G * NWAVES;
    for (int m = gw; m < M; m += NGW) {
        f32x4* xr = (f32x4*)(out + (size_t)m * D) + lane;
        f32x4 v[4]; float s = 0.f;
#pragma unroll
        for (int j = 0; j < 4; ++j) { v[j] = xr[64 * j]; s += (v[j][0] * v[j][0] + v[j][1] * v[j][1]) + (v[j][2] * v[j][2] + v[j][3] * v[j][3]); }
        const float rs = 1.0f / sqrtf(wave_sum(s) * (1.0f / D) + 1e-6f);
#pragma unroll
        for (int j = 0; j < 4; ++j) { const f32x4 gq = *((const f32x4*)gain + lane + 64 * j); xr[64 * j] = v[j] * rs * gq; }
    }
}

constexpr int PH_PER_LAYER = 17;
constexpr int N_PHASES = DEPTH * PH_PER_LAYER + 1;

__global__ void __launch_bounds__(NWAVES * 64, 2) mk_fwd(Args args) {
    extern __shared__ __attribute__((aligned(16))) unsigned char lds[];
    Frame F;
    F.lds = (LAS unsigned char*)lds;
    F.MISC = (volatile LAS unsigned*)(F.lds + MISC_OFF);
    F.wave = __builtin_amdgcn_readfirstlane((int)threadIdx.x >> 6);
    F.G = gridDim.x; { const int bx = blockIdx.x; F.vcu = (F.G % 8 == 0) ? (bx % 8) * (F.G / 8) + bx / 8 : bx; }
    unsigned char* ws = args.ws;
    F.ctl = (gu32*)(ws + WS_CTL);
    for (int u = threadIdx.x; u < (LDS_BYTES - LDSCTL_OFF) / 4; u += NWAVES * 64) ((LAS unsigned*)(F.lds + LDSCTL_OFF))[u] = 0u;
    __syncthreads();
#if MK_PER_PHASE
#define GRID_BAR() do { } while (0)
#else
    XcdBarrier bar = xcd_barrier_post((unsigned*)(F.ctl + CW_BAR), F.MISC + 8);
#define GRID_BAR() xcd_barrier(bar)
#endif
    const int lo = args.ph_lo, hi = args.ph_hi;
    int ph = 0;
#define PHASE_BEGIN if (ph >= lo && ph < hi) {
#define PHASE_END   if (ph + 1 < hi) GRID_BAR(); } ++ph;

#define WIN ((bf16*)(ws + WS_WIN))
#define WBR ((bf16*)(ws + WS_WBR))
#define WOUT ((bf16*)(ws + WS_WOUT))
#define WGU ((bf16*)(ws + WS_WGU))
#define WDN ((bf16*)(ws + WS_WDN))
#define XB ((bf16*)(ws + WS_XB))
#define Y ((bf16*)(ws + WS_Y))
#define S ((bf16*)(ws + WS_S))
#define XB2 ((bf16*)(ws + WS_XB2))
#define HID ((bf16*)(ws + WS_HID))
#define RSS ((float*)(ws + WS_RSS))
#define CS ((const float*)(ws + WS_CS))
#define BLUT ((const float*)(ws + WS_BLUT))
#define DILP ((float*)(ws + WS_DILP))
#define DILS ((float*)(ws + WS_DILS))

    for (int l = 0; l < DEPTH; ++l) {
        PHASE_BEGIN if (EN_CONV) phase_convert(F, args, l); PHASE_END

        for (int sub = 0; sub < 6; ++sub) {
            const int coff = (sub == 0) ? C_RET : (sub == 1) ? C_DIFF : (sub <= 4) ? (C_DIL + (sub - 2) * N_DILG) : C_GATE;
            const int nsub = (sub >= 2 && sub <= 4) ? N_DILG : 3072;
            PHASE_BEGIN {
                pg8::Gemm g{XB, WIN + (size_t)coff * D, D, D, M, nsub, D}; pg8::StaticOrder So; So.init(M, nsub, F.G, (int)blockIdx.x);
                pg8::EpiIn E{S, nsub, RSS, CS, (sub == 0) ? 1 : (sub == 5 ? 2 : 0)};
                if (EN_IN) pg8::gemm_phase<pg8::EpiIn, pg8::StaticOrder, true>(F.lds + RING_OFF, g, So, E);
            } PHASE_END
            if (sub == 0) {
                PHASE_BEGIN if (EN_RET) naive_ret(F, S, args.gn_gain + l * 1024, Y); PHASE_END
                PHASE_BEGIN PHASE_END
            } else if (sub == 1) {
                const float lam_init = (l == 0) ? 0.2f : 0.35550906759096934f;
                PHASE_BEGIN if (EN_DIFF) naive_diff(F, S, args.diff_lambda + l * 256, lam_init, args.subln + l * 128, BLUT, Y); PHASE_END
            } else if (sub <= 4) {
                PHASE_BEGIN if (EN_DIL) naive_dil(F, S, sub - 2, BLUT, DILP, DILS, Y); PHASE_END
            }
        }
        PHASE_BEGIN {
            pg8::Gemm g{Y, WBR, YW, YW, M, D, D}; pg8::SegOrder So; So.init(M, D, F.G, (int)blockIdx.x);
            pg8::EpiMerge E{XB, S};
            if (EN_MERGE) pg8::gemm_phase<pg8::EpiMerge, pg8::SegOrder, true>(F.lds + RING_OFF, g, So, E);
        } PHASE_END
        PHASE_BEGIN {
            pg8::Gemm g{XB, WOUT, D, D, M, D, D}; pg8::StaticOrder So; So.init(M, D, F.G, (int)blockIdx.x);
            pg8::EpiRes E{(l == 0) ? args.x : args.out, args.out, XB2, RSS};
            if (EN_OUT) pg8::gemm_phase<pg8::EpiRes, pg8::StaticOrder, true>(F.lds + RING_OFF, g, So, E);
        } PHASE_END
        PHASE_BEGIN {
            pg8::Gemm g{XB2, WGU, D, D, M, 2 * FFN, D}; pg8::StaticOrder So; So.init(M, 2 * FFN, F.G, (int)blockIdx.x);
            pg8::EpiSwiGLU E{HID, RSS};
            if (EN_UP) pg8::gemm_phase<pg8::EpiSwiGLU, pg8::StaticOrder, true>(F.lds + RING_OFF, g, So, E);
        } PHASE_END
        PHASE_BEGIN {
            pg8::Gemm g{HID, WDN, FFN, FFN, M, D, FFN}; pg8::StaticOrder So; So.init(M, D, F.G, (int)blockIdx.x);
            pg8::EpiRes E{args.out, args.out, XB, RSS};
            if (EN_DOWN) pg8::gemm_phase<pg8::EpiRes, pg8::StaticOrder, true>(F.lds + RING_OFF, g, So, E);
        } PHASE_END
    }
    PHASE_BEGIN if (EN_FIN) phase_final(F, args.out, args.norm_final); PHASE_END
#undef PHASE_BEGIN
#undef PHASE_END
}

extern "C" void kernel_launch(void* const* d_in, const int* in_sizes, int n_in, void* d_out, int out_size, void* d_ws, size_t ws_size, hipStream_t stream) {
    static int grid = 0;
    if (grid == 0) {
        if (n_in != 16 || in_sizes[0] != M * D || out_size != M * D || ws_size < WS_END) { fprintf(stderr, "kernel_launch: unexpected shapes (n_in %d, ws %zu)\n", n_in, ws_size); grid = -1; return; }
        int dev = 0, cus = 0, per_cu = 0;
        if (hipGetDevice(&dev) != hipSuccess || hipDeviceGetAttribute(&cus, hipDeviceAttributeMultiprocessorCount, dev) != hipSuccess) { grid = -1; return; }
        if (hipFuncSetAttribute((const void*)mk_fwd, hipFuncAttributeMaxDynamicSharedMemorySize, LDS_BYTES) != hipSuccess) { grid = -1; return; }
        if (hipOccupancyMaxActiveBlocksPerMultiprocessor(&per_cu, (const void*)mk_fwd, NWAVES * 64, LDS_BYTES) != hipSuccess || per_cu < 1) { fprintf(stderr, "kernel_launch: occupancy query says %d\n", per_cu); }
        (void)hipGetLastError();
        grid = cus;
    }
    if (grid < 0) return;
    if (hipMemsetAsync((char*)d_ws + WS_CTL, 0, CTL_ZERO_BYTES, stream) != hipSuccess) return;
    Args a{};
    a.x = (const float*)d_in[0]; a.w_in = (const float*)d_in[1]; a.w_br_ret = (const float*)d_in[2]; a.w_br_diff = (const float*)d_in[3]; a.w_br_dil = (const float*)d_in[4];
    a.w_out = (const float*)d_in[5]; a.norm_mix = (const float*)d_in[6]; a.norm_ffn = (const float*)d_in[7]; a.gn_gain = (const float*)d_in[8]; a.diff_lambda = (const float*)d_in[9];
    a.subln = (const float*)d_in[10]; a.rel_bias = (const float*)d_in[11]; a.w_gate = (const float*)d_in[12]; a.w_up = (const float*)d_in[13]; a.w_down = (const float*)d_in[14];
    a.norm_final = (const float*)d_in[15];
    a.out = (float*)d_out; a.ws = (unsigned char*)d_ws;
#if MK_PER_PHASE
    for (int p = 0; p < N_PHASES; ++p) {
        if (p % PH_PER_LAYER == 3 && p < DEPTH * PH_PER_LAYER) continue;
        a.ph_lo = p; a.ph_hi = p + 1;
        hipLaunchKernelGGL(mk_fwd, dim3(grid), dim3(NWAVES * 64), LDS_BYTES, stream, a);
    }
#else
    a.ph_lo = 0; a.ph_hi = N_PHASES;
    hipLaunchKernelGGL(mk_fwd, dim3(grid), dim3(NWAVES * 64), LDS_BYTES, stream, a);
#endif
}
```

```cpp
#include <hip/hip_runtime.h>
#include <cstdio>
#include <cstdint>

#ifndef MK_PER_PHASE
#define MK_PER_PHASE 0
#endif


#ifndef DIFF_MFMA
#define DIFF_MFMA 1
#endif
#ifndef DIL_MFMA
#define DIL_MFMA 1
#endif
#ifndef RET_MFMA
#define RET_MFMA 1
#endif
#ifndef EN_ALL
#define EN_ALL 1
#endif
#ifndef EN_CONV
#define EN_CONV EN_ALL
#endif
#ifndef EN_IN
#define EN_IN EN_ALL
#endif
#ifndef EN_RET
#define EN_RET EN_ALL
#endif
#ifndef EN_DIFF
#define EN_DIFF EN_ALL
#endif
#ifndef EN_DIL
#define EN_DIL EN_ALL
#endif
#ifndef EN_MERGE
#define EN_MERGE EN_ALL
#endif
#ifndef EN_OUT
#define EN_OUT EN_ALL
#endif
#ifndef EN_UP
#define EN_UP EN_ALL
#endif
#ifndef EN_DOWN
#define EN_DOWN EN_ALL
#endif
#ifndef EN_FIN
#define EN_FIN EN_ALL
#endif
#define GAS __attribute__((address_space(1)))
#define LAS __attribute__((address_space(3)))
typedef unsigned short bf16;
typedef unsigned short bf16_t;
typedef short bf16x8 __attribute__((ext_vector_type(8)));
typedef float f32x4 __attribute__((ext_vector_type(4)));
typedef float f32x2 __attribute__((ext_vector_type(2)));
typedef unsigned u32x4 __attribute__((ext_vector_type(4)));
typedef unsigned u32x2 __attribute__((ext_vector_type(2)));

constexpr int BATCH = 16, SEQ = 2048, D = 1024, M = BATCH * SEQ, DEPTH = 2;
constexpr int IN_W = 13824, FFN = 2816;
constexpr int C_RET = 0, C_DIFF = 3072, C_DIL = 6144, C_GATE = 10752;
constexpr int N_RET = 3072, N_DIFF = 3072, N_DILG = 1536, N_GATE = 3072;
constexpr int YW = 2560;
constexpr int NWAVES = 8;

constexpr size_t MiB = 1u << 20;
constexpr size_t WS_CTL = 0, CTL_ZERO_BYTES = 1 * MiB;
constexpr size_t WS_CS = 1 * MiB;
constexpr size_t WS_BLUT = 2 * MiB;
constexpr size_t WS_RSS = 3 * MiB;
constexpr size_t WS_WIN = 8 * MiB;
constexpr size_t WS_WBR = 35 * MiB;
constexpr size_t WS_WOUT = 40 * MiB;
constexpr size_t WS_WGU = 42 * MiB;
constexpr size_t WS_WDN = 53 * MiB;
constexpr size_t WS_XB = 60 * MiB;
constexpr size_t WS_Y = 124 * MiB;
constexpr size_t WS_S = 284 * MiB;
constexpr size_t WS_XB2 = 300 * MiB;
constexpr size_t WS_HID = 124 * MiB;
constexpr size_t WS_DILP = WS_S + 96 * MiB;
constexpr size_t WS_DILS = WS_DILP + 64 * MiB;
constexpr size_t WS_END = 512 * MiB;

constexpr int CW_TMO = 0;
constexpr int CW_BAR = 4096;

constexpr int RING_OFF = 0, RING_BYTES = 131072;
constexpr int LDSCTL_OFF = RING_BYTES, MISC_OFF = LDSCTL_OFF + 320;
constexpr int LDS_BYTES = 147456;

typedef GAS unsigned gu32;
#define RLX_AGENT __ATOMIC_RELAXED, __HIP_MEMORY_SCOPE_AGENT
#define LDS_WAIT() asm volatile("s_waitcnt lgkmcnt(0)" ::: "memory")
#define VM_WAIT() asm volatile("s_waitcnt vmcnt(0)" ::: "memory")

__device__ __forceinline__ unsigned f2bf(float f) { unsigned u = __builtin_bit_cast(unsigned, f); return (u + 0x7fffu + ((u >> 16) & 1u)) >> 16; }
__device__ __forceinline__ unsigned pk2(float lo, float hi) { return f2bf(lo) | (f2bf(hi) << 16); }
__device__ __forceinline__ float bflo(unsigned w) { return __builtin_bit_cast(float, w << 16); }
__device__ __forceinline__ float bfhi(unsigned w) { return __builtin_bit_cast(float, w & 0xffff0000u); }
__device__ __forceinline__ float wave_sum(float v) {
#pragma unroll
    for (int o = 1; o < 64; o <<= 1) v += __shfl_xor(v, o);
    return v;
}
__device__ __forceinline__ float wave_max(float v) {
#pragma unroll
    for (int o = 1; o < 64; o <<= 1) v = fmaxf(v, __shfl_xor(v, o));
    return v;
}
__device__ __forceinline__ float rdlane(float v, int j) { return __builtin_bit_cast(float, __builtin_amdgcn_readlane(__builtin_bit_cast(int, v), j)); }
__device__ __forceinline__ float sigmoidf_(float x) { return 1.0f / (1.0f + __expf(-x)); }

__device__ const double ROPE_INV[64] = {1.0,0.8659643233600653,0.7498942093324559,0.6493816315762113,0.5623413251903491,0.4869675251658631,0.4216965034285822,0.3651741272548377,0.31622776601683794,0.27384196342643613,0.23713737056616552,0.2053525026457146,0.1778279410038923,0.1539926526059492,0.1333521432163324,0.11547819846894582,0.1,0.08659643233600653,0.07498942093324558,0.06493816315762113,0.05623413251903491,0.04869675251658631,0.042169650342858224,0.03651741272548377,0.03162277660168379,0.027384196342643614,0.023713737056616554,0.02053525026457146,0.01778279410038923,0.01539926526059492,0.01333521432163324,0.011547819846894581,0.01,0.008659643233600654,0.007498942093324558,0.006493816315762113,0.005623413251903491,0.004869675251658631,0.004216965034285823,0.003651741272548377,0.0031622776601683794,0.0027384196342643613,0.0023713737056616554,0.002053525026457146,0.0017782794100389228,0.001539926526059492,0.001333521432163324,0.0011547819846894581,0.001,0.0008659643233600654,0.0007498942093324559,0.0006493816315762113,0.0005623413251903491,0.0004869675251658631,0.00042169650342858224,0.0003651741272548377,0.00031622776601683794,0.0002738419634264361,0.00023713737056616554,0.0002053525026457146,0.00017782794100389227,0.0001539926526059492,0.0001333521432163324,0.00011547819846894582};
__device__ const unsigned char REL_BUCKET[128] = {0,1,2,3,4,5,6,7,8,9,10,11,12,13,14,15,16,16,16,17,17,18,18,18,19,19,19,20,20,20,20,21,21,21,21,22,22,22,22,22,23,23,23,23,23,23,24,24,24,24,24,24,25,25,25,25,25,25,25,26,26,26,26,26,26,26,26,27,27,27,27,27,27,27,27,27,27,28,28,28,28,28,28,28,28,28,28,29,29,29,29,29,29,29,29,29,29,29,29,30,30,30,30,30,30,30,30,30,30,30,30,30,30,31,31,31,31,31,31,31,31,31,31,31,31,31,31,31};

namespace pg8 {
#define PG8_LAS __attribute__((address_space(3)))
constexpr int BM = 256, BK = 64, HALF = 128, HTB = HALF * BK * 2, STAGE_BYTES = 8 * HTB, NXCD = 8, WGM = 8;
__host__ __device__ __forceinline__ int lds_byte(int r, int c) { const int st = (r >> 4) * 2 + (c >> 5), rr = r & 15, cc = c & 31, ob = rr * 64 + cc * 2; return st * 1024 + (ob ^ (((ob >> 9) & 1) << 5)); }
__host__ __device__ __forceinline__ void stage_rc(int b, int& R, int& C) { const int st = b / 1024, sb = b % 1024, swz = sb ^ (((sb >> 9) & 1) << 5); R = (st >> 1) * 16 + swz / 64; C = (st & 1) * 32 + (swz % 64) / 2; }
__host__ __device__ __forceinline__ int perm32(int rho) { const int n = rho >> 4, i = rho & 15; return 8 * (i >> 2) + 4 * n + (i & 3); }

struct Unit { int pm, pn, seg; };
struct Gemm { const bf16_t* A; const bf16_t* Bt; int lda, ldb, M, N, K; };

struct StaticOrder {
    int nM, nN, nwg, G, c;
    __device__ void init(int M_, int N_, int G_, int c_) { nM = M_ / BM; nN = N_ / BM; nwg = nM * nN; G = G_; c = c_; }
    __device__ __forceinline__ bool tile(int i, Unit& u) const {
        const long L = (long)i * G + c; if (L >= nwg) return false;
        int wgid = (int)L; { const int q = nwg / NXCD, r = nwg % NXCD, xcd = wgid % NXCD, off = wgid / NXCD; wgid = (xcd < r ? xcd * (q + 1) : r * (q + 1) + (xcd - r) * q) + off; }
        const int nig = WGM * nN, gid = wgid / nig, fm = gid * WGM, gsz = (nM - fm) < WGM ? (nM - fm) : WGM;
        u.pm = fm + ((wgid % nig) % gsz); u.pn = (wgid % nig) / gsz; return true;
    }
    __device__ __forceinline__ bool next(int i, Unit& u) const { u.seg = 0; return tile(i, u); }
    __device__ __forceinline__ const char* abase(const Gemm& g, const Unit& u) const { return (const char*)g.A + (size_t)u.pm * BM * g.lda * 2; }
    __device__ __forceinline__ const char* bbase(const Gemm& g, const Unit& u) const { return (const char*)g.Bt + (size_t)u.pn * BM * g.ldb * 2; }
    __device__ __forceinline__ int nt(const Gemm& g, const Unit&) const { return g.K / BK; }
};
struct SegOrder : StaticOrder {
    __device__ __forceinline__ bool next(int i, Unit& u) const { u.seg = i % 3; return tile(i / 3, u); }
    __device__ __forceinline__ const char* abase(const Gemm& g, const Unit& u) const { return (const char*)g.A + (size_t)u.pm * BM * g.lda * 2 + (size_t)u.seg * 2048; }
    __device__ __forceinline__ const char* bbase(const Gemm& g, const Unit& u) const { return (const char*)g.Bt + (size_t)u.pn * BM * g.ldb * 2 + (size_t)u.seg * 2048; }
    __device__ __forceinline__ int nt(const Gemm&, const Unit& u) const { return u.seg < 2 ? 16 : 8; }
};

__device__ __forceinline__ unsigned cvt_pk_bf16(float lo, float hi) { unsigned r; asm volatile("v_cvt_pk_bf16_f32 %0, %1, %2" : "=v"(r) : "v"(lo), "v"(hi)); return r; }

__device__ __forceinline__ float row_rstd(const float* rss, int row) {
    const f32x4* rp = (const f32x4*)(rss + (size_t)row * 16);
    const f32x4 a = rp[0], b = rp[1], c = rp[2], d = rp[3];
    const float ss = (((a[0] + a[1]) + (a[2] + a[3])) + ((b[0] + b[1]) + (b[2] + b[3]))) + (((c[0] + c[1]) + (c[2] + c[3])) + ((d[0] + d[1]) + (d[2] + d[3])));
    return 1.0f / sqrtf(ss * (1.0f / 1024.0f) + 1e-6f);
}

struct EpiIn {
    static constexpr bool PERM = true, AFTER_DRAIN = false;
    bf16_t* O; int ldc; const float* rss; const float* cs; int mode;
    __device__ __forceinline__ void operator()(const f32x4 (&acc)[2][2][4][2], const Unit& u, int wr, int wc, int fr, int fq) const {
        const int row0 = u.pm * BM + wr * 64 + fr, col0 = u.pn * BM + wc * 32 + 8 * fq;
        const bool rot = (mode == 1) && (u.pn < 4);
        const float ksc = (u.pn >= 2) ? 0.08838834764831845f : 1.0f;
#pragma unroll
        for (int ai = 0; ai < 2; ++ai)
#pragma unroll
            for (int m = 0; m < 4; ++m) {
                const int row = row0 + ai * HALF + m * 16;
                const float rs = row_rstd(rss, row);
                bf16_t* rowp = O + (size_t)row * ldc + col0;
                f32x4 c01 = (f32x4){1.f, 0.f, 1.f, 0.f}, c23 = c01;
                if (rot) { const f32x4* cp = (const f32x4*)(cs + ((size_t)(row & (SEQ - 1)) * 64 + 16 * wc + 4 * fq) * 2); c01 = cp[0]; c23 = cp[1]; }
#pragma unroll
                for (int bj = 0; bj < 2; ++bj) {
                    f32x4 v0 = acc[ai][bj][m][0] * rs, v1 = acc[ai][bj][m][1] * rs;
                    if (rot) {
                        f32x4 w0, w1;
                        w0[0] = v0[0] * c01[0] - v0[1] * c01[1]; w0[1] = v0[0] * c01[1] + v0[1] * c01[0];
                        w0[2] = v0[2] * c01[2] - v0[3] * c01[3]; w0[3] = v0[2] * c01[3] + v0[3] * c01[2];
                        w1[0] = v1[0] * c23[0] - v1[1] * c23[1]; w1[1] = v1[0] * c23[1] + v1[1] * c23[0];
                        w1[2] = v1[2] * c23[2] - v1[3] * c23[3]; w1[3] = v1[2] * c23[3] + v1[3] * c23[2];
                        v0 = w0 * ksc; v1 = w1 * ksc;
                    } else if (mode == 4) {
                        if (u.pn < 2) { v0 = v0 * 0.12751743082459868f; v1 = v1 * 0.12751743082459868f; }
                    } else if (mode == 3) {
                        if (u.pn < 4) { v0 = v0 * 0.18033688011112042f; v1 = v1 * 0.18033688011112042f; }
                    } else if (mode == 2) {
#pragma unroll
                        for (int j = 0; j < 4; ++j) { v0[j] = sigmoidf_(v0[j]); v1[j] = sigmoidf_(v1[j]); }
                    }
                    u32x4 w; w.x = cvt_pk_bf16(v0[0], v0[1]); w.y = cvt_pk_bf16(v0[2], v0[3]); w.z = cvt_pk_bf16(v1[0], v1[1]); w.w = cvt_pk_bf16(v1[2], v1[3]);
                    *(u32x4*)(rowp + bj * HALF) = w;
                }
            }
    }
};
struct EpiMerge {
    static constexpr bool PERM = true, AFTER_DRAIN = false;
    bf16_t* O; const bf16_t* Gt;
    __device__ __forceinline__ void operator()(const f32x4 (&acc)[2][2][4][2], const Unit& u, int wr, int wc, int fr, int fq) const {
        const int row0 = u.pm * BM + wr * 64 + fr, col0 = u.pn * BM + wc * 32 + 8 * fq;
#pragma unroll
        for (int ai = 0; ai < 2; ++ai)
#pragma unroll
            for (int m = 0; m < 4; ++m) {
                const int row = row0 + ai * HALF + m * 16;
#pragma unroll
                for (int bj = 0; bj < 2; ++bj) {
                    const int col = col0 + bj * HALF;
                    const u32x4 g = *(const u32x4*)(Gt + (size_t)row * N_GATE + u.seg * 1024 + col);
                    f32x4 v0 = acc[ai][bj][m][0], v1 = acc[ai][bj][m][1];
                    v0[0] *= bflo(g.x); v0[1] *= bfhi(g.x); v0[2] *= bflo(g.y); v0[3] *= bfhi(g.y);
                    v1[0] *= bflo(g.z); v1[1] *= bfhi(g.z); v1[2] *= bflo(g.w); v1[3] *= bfhi(g.w);
                    bf16_t* op = O + (size_t)row * D + col;
                    if (u.seg > 0) {
                        const u32x4 p = *(const u32x4*)op;
                        v0[0] += bflo(p.x); v0[1] += bfhi(p.x); v0[2] += bflo(p.y); v0[3] += bfhi(p.y);
                        v1[0] += bflo(p.z); v1[1] += bfhi(p.z); v1[2] += bflo(p.w); v1[3] += bfhi(p.w);
                    }
                    u32x4 w; w.x = cvt_pk_bf16(v0[0], v0[1]); w.y = cvt_pk_bf16(v0[2], v0[3]); w.z = cvt_pk_bf16(v1[0], v1[1]); w.w = cvt_pk_bf16(v1[2], v1[3]);
                    *(u32x4*)op = w;
                }
            }
    }
};
struct EpiRes {
    static constexpr bool PERM = false, AFTER_DRAIN = false;
    const float* res; float* xo; bf16_t* xb; float* rss;
    __device__ __forceinline__ void operator()(const f32x4 (&acc)[2][2][4][2], const Unit& u, int wr, int wc, int fr, int fq) const {
        const int row0 = u.pm * BM + wr * 64 + fr, col0 = u.pn * BM + wc * 32 + 4 * fq;
#pragma unroll
        for (int ai = 0; ai < 2; ++ai)
#pragma unroll
            for (int m = 0; m < 4; ++m) {
                const int row = row0 + ai * HALF + m * 16; float ss = 0.f;
#pragma unroll
                for (int bj = 0; bj < 2; ++bj)
#pragma unroll
                    for (int n = 0; n < 2; ++n) {
                        const size_t off = (size_t)row * D + col0 + bj * HALF + n * 16;
                        const f32x4 v = acc[ai][bj][m][n] + *(const f32x4*)(res + off);
                        *(f32x4*)(xo + off) = v;
                        ss += (v[0] * v[0] + v[1] * v[1]) + (v[2] * v[2] + v[3] * v[3]);
                        u32x2 w; w.x = cvt_pk_bf16(v[0], v[1]); w.y = cvt_pk_bf16(v[2], v[3]);
                        *(u32x2*)(xb + off) = w;
                    }
                ss += __shfl_xor(ss, 16); ss += __shfl_xor(ss, 32);
                if (fq == 0) rss[(size_t)row * 16 + u.pn * 4 + wc] = ss;
            }
    }
};
struct EpiSwiGLU {
    static constexpr bool PERM = true, AFTER_DRAIN = false;
    bf16_t* H; const float* rss;
    __device__ __forceinline__ void operator()(const f32x4 (&acc)[2][2][4][2], const Unit& u, int wr, int wc, int fr, int fq) const {
        const int row0 = u.pm * BM + wr * 64 + fr, col0 = u.pn * HALF + wc * 32 + 8 * fq;
#pragma unroll
        for (int ai = 0; ai < 2; ++ai)
#pragma unroll
            for (int m = 0; m < 4; ++m) {
                const int row = row0 + ai * HALF + m * 16;
                const float rs = row_rstd(rss, row);
                f32x4 h0, h1;
#pragma unroll
                for (int j = 0; j < 4; ++j) {
                    const float g0 = acc[ai][0][m][0][j] * rs, g1 = acc[ai][0][m][1][j] * rs;
                    h0[j] = g0 * sigmoidf_(g0) * (acc[ai][1][m][0][j] * rs);
                    h1[j] = g1 * sigmoidf_(g1) * (acc[ai][1][m][1][j] * rs);
                }
                u32x4 w; w.x = cvt_pk_bf16(h0[0], h0[1]); w.y = cvt_pk_bf16(h0[2], h0[3]); w.z = cvt_pk_bf16(h1[0], h1[1]); w.w = cvt_pk_bf16(h1[2], h1[3]);
                *(u32x4*)(H + (size_t)row * FFN + col0) = w;
            }
    }
};

template <class Epi, class Sched, bool ALIGN_EPI>
__device__ __forceinline__ void gemm_phase(PG8_LAS unsigned char* lds, const Gemm g, const Sched& S, const Epi& E) {
    int tid_ = threadIdx.x; asm volatile("" : "+v"(tid_));
    const int tid = tid_, wid = __builtin_amdgcn_readfirstlane(tid >> 6), lane = tid & 63, wr = wid >> 2, wc = wid & 3, fr = lane & 15, fq = lane >> 4;
    unsigned voffA[2], voffB[2];
#pragma unroll
    for (int i = 0; i < 2; ++i) { int R, C; stage_rc(tid * 16 + i * 8192, R, C); const int Rb = Epi::PERM ? ((R & ~31) + perm32(R & 31)) : R;
        voffA[i] = (unsigned)(R * g.lda + C) * 2u; voffB[i] = (unsigned)(Rb * g.ldb + C) * 2u; }
    const size_t kstep = (size_t)(BK * 2);
    const size_t hstepA = (size_t)HALF * g.lda * 2, hstepB = (size_t)HALF * g.ldb * 2;
    const unsigned ldsw = (unsigned)wid * 1024u;
    const int aoff = lds_byte(wr * 64 + fr, fq * 8), boff = lds_byte(wc * 32 + fr, fq * 8);
#define PG8_SA(b, h) (((b) * 2 + (h)) * HTB)
#define PG8_SB(b, h) ((4 + (b) * 2 + (h)) * HTB)
#define PG8_STAGE(bufoff, gbase, voff) do { _Pragma("unroll") for (int _i = 0; _i < 2; ++_i) \
        __builtin_amdgcn_global_load_lds((const unsigned*)((const char*)(gbase) + (voff)[_i]), (PG8_LAS unsigned*)(lds + (bufoff) + ldsw + _i * 8192), 16, 0, 0); } while (0)
#define PG8_LDA(dst, b, h) do { _Pragma("unroll") for (int m = 0; m < 4; ++m) _Pragma("unroll") for (int k = 0; k < 2; ++k) dst[m][k] = *(const PG8_LAS bf16x8*)(lds + PG8_SA(b, h) + aoff + m * 2048 + k * 1024); } while (0)
#define PG8_LDB(dst, b, h) do { _Pragma("unroll") for (int n = 0; n < 2; ++n) _Pragma("unroll") for (int k = 0; k < 2; ++k) dst[n][k] = *(const PG8_LAS bf16x8*)(lds + PG8_SB(b, h) + boff + n * 2048 + k * 1024); } while (0)
#define PG8_MMA(ai, bj, At, Bt) do { __builtin_amdgcn_s_setprio(1); _Pragma("unroll") for (int m = 0; m < 4; ++m) _Pragma("unroll") for (int n = 0; n < 2; ++n) _Pragma("unroll") for (int k = 0; k < 2; ++k) \
        acc[ai][bj][m][n] = __builtin_amdgcn_mfma_f32_16x16x32_bf16(Bt[n][k], At[m][k], acc[ai][bj][m][n], 0, 0, 0); __builtin_amdgcn_s_setprio(0); } while (0)
#define PG8_WAIT_V(n) asm volatile("s_waitcnt vmcnt(" #n ")" ::: "memory")
#define PG8_WAIT_L(n) asm volatile("s_waitcnt lgkmcnt(" #n ")" ::: "memory")
#define PG8_BAR __builtin_amdgcn_s_barrier()
#define PG8_SCHED __builtin_amdgcn_sched_barrier(0)
    Unit cur, nxt; int ui = 0;
    if (!S.next(0, cur)) return;
    f32x4 acc[2][2][4][2];
#pragma unroll
    for (int a = 0; a < 2; ++a)
#pragma unroll
        for (int b = 0; b < 2; ++b)
#pragma unroll
            for (int m = 0; m < 4; ++m)
#pragma unroll
                for (int n = 0; n < 2; ++n) acc[a][b][m][n] = (f32x4){0.f, 0.f, 0.f, 0.f};
    bf16x8 At[4][2], B0[2][2], B1[2][2];
    const char* cA = S.abase(g, cur); const char* cB = S.bbase(g, cur);
    PG8_STAGE(PG8_SB(0, 0), cB, voffB); PG8_STAGE(PG8_SB(0, 1), cB + hstepB, voffB); PG8_STAGE(PG8_SA(0, 0), cA, voffA); PG8_STAGE(PG8_SA(0, 1), cA + hstepA, voffA);
    if (wr == 1) PG8_BAR;
    PG8_WAIT_V(2); PG8_BAR;
    PG8_STAGE(PG8_SB(1, 0), cB + kstep, voffB); PG8_STAGE(PG8_SA(1, 0), cA + kstep, voffA); PG8_STAGE(PG8_SB(1, 1), cB + hstepB + kstep, voffB);
    PG8_WAIT_V(6); PG8_BAR;
    for (;;) {
        const bool has_next = S.next(ui + 1, nxt);
        const int nt = S.nt(g, cur);
        const char* nA = has_next ? S.abase(g, nxt) : cA; const char* nB = has_next ? S.bbase(g, nxt) : cB;
        for (int t = 0; t < nt; t += 2) {
            const bool last = (t == nt - 2);
            const char* a1 = cA + (size_t)(t + 1) * kstep;
            const char* a2 = last ? nA : cA + (size_t)(t + 2) * kstep; const char* b2 = last ? nB : cB + (size_t)(t + 2) * kstep;
            const char* a3 = a2 + kstep; const char* b3 = b2 + kstep;
            PG8_LDB(B0, 0, 0); PG8_LDB(B1, 0, 1); PG8_SCHED; PG8_LDA(At, 0, 0); PG8_STAGE(PG8_SA(1, 1), a1 + hstepA, voffA);
            PG8_WAIT_V(8); PG8_WAIT_L(0); PG8_BAR; PG8_MMA(0, 0, At, B0); PG8_MMA(0, 1, At, B1); PG8_BAR; PG8_SCHED;
            PG8_LDA(At, 0, 1); PG8_STAGE(PG8_SB(0, 0), b2, voffB); PG8_STAGE(PG8_SB(0, 1), b2 + hstepB, voffB); PG8_STAGE(PG8_SA(0, 0), a2, voffA);
            PG8_WAIT_V(8); PG8_WAIT_L(0); PG8_BAR; PG8_MMA(1, 0, At, B0); PG8_MMA(1, 1, At, B1); PG8_BAR; PG8_SCHED;
            PG8_LDB(B0, 1, 0); PG8_LDB(B1, 1, 1); PG8_SCHED; PG8_LDA(At, 1, 0); PG8_STAGE(PG8_SA(0, 1), a2 + hstepA, voffA);
            PG8_WAIT_V(8); PG8_WAIT_L(0); PG8_BAR; PG8_MMA(0, 0, At, B0); PG8_MMA(0, 1, At, B1); PG8_BAR; PG8_SCHED;
            PG8_LDA(At, 1, 1); PG8_STAGE(PG8_SB(1, 0), b3, voffB); PG8_STAGE(PG8_SB(1, 1), b3 + hstepB, voffB); PG8_STAGE(PG8_SA(1, 0), a3, voffA);
            PG8_WAIT_V(8); PG8_WAIT_L(0); PG8_BAR; PG8_MMA(1, 0, At, B0); PG8_MMA(1, 1, At, B1); PG8_BAR; PG8_SCHED;
        }
        if constexpr (ALIGN_EPI) { if (wr == 0) PG8_BAR; }
        E(acc, cur, wr, wc, fr, fq);
        if (!has_next) break;
#pragma unroll
        for (int a = 0; a < 2; ++a)
#pragma unroll
            for (int b = 0; b < 2; ++b)
#pragma unroll
                for (int m = 0; m < 4; ++m)
#pragma unroll
                    for (int n = 0; n < 2; ++n) acc[a][b][m][n] = (f32x4){0.f, 0.f, 0.f, 0.f};
        cur = nxt; cA = nA; cB = nB; ++ui;
        if constexpr (ALIGN_EPI) { if (wr == 1) PG8_BAR; }
    }
    PG8_WAIT_V(0);
    if constexpr (!ALIGN_EPI) { if (wr == 0) PG8_BAR; }
    PG8_BAR;
#undef PG8_SA
#undef PG8_SB
#undef PG8_STAGE
#undef PG8_LDA
#undef PG8_LDB
#undef PG8_MMA
#undef PG8_WAIT_V
#undef PG8_WAIT_L
#undef PG8_BAR
#undef PG8_SCHED
}
}

#define XB_TMO      128
#define XB_XCNT(j)  (256  + 64 * (j))
#define XB_XSUB(j)  (1280 + 64 * (j))
#define XB_XGEN(j)  (2304 + 64 * (j))
#define XB_TOP      3328
#define XB_TOPGEN   3392
#define XCD_BAR_WORDS 3456
#define XB_SPIN_CAP (1u << 18)

__device__ __forceinline__ unsigned xb_ld(unsigned* p)              { return __hip_atomic_load(p, __ATOMIC_RELAXED, __HIP_MEMORY_SCOPE_AGENT); }
__device__ __forceinline__ unsigned xb_add(unsigned* p, unsigned v) { return __hip_atomic_fetch_add(p, v, __ATOMIC_RELAXED, __HIP_MEMORY_SCOPE_AGENT); }
__device__ __forceinline__ unsigned xb_xcc_id() { return (unsigned)__builtin_amdgcn_s_getreg((3 << 11) | 20) & 0xFu; }
#define XB_SPIN(cond, bar) do { unsigned _sp = 0; while (cond) { __builtin_amdgcn_s_sleep(1); \
    if ((++_sp & 255u) == 0u) { if (xb_ld(&(bar)[XB_TMO])) break; if (_sp > XB_SPIN_CAP) { atomicAdd(&(bar)[XB_TMO], 1u); break; } } } } while (0)

struct XcdBarrier { unsigned* bar; unsigned x; volatile LAS unsigned* st; };

__device__ __forceinline__ XcdBarrier xcd_barrier_post(unsigned* bar, volatile LAS unsigned* st) {
    XcdBarrier b; b.bar = bar; b.x = xb_xcc_id(); b.st = st;
    if (threadIdx.x == 0) (void)xb_add(&bar[XB_XCNT(b.x)], 1u);
    return b;
}
__device__ __forceinline__ void xcd_barrier_complete(unsigned* bar, unsigned x, unsigned& nloc, unsigned& nx) {
    const unsigned G = gridDim.x * gridDim.y * gridDim.z;
    unsigned sum, cnt, mine, sp = 0u;
    for (;;) {
        sum = 0u; cnt = 0u; mine = 0u;
#pragma unroll
        for (unsigned j = 0; j < 16; ++j) { const unsigned c = xb_ld(&bar[XB_XCNT(j)]); sum += c; cnt += (c > 0u) ? 1u : 0u; mine = (j == x) ? c : mine; }
        if (sum == G) break;
        __builtin_amdgcn_s_sleep(1);
        if ((++sp & 255u) == 0u) { if (xb_ld(&bar[XB_TMO])) break; if (sp > XB_SPIN_CAP) { atomicAdd(&bar[XB_TMO], 1u); break; } }
    }
    nloc = mine > 0u ? mine : 1u; nx = cnt > 0u ? cnt : 1u;
}
__device__ __forceinline__ void xcd_barrier(const XcdBarrier& b) {
    asm volatile("s_waitcnt vmcnt(0)" ::: "memory");
    __syncthreads();
    if (threadIdx.x == 0) {
        unsigned* bar = b.bar;
        __builtin_amdgcn_s_waitcnt(0);
        unsigned nloc = b.st[0], nx = b.st[1];
        if (nloc == 0u) { xcd_barrier_complete(bar, b.x, nloc, nx); b.st[0] = nloc; b.st[1] = nx; }
        const unsigned old = xb_add(&bar[XB_XSUB(b.x)], 1u);
        const unsigned gen = old / nloc;
        if (old + 1u == (gen + 1u) * nloc) {
            __builtin_amdgcn_fence(__ATOMIC_RELEASE, "agent");
            asm volatile("s_waitcnt vmcnt(0)" ::: "memory");
            const unsigned og = xb_add(&bar[XB_TOP], 1u);
            const unsigned tg = og / nx;
            if (og + 1u == (tg + 1u) * nx) xb_add(&bar[XB_TOPGEN], 1u);
            else XB_SPIN(xb_ld(&bar[XB_TOPGEN]) == tg, bar);
            __builtin_amdgcn_fence(__ATOMIC_ACQUIRE, "agent");
            xb_add(&bar[XB_XGEN(b.x)], 1u);
            asm volatile("s_waitcnt vmcnt(0)" ::: "memory");
        } else {
            XB_SPIN(xb_ld(&bar[XB_XGEN(b.x)]) == gen, bar);
            __builtin_amdgcn_fence(__ATOMIC_ACQUIRE, "agent");
            asm volatile("s_waitcnt vmcnt(0)" ::: "memory");
        }
    }
    __syncthreads();
}

struct Frame {
    LAS unsigned char* lds;
    volatile LAS unsigned* MISC;
    gu32* ctl;
    int wave;
    int vcu, G;
};

__device__ __forceinline__ int dst_row(int map, int n) {
    if (map == 1) { if (n < 1024) { const int d = n & 127; return (n & ~127) + 2 * (d & 63) + (d >> 6); } return n; }
    if (map == 2) return (n >> 7) * 256 + (n & 127);
    if (map == 3) return (n >> 7) * 256 + 128 + (n & 127);
    return n;
}
__device__ __forceinline__ void tr_item(const float* W, int N, bf16* WT, int ldw, int koff, int map, const float* gain, LAS float* scr, int item, int lane) {
    const int nblk = N / 32, kb = item / nblk, nb = item % nblk, k0 = 64 * kb, n0 = 32 * nb;
#pragma unroll 8
    for (int i = 0; i < 32; ++i) { const int kk = 2 * i + (lane >> 5); float v = W[(size_t)(k0 + kk) * N + n0 + (lane & 31)]; if (gain) v *= gain[k0 + kk]; scr[kk * 33 + (lane & 31)] = v; }
    LDS_WAIT(); asm volatile("" ::: "memory");
    const int c = lane & 7;
#pragma unroll
    for (int j = 0; j < 4; ++j) { const int n = (lane >> 3) + 8 * j; const LAS float* s = scr + (8 * c) * 33 + n;
        u32x4 o; o.x = pk2(s[0 * 33], s[1 * 33]); o.y = pk2(s[2 * 33], s[3 * 33]); o.z = pk2(s[4 * 33], s[5 * 33]); o.w = pk2(s[6 * 33], s[7 * 33]);
        *(u32x4*)(WT + (size_t)dst_row(map, n0 + n) * ldw + koff + k0 + 8 * c) = o; }
    LDS_WAIT(); asm volatile("" ::: "memory");
}

struct Args {
    const float* x; const float* w_in; const float* w_br_ret; const float* w_br_diff; const float* w_br_dil; const float* w_out;
    const float* norm_mix; const float* norm_ffn; const float* gn_gain; const float* diff_lambda; const float* subln; const float* rel_bias;
    const float* w_gate; const float* w_up; const float* w_down; const float* norm_final;
    float* out; unsigned char* ws; int ph_lo, ph_hi;
};

__device__ __forceinline__ void phase_convert(Frame& F, const Args& a, int l) {
    int tid = threadIdx.x; asm volatile("" : "+v"(tid));
    const int lane = tid & 63;
    LAS float* scr = (LAS float*)(F.lds + RING_OFF + F.wave * 16384);
    const int gw = F.vcu * NWAVES + F.wave, NGW = F.G * NWAVES;
    unsigned char* ws = a.ws;
    constexpr int I_IN = 16 * (IN_W / 32), I_BR = 16 * 32, I_BL = 8 * 32, I_O = 16 * 32, I_G = 16 * (FFN / 32), I_D = (FFN / 64) * 32;
    constexpr int NITEMS = I_IN + 2 * I_BR + I_BL + I_O + 2 * I_G + I_D;
    for (int it = gw; it < NITEMS; it += NGW) {
        int r = it; const float* W; int N; bf16* WT; int ldw, koff = 0, map = 0; const float* gain = nullptr;
        if (r < I_IN) { W = a.w_in + (size_t)l * D * IN_W; N = IN_W; WT = (bf16*)(ws + WS_WIN); ldw = D; map = 1; gain = a.norm_mix + l * D; }
        else if ((r -= I_IN) < I_BR) { W = a.w_br_ret + (size_t)l * 1024 * D; N = D; WT = (bf16*)(ws + WS_WBR); ldw = YW; }
        else if ((r -= I_BR) < I_BR) { W = a.w_br_diff + (size_t)l * 1024 * D; N = D; WT = (bf16*)(ws + WS_WBR); ldw = YW; koff = 1024; }
        else if ((r -= I_BR) < I_BL) { W = a.w_br_dil + (size_t)l * 512 * D; N = D; WT = (bf16*)(ws + WS_WBR); ldw = YW; koff = 2048; }
        else if ((r -= I_BL) < I_O) { W = a.w_out + (size_t)l * D * D; N = D; WT = (bf16*)(ws + WS_WOUT); ldw = D; }
        else if ((r -= I_O) < I_G) { W = a.w_gate + (size_t)l * D * FFN; N = FFN; WT = (bf16*)(ws + WS_WGU); ldw = D; map = 2; gain = a.norm_ffn + l * D; }
        else if ((r -= I_G) < I_G) { W = a.w_up + (size_t)l * D * FFN; N = FFN; WT = (bf16*)(ws + WS_WGU); ldw = D; map = 3; gain = a.norm_ffn + l * D; }
        else { r -= I_G; W = a.w_down + (size_t)l * FFN * D; N = D; WT = (bf16*)(ws + WS_WDN); ldw = FFN; }
        tr_item(W, N, WT, ldw, koff, map, gain, scr, r, lane);
    }
    if (l == 0) {
        bf16* XB = (bf16*)(ws + WS_XB); float* rss = (float*)(ws + WS_RSS);
        for (int m = gw; m < M; m += NGW) {
            const f32x4* xr = (const f32x4*)(a.x + (size_t)m * D) + lane;
            u32x2* o8 = (u32x2*)(XB + (size_t)m * D) + lane;
            float s = 0.f;
#pragma unroll
            for (int j = 0; j < 4; ++j) { const f32x4 v = xr[64 * j]; s += (v[0] * v[0] + v[1] * v[1]) + (v[2] * v[2] + v[3] * v[3]); u32x2 w; w.x = pk2(v[0], v[1]); w.y = pk2(v[2], v[3]); o8[64 * j] = w; }
            s = wave_sum(s);
            if (lane < 16) rss[(size_t)m * 16 + lane] = (lane == 0) ? s : 0.f;
        }
        float* cs = (float*)(ws + WS_CS);
        const int gt = F.vcu * NWAVES * 64 + tid, NT = F.G * NWAVES * 64;
        for (int idx = gt; idx < SEQ * 64; idx += NT) {
            const int pos = idx >> 6, i = idx & 63;
            const double t = (double)pos * ROPE_INV[i] * 0.15915494309189535;
            const double fr = t - floor(t);
            const float f = (float)fr;
            cs[2 * idx] = __builtin_amdgcn_cosf(f); cs[2 * idx + 1] = __builtin_amdgcn_sinf(f);
        }
        float* blut = (float*)(ws + WS_BLUT);
        for (int idx = gt; idx < 20 * 128; idx += NT) { const int h = idx >> 7, dist = idx & 127; blut[idx] = a.rel_bias[REL_BUCKET[dist] * 20 + h]; }
    }
}

__device__ __forceinline__ float dot8(const u32x4 a, const u32x4 b, float acc) {
    acc += bflo(a.x) * bflo(b.x); acc += bfhi(a.x) * bfhi(b.x); acc += bflo(a.y) * bflo(b.y); acc += bfhi(a.y) * bfhi(b.y);
    acc += bflo(a.z) * bflo(b.z); acc += bfhi(a.z) * bfhi(b.z); acc += bflo(a.w) * bflo(b.w); acc += bfhi(a.w) * bfhi(b.w);
    return acc;
}

__device__ __forceinline__ void naive_ret(Frame& F, const bf16* R, const float* gn_gain, bf16* Y) {
    LAS unsigned* qs = (LAS unsigned*)(F.lds + RING_OFF + F.wave * 1024);
    int lane_ = threadIdx.x & 63; asm volatile("" : "+v"(lane_));
    const int gw = F.vcu * NWAVES + F.wave, NGW = F.G * NWAVES, lane = lane_;
    for (int it = gw; it < M * 4; it += NGW) {
        const int bh = it & 63, t = it >> 6, b = bh >> 2, h = bh & 3;
        const size_t row = (size_t)b * SEQ + t;
        LDS_WAIT();
        qs[lane] = *(const unsigned*)(R + row * N_RET + h * 128 + 2 * lane);
        LDS_WAIT(); asm volatile("" ::: "memory");
        const float l2g = log2f(1.0f - exp2f(-5.0f - (float)h));
        float y0 = 0.f, y1 = 0.f, y2 = 0.f, y3 = 0.f;
        for (int s0 = 0; s0 <= t; s0 += 64) {
            const int s = s0 + lane; const bool valid = s <= t; const int sc = valid ? s : t;
            const u32x4* kr = (const u32x4*)(R + ((size_t)b * SEQ + sc) * N_RET + 512 + h * 128);
            float dot = 0.f;
#pragma unroll
            for (int d8 = 0; d8 < 16; ++d8) { const u32x4 q8 = *(const LAS u32x4*)(qs + d8 * 4); dot = dot8(q8, kr[d8], dot); }
            const float w = valid ? dot * exp2f((float)(t - s) * l2g) : 0.f;
            const int ns = (t - s0 + 1) < 64 ? (t - s0 + 1) : 64;
            const bf16* vb = R + ((size_t)b * SEQ + s0) * N_RET + 1024 + h * 256 + 4 * lane;
            for (int j = 0; j < ns; ++j) {
                const float wj = rdlane(w, j);
                const u32x2 v = *(const u32x2*)(vb + (size_t)j * N_RET);
                y0 += wj * bflo(v.x); y1 += wj * bfhi(v.x); y2 += wj * bflo(v.y); y3 += wj * bfhi(v.y);
            }
        }
        const float mean = wave_sum((y0 + y1) + (y2 + y3)) * (1.0f / 256.0f);
        const float d0 = y0 - mean, d1 = y1 - mean, d2 = y2 - mean, d3 = y3 - mean;
        const float var = wave_sum((d0 * d0 + d1 * d1) + (d2 * d2 + d3 * d3)) * (1.0f / 256.0f);
        const float rstd = 1.0f / sqrtf(var + 1e-5f);
        const f32x4 gg = *(const f32x4*)(gn_gain + h * 256 + 4 * lane);
        const u32x2 gv = *(const u32x2*)(R + row * N_RET + 2048 + h * 256 + 4 * lane);
        const float g0 = bflo(gv.x), g1 = bfhi(gv.x), g2 = bflo(gv.y), g3 = bfhi(gv.y);
        const float o0 = d0 * rstd * gg[0] * (g0 * sigmoidf_(g0)), o1 = d1 * rstd * gg[1] * (g1 * sigmoidf_(g1));
        const float o2 = d2 * rstd * gg[2] * (g2 * sigmoidf_(g2)), o3 = d3 * rstd * gg[3] * (g3 * sigmoidf_(g3));
        u32x2 w; w.x = pk2(o0, o1); w.y = pk2(o2, o3);
        *(u32x2*)(Y + row * YW + h * 256 + 4 * lane) = w;
    }
}

__device__ __forceinline__ void naive_diff(Frame& F, const bf16* Sd, const float* lamp, float lam_init, const float* subln, const float* blut, bf16* Y) {
    LAS unsigned* qs = (LAS unsigned*)(F.lds + RING_OFF + F.wave * 1024);
    int lane_ = threadIdx.x & 63; asm volatile("" : "+v"(lane_));
    const int gw = F.vcu * NWAVES + F.wave, NGW = F.G * NWAVES, lane = lane_;
    const float lam = __expf(wave_sum(lamp[lane] * lamp[64 + lane])) - __expf(wave_sum(lamp[128 + lane] * lamp[192 + lane])) + lam_init;
    for (int it = gw; it < M * 8; it += NGW) {
        const int bh = it & 127, t = it >> 7, b = bh >> 3, h = bh & 7;
        const size_t row = (size_t)b * SEQ + t;
        LDS_WAIT();
        qs[lane] = *(const unsigned*)(Sd + row * N_DIFF + h * 128 + 2 * lane);
        LDS_WAIT(); asm volatile("" ::: "memory");
        float om0[2], om1[2];
#pragma unroll
        for (int mm = 0; mm < 2; ++mm) {
            float mrun = -3.0e38f, l = 0.f, o0 = 0.f, o1 = 0.f;
            for (int s0 = 0; s0 <= t; s0 += 64) {
                const int s = s0 + lane; const bool valid = s <= t; const int sc = valid ? s : t;
                const u32x4* kr = (const u32x4*)(Sd + ((size_t)b * SEQ + sc) * N_DIFF + 1024 + h * 128 + mm * 64);
                float dot = 0.f;
#pragma unroll
                for (int d8 = 0; d8 < 8; ++d8) { const u32x4 q8 = *(const LAS u32x4*)(qs + mm * 32 + d8 * 4); dot = dot8(q8, kr[d8], dot); }
                const int dist = (t - sc) < 127 ? (t - sc) : 127;
                const float scv = valid ? dot * 0.125f + blut[h * 128 + dist] : -3.0e38f;
                const float mnew = fmaxf(mrun, wave_max(scv));
                const float alpha = __expf(mrun - mnew);
                const float p = valid ? __expf(scv - mnew) : 0.f;
                l = l * alpha + wave_sum(p); o0 *= alpha; o1 *= alpha; mrun = mnew;
                const int ns = (t - s0 + 1) < 64 ? (t - s0 + 1) : 64;
                const bf16* vb = Sd + ((size_t)b * SEQ + s0) * N_DIFF + 2048 + h * 128 + 2 * lane;
                for (int j = 0; j < ns; ++j) {
                    const float pj = rdlane(p, j);
                    const unsigned v = *(const unsigned*)(vb + (size_t)j * N_DIFF);
                    o0 += pj * bflo(v); o1 += pj * bfhi(v);
                }
            }
            om0[mm] = o0 / l; om1[mm] = o1 / l;
        }
        const float a0 = om0[0] - lam * om0[1], a1 = om1[0] - lam * om1[1];
        const float ms = wave_sum(a0 * a0 + a1 * a1) * (1.0f / 128.0f);
        const float rs = (1.0f / sqrtf(ms + 1e-5f)) * (1.0f - lam_init);
        *(unsigned*)(Y + row * YW + 1024 + h * 128 + 2 * lane) = pk2(a0 * rs * subln[2 * lane], a1 * rs * subln[2 * lane + 1]);
    }
}

__device__ __forceinline__ void naive_dil(Frame& F, const bf16* Sl, int g, const float* blut, float* Pn, float* Ps, bf16* Y) {
    LAS unsigned* qs = (LAS unsigned*)(F.lds + RING_OFF + F.wave * 1024);
    int lane_ = threadIdx.x & 63; asm volatile("" : "+v"(lane_));
    const int gw = F.vcu * NWAVES + F.wave, NGW = F.G * NWAVES, lane = lane_;
    const int dl = (g == 0) ? 1 : (g == 1 ? 4 : 16);
    for (int it = gw; it < M * 4; it += NGW) {
        const int bh = it & 63, t = it >> 6, b = bh >> 2, h = bh & 3;
        const size_t row = (size_t)b * SEQ + t;
        LDS_WAIT();
        qs[lane] = *(const unsigned*)(Sl + row * N_DILG + h * 128 + 2 * lane);
        LDS_WAIT(); asm volatile("" ::: "memory");
        float sc[3];
#pragma unroll
        for (int tl = 0; tl < 3; ++tl) {
            const int mi = tl * 64 + lane; const int kp = t - mi * dl; const bool valid = (mi <= 128) && (kp >= 0);
            const u32x4* kr = (const u32x4*)(Sl + ((size_t)b * SEQ + (valid ? kp : t)) * N_DILG + 512 + h * 128);
            float dot = 0.f;
#pragma unroll
            for (int d8 = 0; d8 < 16; ++d8) { const u32x4 q8 = *(const LAS u32x4*)(qs + d8 * 4); dot = dot8(q8, kr[d8], dot); }
            const int dist = (mi * dl) < 127 ? (mi * dl) : 127;
            sc[tl] = valid ? dot * 0.08838834764831845f + blut[(8 + g * 4 + h) * 128 + dist] : -3.0e38f;
        }
        float mx = wave_max(fmaxf(fmaxf(sc[0], sc[1]), sc[2]));
        float p[3], den = 0.f;
#pragma unroll
        for (int tl = 0; tl < 3; ++tl) { p[tl] = (sc[tl] > -1.0e38f) ? __expf(sc[tl] - mx) : 0.f; den += p[tl]; }
        den = wave_sum(den);
        float n0 = 0.f, n1 = 0.f;
#pragma unroll
        for (int tl = 0; tl < 3; ++tl) {
            for (int j = 0; j < 64; ++j) {
                const int mi = tl * 64 + j; const int kp = t - mi * dl;
                if (mi > 128 || kp < 0) break;
                const float pj = rdlane(p[tl], j);
                const unsigned v = *(const unsigned*)(Sl + ((size_t)b * SEQ + kp) * N_DILG + 1024 + h * 128 + 2 * lane);
                n0 += pj * bflo(v); n1 += pj * bfhi(v);
            }
        }
        float* pn = Pn + (row * 4 + h) * 128 + 2 * lane; float* ps = Ps + (row * 4 + h) * 2;
        if (g > 0) {
            const f32x2 q = *(const f32x2*)pn; const float pm = ps[0], pd = ps[1];
            const float mnew = fmaxf(mx, pm), ea = __expf(mx - mnew), eb = __expf(pm - mnew);
            n0 = ea * n0 + eb * q[0]; n1 = ea * n1 + eb * q[1]; den = ea * den + eb * pd; mx = mnew;
        }
        if (g < 2) { *(f32x2*)pn = (f32x2){n0, n1}; if (lane == 0) { ps[0] = mx; ps[1] = den; } }
        else { const float inv = 1.0f / den; *(unsigned*)(Y + row * YW + 2048 + h * 128 + 2 * lane) = pk2(n0 * inv, n1 * inv); }
    }
}


typedef short v4i16 __attribute__((ext_vector_type(4)));
constexpr int AT_PITCH = 288, AT_TILE = 64 * AT_PITCH, AT_BUF = 2 * AT_TILE, AT_LUT = 2 * AT_BUF, AT_XP = 132;
__device__ __forceinline__ bf16x8 tr16x2(const LAS unsigned char* p0, const LAS unsigned char* p1) {
    const v4i16 a = __builtin_amdgcn_ds_read_tr16_b64_v4i16((LAS v4i16*)p0), b = __builtin_amdgcn_ds_read_tr16_b64_v4i16((LAS v4i16*)p1);
    return __builtin_shufflevector(a, b, 0, 1, 2, 3, 4, 5, 6, 7);
}
__device__ __forceinline__ void diff_attn_phase(Frame& F, const bf16* Sd, const float* lamp, float lam_init, const float* subln, const float* blut, bf16* Yo) {
    int tid_ = threadIdx.x; asm volatile("" : "+v"(tid_));
    const int tid = tid_, lane = tid & 63, wave = F.wave, mw = wave >> 2, wq = wave & 3, l15 = lane & 15, kg = lane >> 4;
    LAS unsigned char* lds = F.lds;
    const float lam = __expf(wave_sum(lamp[lane] * lamp[64 + lane])) - __expf(wave_sum(lamp[128 + lane] * lamp[192 + lane])) + lam_init;
    const LAS float* lut = (const LAS float*)(lds + AT_LUT);
    for (int u = blockIdx.x; u < 2048; u += F.G) {
        const int bh = (u & 255) >> 1, hf = u & 1, jj = u >> 8;
        const int qb = hf ? (14 - 2 * jj + (jj & 1)) : (15 - 2 * jj - (jj & 1));
        const int b = bh >> 3, h = bh & 7, Q0 = qb * 128, nt = Q0 / 64 + 2;
        const int qw = Q0 + 32 * wq;
        __syncthreads();
        if (tid < 128) ((LAS float*)(lds + AT_LUT))[tid] = blut[h * 128 + tid] * 1.4426950408889634f;
        const bf16* base = Sd + (size_t)b * SEQ * N_DIFF + h * 128;
        bf16x8 qf[2][2];
#pragma unroll
        for (int g = 0; g < 2; ++g)
#pragma unroll
            for (int ks = 0; ks < 2; ++ks) qf[g][ks] = *(const bf16x8*)(base + (size_t)(qw + 16 * g + l15) * N_DIFF + mw * 64 + 32 * ks + 8 * kg);
        const int sr0 = tid >> 4, sc = tid & 15;
        const bf16* kg0 = base + (size_t)sr0 * N_DIFF + 1024 + sc * 8;
        const int sl0 = sr0 * AT_PITCH + sc * 16;
        u32x4 kr[2], vr[2];
#pragma unroll
        for (int i = 0; i < 2; ++i) { kr[i] = *(const u32x4*)(kg0 + (size_t)(32 * i) * N_DIFF); vr[i] = *(const u32x4*)(kg0 + (size_t)(32 * i) * N_DIFF + 1024); }
#pragma unroll
        for (int i = 0; i < 2; ++i) { *(LAS u32x4*)(lds + sl0 + 32 * i * AT_PITCH) = kr[i]; *(LAS u32x4*)(lds + AT_TILE + sl0 + 32 * i * AT_PITCH) = vr[i]; }
        __syncthreads();
        f32x4 O[2][8]; float mrun[2], lsum[2];
#pragma unroll
        for (int g = 0; g < 2; ++g) { mrun[g] = -1.0e30f; lsum[g] = 0.f;
#pragma unroll
            for (int eb = 0; eb < 8; ++eb) O[g][eb] = (f32x4){0.f, 0.f, 0.f, 0.f}; }
        const float c31 = lut[127];
        for (int t = 0; t < nt; ++t) {
            const int k0 = t * 64;
            const bool more = (t + 1 < nt);
            if (more) {
#pragma unroll
                for (int i = 0; i < 2; ++i) { kr[i] = *(const u32x4*)(kg0 + (size_t)(k0 + 64 + 32 * i) * N_DIFF); vr[i] = *(const u32x4*)(kg0 + (size_t)(k0 + 64 + 32 * i) * N_DIFF + 1024); }
            }
            const LAS unsigned char* Kt = lds + (t & 1) * AT_BUF;
            const LAS unsigned char* Vt = Kt + AT_TILE;
            if (k0 <= qw + 31) {
                f32x4 Sx[2][4];
#pragma unroll
                for (int g = 0; g < 2; ++g)
#pragma unroll
                    for (int kb = 0; kb < 4; ++kb) Sx[g][kb] = (f32x4){0.f, 0.f, 0.f, 0.f};
#pragma unroll
                for (int kb = 0; kb < 4; ++kb)
#pragma unroll
                    for (int ks = 0; ks < 2; ++ks) {
                        const bf16x8 kf = *(const LAS bf16x8*)(Kt + (16 * kb + l15) * AT_PITCH + mw * 128 + ks * 64 + kg * 16);
#pragma unroll
                        for (int g = 0; g < 2; ++g) Sx[g][kb] = __builtin_amdgcn_mfma_f32_16x16x32_bf16(kf, qf[g][ks], Sx[g][kb], 0, 0, 0);
                    }
                const bool nearT = (qw - k0 - 63) < 113;
                bf16x8 pf[2][2];
#pragma unroll
                for (int g = 0; g < 2; ++g) {
                    const int qpos = qw + 16 * g + l15;
                    if (nearT) {
#pragma unroll
                        for (int kb = 0; kb < 4; ++kb)
#pragma unroll
                            for (int r = 0; r < 4; ++r) {
                                const int dist = qpos - (k0 + 16 * kb + 4 * kg + r);
                                const float bv = lut[dist < 0 ? 0 : (dist > 127 ? 127 : dist)];
                                Sx[g][kb][r] = (dist < 0) ? -1.0e30f : Sx[g][kb][r] + bv;
                            }
                    } else {
#pragma unroll
                        for (int kb = 0; kb < 4; ++kb) Sx[g][kb] = Sx[g][kb] + c31;
                    }
                    float mx = fmaxf(fmaxf(Sx[g][0][0], Sx[g][0][1]), fmaxf(Sx[g][0][2], Sx[g][0][3]));
#pragma unroll
                    for (int kb = 1; kb < 4; ++kb) mx = fmaxf(mx, fmaxf(fmaxf(Sx[g][kb][0], Sx[g][kb][1]), fmaxf(Sx[g][kb][2], Sx[g][kb][3])));
                    mx = fmaxf(mx, __shfl_xor(mx, 16)); mx = fmaxf(mx, __shfl_xor(mx, 32));
                    const float mnew = fmaxf(mrun[g], mx), alpha = exp2f(mrun[g] - mnew);
                    mrun[g] = mnew;
                    float ps = 0.f;
#pragma unroll
                    for (int kb = 0; kb < 4; ++kb)
#pragma unroll
                        for (int r = 0; r < 4; ++r) { const float p = exp2f(Sx[g][kb][r] - mnew); Sx[g][kb][r] = p; ps += p; }
                    lsum[g] = lsum[g] * alpha + ps;
#pragma unroll
                    for (int eb = 0; eb < 8; ++eb) O[g][eb] = O[g][eb] * alpha;
#pragma unroll
                    for (int c = 0; c < 2; ++c) {
                        u32x4 w; w.x = pk2(Sx[g][2 * c][0], Sx[g][2 * c][1]); w.y = pk2(Sx[g][2 * c][2], Sx[g][2 * c][3]);
                        w.z = pk2(Sx[g][2 * c + 1][0], Sx[g][2 * c + 1][1]); w.w = pk2(Sx[g][2 * c + 1][2], Sx[g][2 * c + 1][3]);
                        pf[g][c] = __builtin_bit_cast(bf16x8, w);
                    }
                }
                const LAS unsigned char* vb = Vt + (4 * kg + (l15 >> 2)) * AT_PITCH + (l15 & 3) * 8;
#pragma unroll
                for (int eb = 0; eb < 8; ++eb)
#pragma unroll
                    for (int c = 0; c < 2; ++c) {
                        const bf16x8 vf = tr16x2(vb + (32 * c) * AT_PITCH + eb * 32, vb + (32 * c + 16) * AT_PITCH + eb * 32);
#pragma unroll
                        for (int g = 0; g < 2; ++g) O[g][eb] = __builtin_amdgcn_mfma_f32_16x16x32_bf16(vf, pf[g][c], O[g][eb], 0, 0, 0);
                    }
            }
            if (more) {
                LAS unsigned char* nb = lds + ((t + 1) & 1) * AT_BUF;
#pragma unroll
                for (int i = 0; i < 2; ++i) { *(LAS u32x4*)(nb + sl0 + 32 * i * AT_PITCH) = kr[i]; *(LAS u32x4*)(nb + AT_TILE + sl0 + 32 * i * AT_PITCH) = vr[i]; }
            }
            __syncthreads();
        }
#pragma unroll
        for (int g = 0; g < 2; ++g) {
            float l = lsum[g]; l += __shfl_xor(l, 16); l += __shfl_xor(l, 32);
            const float inv = 1.0f / l;
#pragma unroll
            for (int eb = 0; eb < 8; ++eb) O[g][eb] = O[g][eb] * inv;
        }
        LAS float* ex = (LAS float*)lds + wq * 32 * AT_XP;
        if (mw == 1) {
#pragma unroll
            for (int g = 0; g < 2; ++g)
#pragma unroll
                for (int eb = 0; eb < 8; ++eb) *(LAS f32x4*)(ex + (16 * g + l15) * AT_XP + 16 * eb + 4 * kg) = O[g][eb];
        }
        __syncthreads();
        if (mw == 0) {
#pragma unroll
            for (int g = 0; g < 2; ++g) {
                float ss = 0.f;
#pragma unroll
                for (int eb = 0; eb < 8; ++eb) { const f32x4 o1 = *(const LAS f32x4*)(ex + (16 * g + l15) * AT_XP + 16 * eb + 4 * kg); const f32x4 a = O[g][eb] - o1 * lam; O[g][eb] = a;
                    ss += (a[0] * a[0] + a[1] * a[1]) + (a[2] * a[2] + a[3] * a[3]); }
                ss += __shfl_xor(ss, 16); ss += __shfl_xor(ss, 32);
                const float rs = (1.0f / sqrtf(ss * (1.0f / 128.0f) + 1e-5f)) * (1.0f - lam_init);
                bf16* orow = Yo + ((size_t)b * SEQ + qw + 16 * g + l15) * YW + 1024 + h * 128 + 4 * kg;
#pragma unroll
                for (int eb = 0; eb < 8; ++eb) { const f32x4 gq = *(const f32x4*)(subln + 16 * eb + 4 * kg); const f32x4 a = O[g][eb] * rs * gq;
                    u32x2 w; w.x = pk2(a[0], a[1]); w.y = pk2(a[2], a[3]); *(u32x2*)(orow + 16 * eb) = w; }
            }
        }
    }
    __syncthreads();
}


__device__ __forceinline__ void dil_attn_phase(Frame& F, const bf16* Sl, int g, const float* blut, float* Lse, bf16* Yo) {
    int tid_ = threadIdx.x; asm volatile("" : "+v"(tid_));
    const int tid = tid_, lane = tid & 63, wave = F.wave, l15 = lane & 15, kg = lane >> 4;
    const int dl = (g == 0) ? 1 : (g == 1 ? 4 : 16);
    LAS unsigned char* lds = F.lds;
    const LAS float* lut = (const LAS float*)(lds + AT_LUT);
    const int tlo = wave >> 2, thi = tlo + 2;
    for (int u = blockIdx.x; u < 1024; u += F.G) {
        const int bh = u & 63, idx = u >> 6, b = bh >> 2, h = bh & 3, r = idx % dl, nbi = idx / dl;
        __syncthreads();
        if (tid < 128) ((LAS float*)(lds + AT_LUT))[tid] = blut[(8 + g * 4 + h) * 128 + tid] * 1.4426950408889634f;
        const bf16* base = Sl + (size_t)b * SEQ * N_DILG + h * 128;
        const int qi = 16 * wave + l15;
        const int qpos = (nbi * 128 + qi) * dl + r;
        bf16x8 qf[4];
#pragma unroll
        for (int ks = 0; ks < 4; ++ks) qf[ks] = *(const bf16x8*)(base + (size_t)qpos * N_DILG + 32 * ks + 8 * kg);
        const int t0 = (nbi == 0) ? 2 : 0;
        const int sr0 = tid >> 4, sc = tid & 15;
        const int sl0 = sr0 * AT_PITCH + sc * 16;
        const bf16* kbase = base + 512 + sc * 8;
        const int krow0 = ((nbi - 1) * 128 + sr0) * dl + r, kstep32 = 32 * dl;
#define DIL_KPTR(j) (kbase + (size_t)(krow0 + (j) * kstep32) * N_DILG)
        u32x4 kr[2], vr[2];
#pragma unroll
        for (int i = 0; i < 2; ++i) { kr[i] = *(const u32x4*)DIL_KPTR(2 * t0 + i); vr[i] = *(const u32x4*)(DIL_KPTR(2 * t0 + i) + 512); }
        {
            LAS unsigned char* nb = lds + (t0 & 1) * AT_BUF;
#pragma unroll
            for (int i = 0; i < 2; ++i) { *(LAS u32x4*)(nb + sl0 + 32 * i * AT_PITCH) = kr[i]; *(LAS u32x4*)(nb + AT_TILE + sl0 + 32 * i * AT_PITCH) = vr[i]; }
        }
        __syncthreads();
        f32x4 O[8]; float mrun = -1.0e30f, lsum = 0.f;
#pragma unroll
        for (int eb = 0; eb < 8; ++eb) O[eb] = (f32x4){0.f, 0.f, 0.f, 0.f};
        for (int tt = t0; tt < 4; ++tt) {
            const bool more = (tt + 1 < 4);
            if (more) {
#pragma unroll
                for (int i = 0; i < 2; ++i) { kr[i] = *(const u32x4*)DIL_KPTR(2 * (tt + 1) + i); vr[i] = *(const u32x4*)(DIL_KPTR(2 * (tt + 1) + i) + 512); }
            }
            const LAS unsigned char* Kt = lds + (tt & 1) * AT_BUF;
            const LAS unsigned char* Vt = Kt + AT_TILE;
            if (tt >= tlo && tt <= thi) {
                f32x4 Sx[4];
#pragma unroll
                for (int kb = 0; kb < 4; ++kb) Sx[kb] = (f32x4){0.f, 0.f, 0.f, 0.f};
#pragma unroll
                for (int kb = 0; kb < 4; ++kb)
#pragma unroll
                    for (int ks = 0; ks < 4; ++ks) {
                        const bf16x8 kf = *(const LAS bf16x8*)(Kt + (16 * kb + l15) * AT_PITCH + ks * 64 + kg * 16);
                        Sx[kb] = __builtin_amdgcn_mfma_f32_16x16x32_bf16(kf, qf[ks], Sx[kb], 0, 0, 0);
                    }
#pragma unroll
                for (int kb = 0; kb < 4; ++kb)
#pragma unroll
                    for (int rr = 0; rr < 4; ++rr) {
                        const int m = qi + 128 - (64 * tt + 16 * kb + 4 * kg + rr);
                        const bool valid = (m >= 0) && (m <= 128);
                        const int di = m * dl;
                        const float bv = lut[!valid ? 0 : (di > 127 ? 127 : di)];
                        Sx[kb][rr] = valid ? Sx[kb][rr] + bv : -1.0e30f;
                    }
                float mx = fmaxf(fmaxf(Sx[0][0], Sx[0][1]), fmaxf(Sx[0][2], Sx[0][3]));
#pragma unroll
                for (int kb = 1; kb < 4; ++kb) mx = fmaxf(mx, fmaxf(fmaxf(Sx[kb][0], Sx[kb][1]), fmaxf(Sx[kb][2], Sx[kb][3])));
                mx = fmaxf(mx, __shfl_xor(mx, 16)); mx = fmaxf(mx, __shfl_xor(mx, 32));
                const float mnew = fmaxf(mrun, mx), alpha = exp2f(mrun - mnew);
                mrun = mnew;
                float ps = 0.f;
#pragma unroll
                for (int kb = 0; kb < 4; ++kb)
#pragma unroll
                    for (int rr = 0; rr < 4; ++rr) { const float p = (Sx[kb][rr] < -1.0e29f) ? 0.f : exp2f(Sx[kb][rr] - mnew); Sx[kb][rr] = p; ps += p; }
                lsum = lsum * alpha + ps;
#pragma unroll
                for (int eb = 0; eb < 8; ++eb) O[eb] = O[eb] * alpha;
                bf16x8 pf[2];
#pragma unroll
                for (int c = 0; c < 2; ++c) {
                    u32x4 w; w.x = pk2(Sx[2 * c][0], Sx[2 * c][1]); w.y = pk2(Sx[2 * c][2], Sx[2 * c][3]);
                    w.z = pk2(Sx[2 * c + 1][0], Sx[2 * c + 1][1]); w.w = pk2(Sx[2 * c + 1][2], Sx[2 * c + 1][3]);
                    pf[c] = __builtin_bit_cast(bf16x8, w);
                }
                const LAS unsigned char* vb = Vt + (4 * kg + (l15 >> 2)) * AT_PITCH + (l15 & 3) * 8;
#pragma unroll
                for (int eb = 0; eb < 8; ++eb)
#pragma unroll
                    for (int c = 0; c < 2; ++c) {
                        const bf16x8 vf = tr16x2(vb + (32 * c) * AT_PITCH + eb * 32, vb + (32 * c + 16) * AT_PITCH + eb * 32);
                        O[eb] = __builtin_amdgcn_mfma_f32_16x16x32_bf16(vf, pf[c], O[eb], 0, 0, 0);
                    }
            }
            if (more) {
                LAS unsigned char* nb = lds + ((tt + 1) & 1) * AT_BUF;
#pragma unroll
                for (int i = 0; i < 2; ++i) { *(LAS u32x4*)(nb + sl0 + 32 * i * AT_PITCH) = kr[i]; *(LAS u32x4*)(nb + AT_TILE + sl0 + 32 * i * AT_PITCH) = vr[i]; }
            }
            __syncthreads();
        }
        float l = lsum; l += __shfl_xor(l, 16); l += __shfl_xor(l, 32);
        float inv = 1.0f / l, lse = mrun + log2f(l);
        const size_t row = (size_t)b * SEQ + qpos;
        bf16* orow = Yo + row * YW + 2048 + h * 128 + 4 * kg;
        float wa = inv, wb = 0.f;
        if (g > 0) {
            const float lp = Lse[row * 4 + h];
            const float mm = fmaxf(lse, lp), ea = exp2f(lse - mm), eb_ = exp2f(lp - mm), tot = ea + eb_;
            wa = inv * ea / tot; wb = eb_ / tot; lse = mm + log2f(tot);
        }
#pragma unroll
        for (int eb = 0; eb < 8; ++eb) {
            f32x4 a = O[eb] * wa;
            if (g > 0) { const u32x2 p = *(const u32x2*)(orow + 16 * eb); a[0] += wb * bflo(p.x); a[1] += wb * bfhi(p.x); a[2] += wb * bflo(p.y); a[3] += wb * bfhi(p.y); }
            u32x2 w; w.x = pk2(a[0], a[1]); w.y = pk2(a[2], a[3]); *(u32x2*)(orow + 16 * eb) = w;
        }
        if (g < 2 && kg == 0) Lse[row * 4 + h] = lse;
    }
#undef DIL_KPTR
    __syncthreads();
}


constexpr int RT_VP = 544, RT_KT = 64 * AT_PITCH, RT_BUF = RT_KT + 64 * RT_VP;
__device__ __forceinline__ void ret_phase(Frame& F, const bf16* R, const float* gn_gain, bf16* Yo) {
    int tid_ = threadIdx.x; asm volatile("" : "+v"(tid_));
    const int tid = tid_, lane = tid & 63, wave = F.wave, l15 = lane & 15, kg = lane >> 4;
    LAS unsigned char* lds = F.lds;
    for (int u = blockIdx.x; u < 1024; u += F.G) {
        const int bh = (u & 255) >> 2, qt = u & 3, jj = u >> 8;
        const int qb = (jj == 0) ? (15 - qt) : (jj == 1) ? (8 + qt) : (jj == 2) ? (7 - qt) : qt;
        const int b = bh >> 2, h = bh & 3, Q0 = qb * 128, nt = Q0 / 64 + 2;
        const int qw = Q0 + 16 * wave, tq = qw + l15;
        const float l2g = log2f(1.0f - exp2f(-5.0f - (float)h));
        const bf16* base = R + (size_t)b * SEQ * N_RET;
        bf16x8 qf[4];
#pragma unroll
        for (int ks = 0; ks < 4; ++ks) qf[ks] = *(const bf16x8*)(base + (size_t)tq * N_RET + h * 128 + 32 * ks + 8 * kg);
        const int sr0 = tid >> 4, sc = tid & 15;
        const int vr0 = tid >> 5, vc = tid & 31;
        const bf16* kgp = base + (size_t)sr0 * N_RET + 512 + h * 128 + sc * 8;
        const bf16* vgp = base + (size_t)vr0 * N_RET + 1024 + h * 256 + vc * 8;
        const int ksl = sr0 * AT_PITCH + sc * 16, vsl = RT_KT + vr0 * RT_VP + vc * 16;
        u32x4 kr[2], vr[4];
#pragma unroll
        for (int i = 0; i < 2; ++i) kr[i] = *(const u32x4*)(kgp + (size_t)(32 * i) * N_RET);
#pragma unroll
        for (int i = 0; i < 4; ++i) vr[i] = *(const u32x4*)(vgp + (size_t)(16 * i) * N_RET);
        __syncthreads();
#pragma unroll
        for (int i = 0; i < 2; ++i) *(LAS u32x4*)(lds + ksl + 32 * i * AT_PITCH) = kr[i];
#pragma unroll
        for (int i = 0; i < 4; ++i) *(LAS u32x4*)(lds + vsl + 16 * i * RT_VP) = vr[i];
        __syncthreads();
        f32x4 O[16];
#pragma unroll
        for (int eb = 0; eb < 16; ++eb) O[eb] = (f32x4){0.f, 0.f, 0.f, 0.f};
        for (int t = 0; t < nt; ++t) {
            const int k0 = t * 64;
            const bool more = (t + 1 < nt);
            if (more) {
#pragma unroll
                for (int i = 0; i < 2; ++i) kr[i] = *(const u32x4*)(kgp + (size_t)(k0 + 64 + 32 * i) * N_RET);
#pragma unroll
                for (int i = 0; i < 4; ++i) vr[i] = *(const u32x4*)(vgp + (size_t)(k0 + 64 + 16 * i) * N_RET);
            }
            const LAS unsigned char* Kt = lds + (t & 1) * RT_BUF;
            const LAS unsigned char* Vt = Kt + RT_KT;
            if (k0 <= qw + 15) {
                f32x4 Sx[4];
#pragma unroll
                for (int kb = 0; kb < 4; ++kb) Sx[kb] = (f32x4){0.f, 0.f, 0.f, 0.f};
#pragma unroll
                for (int kb = 0; kb < 4; ++kb)
#pragma unroll
                    for (int ks = 0; ks < 4; ++ks) {
                        const bf16x8 kf = *(const LAS bf16x8*)(Kt + (16 * kb + l15) * AT_PITCH + ks * 64 + kg * 16);
                        Sx[kb] = __builtin_amdgcn_mfma_f32_16x16x32_bf16(kf, qf[ks], Sx[kb], 0, 0, 0);
                    }
#pragma unroll
                for (int kb = 0; kb < 4; ++kb)
#pragma unroll
                    for (int rr = 0; rr < 4; ++rr) {
                        const int dist = tq - (k0 + 16 * kb + 4 * kg + rr);
                        const float w = exp2f((float)dist * l2g);
                        Sx[kb][rr] = (dist >= 0) ? Sx[kb][rr] * w : 0.f;
                    }
                bf16x8 pf[2];
#pragma unroll
                for (int c = 0; c < 2; ++c) {
                    u32x4 w; w.x = pk2(Sx[2 * c][0], Sx[2 * c][1]); w.y = pk2(Sx[2 * c][2], Sx[2 * c][3]);
                    w.z = pk2(Sx[2 * c + 1][0], Sx[2 * c + 1][1]); w.w = pk2(Sx[2 * c + 1][2], Sx[2 * c + 1][3]);
                    pf[c] = __builtin_bit_cast(bf16x8, w);
                }
                const LAS unsigned char* vb = Vt + (4 * kg + (l15 >> 2)) * RT_VP + (l15 & 3) * 8;
#pragma unroll
                for (int eb = 0; eb < 16; ++eb)
#pragma unroll
                    for (int c = 0; c < 2; ++c) {
                        const bf16x8 vf = tr16x2(vb + (32 * c) * RT_VP + eb * 32, vb + (32 * c + 16) * RT_VP + eb * 32);
                        O[eb] = __builtin_amdgcn_mfma_f32_16x16x32_bf16(vf, pf[c], O[eb], 0, 0, 0);
                    }
            }
            if (more) {
                LAS unsigned char* nb = lds + ((t + 1) & 1) * RT_BUF;
#pragma unroll
                for (int i = 0; i < 2; ++i) *(LAS u32x4*)(nb + ksl + 32 * i * AT_PITCH) = kr[i];
#pragma unroll
                for (int i = 0; i < 4; ++i) *(LAS u32x4*)(nb + vsl + 16 * i * RT_VP) = vr[i];
            }
            __syncthreads();
        }
        float sm = 0.f;
#pragma unroll
        for (int eb = 0; eb < 16; ++eb) sm += (O[eb][0] + O[eb][1]) + (O[eb][2] + O[eb][3]);
        sm += __shfl_xor(sm, 16); sm += __shfl_xor(sm, 32);
        const float mean = sm * (1.0f / 256.0f);
        float sq = 0.f;
#pragma unroll
        for (int eb = 0; eb < 16; ++eb) { O[eb] = O[eb] - mean; sq += (O[eb][0] * O[eb][0] + O[eb][1] * O[eb][1]) + (O[eb][2] * O[eb][2] + O[eb][3] * O[eb][3]); }
        sq += __shfl_xor(sq, 16); sq += __shfl_xor(sq, 32);
        const float rstd = 1.0f / sqrtf(sq * (1.0f / 256.0f) + 1e-5f);
        const size_t row = (size_t)b * SEQ + tq;
        const bf16* grow = R + row * N_RET + 2048 + h * 256 + 4 * kg;
        bf16* orow = Yo + row * YW + h * 256 + 4 * kg;
        const float* gg = gn_gain + h * 256 + 4 * kg;
#pragma unroll
        for (int eb = 0; eb < 16; ++eb) {
            const f32x4 gq = *(const f32x4*)(gg + 16 * eb);
            const u32x2 gv = *(const u32x2*)(grow + 16 * eb);
            const float g0 = bflo(gv.x), g1 = bfhi(gv.x), g2 = bflo(gv.y), g3 = bfhi(gv.y);
            const float o0 = O[eb][0] * rstd * gq[0] * (g0 * sigmoidf_(g0)), o1 = O[eb][1] * rstd * gq[1] * (g1 * sigmoidf_(g1));
            const float o2 = O[eb][2] * rstd * gq[2] * (g2 * sigmoidf_(g2)), o3 = O[eb][3] * rstd * gq[3] * (g3 * sigmoidf_(g3));
            u32x2 w; w.x = pk2(o0, o1); w.y = pk2(o2, o3);
            *(u32x2*)(orow + 16 * eb) = w;
        }
    }
    __syncthreads();
}

__device__ __forceinline__ void phase_final(Frame& F, float* out, const float* gain) {
    int lane = threadIdx.x & 63; asm volatile("" : "+v"(lane));
    const int gw = F.vcu * NWAVES + F.wave, NGW = F.G * NWAVES;
    for (int m = gw; m < M; m += NGW) {
        f32x4* xr = (f32x4*)(out + (size_t)m * D) + lane;
        f32x4 v[4]; float s = 0.f;
#pragma unroll
        for (int j = 0; j < 4; ++j) { v[j] = xr[64 * j]; s += (v[j][0] * v[j][0] + v[j][1] * v[j][1]) + (v[j][2] * v[j][2] + v[j][3] * v[j][3]); }
        const float rs = 1.0f / sqrtf(wave_sum(s) * (1.0f / D) + 1e-6f);
#pragma unroll
        for (int j = 0; j < 4; ++j) { const f32x4 gq = *((const f32x4*)gain + lane + 64 * j); xr[64 * j] = v[j] * rs * gq; }
    }
}

constexpr int PH_PER_LAYER = 17;
constexpr int N_PHASES = DEPTH * PH_PER_LAYER + 1;

__global__ void __launch_bounds__(NWAVES * 64, 2) mk_fwd(Args args) {
    extern __shared__ __attribute__((aligned(16))) unsigned char lds[];
    Frame F;
    F.lds = (LAS unsigned char*)lds;
    F.MISC = (volatile LAS unsigned*)(F.lds + MISC_OFF);
    F.wave = __builtin_amdgcn_readfirstlane((int)threadIdx.x >> 6);
    F.G = gridDim.x; { const int bx = blockIdx.x; F.vcu = (F.G % 8 == 0) ? (bx % 8) * (F.G / 8) + bx / 8 : bx; }
    unsigned char* ws = args.ws;
    F.ctl = (gu32*)(ws + WS_CTL);
    for (int u = threadIdx.x; u < (LDS_BYTES - LDSCTL_OFF) / 4; u += NWAVES * 64) ((LAS unsigned*)(F.lds + LDSCTL_OFF))[u] = 0u;
    __syncthreads();
#if MK_PER_PHASE
#define GRID_BAR() do { } while (0)
#else
    XcdBarrier bar = xcd_barrier_post((unsigned*)(F.ctl + CW_BAR), F.MISC + 8);
#define GRID_BAR() xcd_barrier(bar)
#endif
    const int lo = args.ph_lo, hi = args.ph_hi;
    int ph = 0;
#define PHASE_BEGIN if (ph >= lo && ph < hi) {
#define PHASE_END   if (ph + 1 < hi) GRID_BAR(); } ++ph;

#define WIN ((bf16*)(ws + WS_WIN))
#define WBR ((bf16*)(ws + WS_WBR))
#define WOUT ((bf16*)(ws + WS_WOUT))
#define WGU ((bf16*)(ws + WS_WGU))
#define WDN ((bf16*)(ws + WS_WDN))
#define XB ((bf16*)(ws + WS_XB))
#define Y ((bf16*)(ws + WS_Y))
#define S ((bf16*)(ws + WS_S))
#define XB2 ((bf16*)(ws + WS_XB2))
#define HID ((bf16*)(ws + WS_HID))
#define RSS ((float*)(ws + WS_RSS))
#define CS ((const float*)(ws + WS_CS))
#define BLUT ((const float*)(ws + WS_BLUT))
#define DILP ((float*)(ws + WS_DILP))
#define DILS ((float*)(ws + WS_DILS))

    for (int l = 0; l < DEPTH; ++l) {
        PHASE_BEGIN if (EN_CONV) phase_convert(F, args, l); PHASE_END

        for (int sub = 0; sub < 6; ++sub) {
            const int coff = (sub == 0) ? C_RET : (sub == 1) ? C_DIFF : (sub <= 4) ? (C_DIL + (sub - 2) * N_DILG) : C_GATE;
            const int nsub = (sub >= 2 && sub <= 4) ? N_DILG : 3072;
            PHASE_BEGIN {
                pg8::Gemm g{XB, WIN + (size_t)coff * D, D, D, M, nsub, D}; pg8::StaticOrder So; So.init(M, nsub, F.G, (int)blockIdx.x);
                pg8::EpiIn E{S, nsub, RSS, CS, (sub == 0) ? 1 : (sub == 5 ? 2 : ((sub == 1 && DIFF_MFMA) ? 3 : ((sub >= 2 && sub <= 4 && DIL_MFMA) ? 4 : 0)))};
                if (EN_IN) pg8::gemm_phase<pg8::EpiIn, pg8::StaticOrder, true>(F.lds + RING_OFF, g, So, E);
            } PHASE_END
            if (sub == 0) {
#if RET_MFMA
                PHASE_BEGIN if (EN_RET) ret_phase(F, S, args.gn_gain + l * 1024, Y); PHASE_END
#else
                PHASE_BEGIN if (EN_RET) naive_ret(F, S, args.gn_gain + l * 1024, Y); PHASE_END
#endif
                PHASE_BEGIN PHASE_END
            } else if (sub == 1) {
                const float lam_init = (l == 0) ? 0.2f : 0.35550906759096934f;
#if DIFF_MFMA
                PHASE_BEGIN if (EN_DIFF) diff_attn_phase(F, S, args.diff_lambda + l * 256, lam_init, args.subln + l * 128, BLUT, Y); PHASE_END
#else
                PHASE_BEGIN if (EN_DIFF) naive_diff(F, S, args.diff_lambda + l * 256, lam_init, args.subln + l * 128, BLUT, Y); PHASE_END
#endif
            } else if (sub <= 4) {
#if DIL_MFMA
                PHASE_BEGIN if (EN_DIL) dil_attn_phase(F, S, sub - 2, BLUT, DILS, Y); PHASE_END
#else
                PHASE_BEGIN if (EN_DIL) naive_dil(F, S, sub - 2, BLUT, DILP, DILS, Y); PHASE_END
#endif
            }
        }
        PHASE_BEGIN {
            pg8::Gemm g{Y, WBR, YW, YW, M, D, D}; pg8::SegOrder So; So.init(M, D, F.G, (int)blockIdx.x);
            pg8::EpiMerge E{XB, S};
            if (EN_MERGE) pg8::gemm_phase<pg8::EpiMerge, pg8::SegOrder, true>(F.lds + RING_OFF, g, So, E);
        } PHASE_END
        PHASE_BEGIN {
            pg8::Gemm g{XB, WOUT, D, D, M, D, D}; pg8::StaticOrder So; So.init(M, D, F.G, (int)blockIdx.x);
            pg8::EpiRes E{(l == 0) ? args.x : args.out, args.out, XB2, RSS};
            if (EN_OUT) pg8::gemm_phase<pg8::EpiRes, pg8::StaticOrder, true>(F.lds + RING_OFF, g, So, E);
        } PHASE_END
        PHASE_BEGIN {
            pg8::Gemm g{XB2, WGU, D, D, M, 2 * FFN, D}; pg8::StaticOrder So; So.init(M, 2 * FFN, F.G, (int)blockIdx.x);
            pg8::EpiSwiGLU E{HID, RSS};
            if (EN_UP) pg8::gemm_phase<pg8::EpiSwiGLU, pg8::StaticOrder, true>(F.lds + RING_OFF, g, So, E);
        } PHASE_END
        PHASE_BEGIN {
            pg8::Gemm g{HID, WDN, FFN, FFN, M, D, FFN}; pg8::StaticOrder So; So.init(M, D, F.G, (int)blockIdx.x);
            pg8::EpiRes E{args.out, args.out, XB, RSS};
            if (EN_DOWN) pg8::gemm_phase<pg8::EpiRes, pg8::StaticOrder, true>(F.lds + RING_OFF, g, So, E);
        } PHASE_END
    }
    PHASE_BEGIN if (EN_FIN) phase_final(F, args.out, args.norm_final); PHASE_END
#undef PHASE_BEGIN
#undef PHASE_END
}

extern "C" void kernel_launch(void* const* d_in, const int* in_sizes, int n_in, void* d_out, int out_size, void* d_ws, size_t ws_size, hipStream_t stream) {
    static int grid = 0;
    if (grid == 0) {
        if (n_in != 16 || in_sizes[0] != M * D || out_size != M * D || ws_size < WS_END) { fprintf(stderr, "kernel_launch: unexpected shapes (n_in %d, ws %zu)\n", n_in, ws_size); grid = -1; return; }
        int dev = 0, cus = 0, per_cu = 0;
        if (hipGetDevice(&dev) != hipSuccess || hipDeviceGetAttribute(&cus, hipDeviceAttributeMultiprocessorCount, dev) != hipSuccess) { grid = -1; return; }
        if (hipFuncSetAttribute((const void*)mk_fwd, hipFuncAttributeMaxDynamicSharedMemorySize, LDS_BYTES) != hipSuccess) { grid = -1; return; }
        if (hipOccupancyMaxActiveBlocksPerMultiprocessor(&per_cu, (const void*)mk_fwd, NWAVES * 64, LDS_BYTES) != hipSuccess || per_cu < 1) { fprintf(stderr, "kernel_launch: occupancy query says %d\n", per_cu); }
        (void)hipGetLastError();
        grid = cus;
    }
    if (grid < 0) return;
    if (hipMemsetAsync((char*)d_ws + WS_CTL, 0, CTL_ZERO_BYTES, stream) != hipSuccess) return;
    Args a{};
    a.x = (const float*)d_in[0]; a.w_in = (const float*)d_in[1]; a.w_br_ret = (const float*)d_in[2]; a.w_br_diff = (const float*)d_in[3]; a.w_br_dil = (const float*)d_in[4];
    a.w_out = (const float*)d_in[5]; a.norm_mix = (const float*)d_in[6]; a.norm_ffn = (const float*)d_in[7]; a.gn_gain = (const float*)d_in[8]; a.diff_lambda = (const float*)d_in[9];
    a.subln = (const float*)d_in[10]; a.rel_bias = (const float*)d_in[11]; a.w_gate = (const float*)d_in[12]; a.w_up = (const float*)d_in[13]; a.w_down = (const float*)d_in[14];
    a.norm_final = (const float*)d_in[15];
    a.out = (float*)d_out; a.ws = (unsigned char*)d_ws;
#if MK_PER_PHASE
    for (int p = 0; p < N_PHASES; ++p) {
        if (p % PH_PER_LAYER == 3 && p < DEPTH * PH_PER_LAYER) continue;
        a.ph_lo = p; a.ph_hi = p + 1;
        hipLaunchKernelGGL(mk_fwd, dim3(grid), dim3(NWAVES * 64), LDS_BYTES, stream, a);
    }
#else
    a.ph_lo = 0; a.ph_hi = N_PHASES;
    hipLaunchKernelGGL(mk_fwd, dim3(grid), dim3(NWAVES * 64), LDS_BYTES, stream, a);
#endif
}
```

```cpp
#include <hip/hip_runtime.h>
#include <cstdio>
#include <cstdint>

#ifndef MK_PER_PHASE
#define MK_PER_PHASE 0
#endif


#ifndef DIFF_MFMA
#define DIFF_MFMA 1
#endif
#ifndef DIL_MFMA
#define DIL_MFMA 1
#endif
#ifndef RET_MFMA
#define RET_MFMA 1
#endif
#ifndef REP_IN
#define REP_IN 1
#endif
#ifndef REP_RET
#define REP_RET 1
#endif
#ifndef REP_DIFF
#define REP_DIFF 1
#endif
#ifndef REP_MERGE
#define REP_MERGE 1
#endif
#ifndef REP_UP
#define REP_UP 1
#endif
#ifndef PROBE_DIFF
#define PROBE_DIFF 0
#endif
#ifndef EN_ALL
#define EN_ALL 1
#endif
#ifndef EN_CONV
#define EN_CONV EN_ALL
#endif
#ifndef EN_IN
#define EN_IN EN_ALL
#endif
#ifndef EN_RET
#define EN_RET EN_ALL
#endif
#ifndef EN_DIFF
#define EN_DIFF EN_ALL
#endif
#ifndef EN_DIL
#define EN_DIL EN_ALL
#endif
#ifndef EN_MERGE
#define EN_MERGE EN_ALL
#endif
#ifndef EN_OUT
#define EN_OUT EN_ALL
#endif
#ifndef EN_UP
#define EN_UP EN_ALL
#endif
#ifndef EN_DOWN
#define EN_DOWN EN_ALL
#endif
#ifndef EN_FIN
#define EN_FIN EN_ALL
#endif
#define GAS __attribute__((address_space(1)))
#define LAS __attribute__((address_space(3)))
typedef unsigned short bf16;
typedef unsigned short bf16_t;
typedef short bf16x8 __attribute__((ext_vector_type(8)));
typedef float f32x4 __attribute__((ext_vector_type(4)));
typedef float f32x2 __attribute__((ext_vector_type(2)));
typedef unsigned u32x4 __attribute__((ext_vector_type(4)));
typedef unsigned u32x2 __attribute__((ext_vector_type(2)));

constexpr int BATCH = 16, SEQ = 2048, D = 1024, M = BATCH * SEQ, DEPTH = 2;
constexpr int IN_W = 13824, FFN = 2816;
constexpr int C_RET = 0, C_DIFF = 3072, C_DIL = 6144, C_GATE = 10752;
constexpr int N_RET = 3072, N_DIFF = 3072, N_DILG = 1536, N_GATE = 3072;
constexpr int YW = 2560;
constexpr int NWAVES = 8;

constexpr size_t MiB = 1u << 20;
constexpr size_t WS_CTL = 0, CTL_ZERO_BYTES = 1 * MiB;
constexpr size_t WS_CS = 1 * MiB;
constexpr size_t WS_BLUT = 2 * MiB;
constexpr size_t WS_RSS = 3 * MiB;
constexpr size_t WS_RSTD = 5 * MiB;
constexpr size_t WS_WIN = 8 * MiB;
constexpr size_t WS_WBR = 35 * MiB;
constexpr size_t WS_WOUT = 40 * MiB;
constexpr size_t WS_WGU = 42 * MiB;
constexpr size_t WS_WDN = 53 * MiB;
constexpr size_t WS_XB = 60 * MiB;
constexpr size_t WS_Y = 124 * MiB;
constexpr size_t WS_S = 284 * MiB;
constexpr size_t WS_XB2 = 300 * MiB;
constexpr size_t WS_HID = 124 * MiB;
constexpr size_t WS_DILP = WS_S + 96 * MiB;
constexpr size_t WS_DILS = WS_DILP + 64 * MiB;
constexpr size_t WS_END = 512 * MiB;

constexpr int CW_TMO = 0;
constexpr int CW_BAR = 4096;

constexpr int RING_OFF = 0, RING_BYTES = 131072;
constexpr int LDSCTL_OFF = RING_BYTES, MISC_OFF = LDSCTL_OFF + 320;
constexpr int LDS_BYTES = 147456;

typedef GAS unsigned gu32;
#define RLX_AGENT __ATOMIC_RELAXED, __HIP_MEMORY_SCOPE_AGENT
#define LDS_WAIT() asm volatile("s_waitcnt lgkmcnt(0)" ::: "memory")
#define VM_WAIT() asm volatile("s_waitcnt vmcnt(0)" ::: "memory")

__device__ __forceinline__ unsigned f2bf(float f) { unsigned u = __builtin_bit_cast(unsigned, f); return (u + 0x7fffu + ((u >> 16) & 1u)) >> 16; }
__device__ __forceinline__ unsigned pk2(float lo, float hi) { return f2bf(lo) | (f2bf(hi) << 16); }
__device__ __forceinline__ float bflo(unsigned w) { return __builtin_bit_cast(float, w << 16); }
__device__ __forceinline__ float bfhi(unsigned w) { return __builtin_bit_cast(float, w & 0xffff0000u); }
__device__ __forceinline__ float wave_sum(float v) {
#pragma unroll
    for (int o = 1; o < 64; o <<= 1) v += __shfl_xor(v, o);
    return v;
}
__device__ __forceinline__ float wave_max(float v) {
#pragma unroll
    for (int o = 1; o < 64; o <<= 1) v = fmaxf(v, __shfl_xor(v, o));
    return v;
}
__device__ __forceinline__ float rdlane(float v, int j) { return __builtin_bit_cast(float, __builtin_amdgcn_readlane(__builtin_bit_cast(int, v), j)); }
__device__ __forceinline__ float sigmoidf_(float x) { return 1.0f / (1.0f + __expf(-x)); }

__device__ const double ROPE_INV[64] = {1.0,0.8659643233600653,0.7498942093324559,0.6493816315762113,0.5623413251903491,0.4869675251658631,0.4216965034285822,0.3651741272548377,0.31622776601683794,0.27384196342643613,0.23713737056616552,0.2053525026457146,0.1778279410038923,0.1539926526059492,0.1333521432163324,0.11547819846894582,0.1,0.08659643233600653,0.07498942093324558,0.06493816315762113,0.05623413251903491,0.04869675251658631,0.042169650342858224,0.03651741272548377,0.03162277660168379,0.027384196342643614,0.023713737056616554,0.02053525026457146,0.01778279410038923,0.01539926526059492,0.01333521432163324,0.011547819846894581,0.01,0.008659643233600654,0.007498942093324558,0.006493816315762113,0.005623413251903491,0.004869675251658631,0.004216965034285823,0.003651741272548377,0.0031622776601683794,0.0027384196342643613,0.0023713737056616554,0.002053525026457146,0.0017782794100389228,0.001539926526059492,0.001333521432163324,0.0011547819846894581,0.001,0.0008659643233600654,0.0007498942093324559,0.0006493816315762113,0.0005623413251903491,0.0004869675251658631,0.00042169650342858224,0.0003651741272548377,0.00031622776601683794,0.0002738419634264361,0.00023713737056616554,0.0002053525026457146,0.00017782794100389227,0.0001539926526059492,0.0001333521432163324,0.00011547819846894582};
__device__ const unsigned char REL_BUCKET[128] = {0,1,2,3,4,5,6,7,8,9,10,11,12,13,14,15,16,16,16,17,17,18,18,18,19,19,19,20,20,20,20,21,21,21,21,22,22,22,22,22,23,23,23,23,23,23,24,24,24,24,24,24,25,25,25,25,25,25,25,26,26,26,26,26,26,26,26,27,27,27,27,27,27,27,27,27,27,28,28,28,28,28,28,28,28,28,28,29,29,29,29,29,29,29,29,29,29,29,29,30,30,30,30,30,30,30,30,30,30,30,30,30,30,31,31,31,31,31,31,31,31,31,31,31,31,31,31,31};

typedef __bf16 bf16x2_t __attribute__((ext_vector_type(2)));
__device__ __forceinline__ unsigned cvtpk(float lo, float hi) { const f32x2 v = {lo, hi}; const bf16x2_t b = __builtin_convertvector(v, bf16x2_t); return __builtin_bit_cast(unsigned, b); }
namespace pg8 {
#define PG8_LAS __attribute__((address_space(3)))
constexpr int BM = 256, BK = 64, HALF = 128, HTB = HALF * BK * 2, STAGE_BYTES = 8 * HTB, NXCD = 8, WGM = 8;
__host__ __device__ __forceinline__ int lds_byte(int r, int c) { const int st = (r >> 4) * 2 + (c >> 5), rr = r & 15, cc = c & 31, ob = rr * 64 + cc * 2; return st * 1024 + (ob ^ (((ob >> 9) & 1) << 5)); }
__host__ __device__ __forceinline__ void stage_rc(int b, int& R, int& C) { const int st = b / 1024, sb = b % 1024, swz = sb ^ (((sb >> 9) & 1) << 5); R = (st >> 1) * 16 + swz / 64; C = (st & 1) * 32 + (swz % 64) / 2; }
__host__ __device__ __forceinline__ int perm32(int rho) { const int n = rho >> 4, i = rho & 15; return 8 * (i >> 2) + 4 * n + (i & 3); }

struct Unit { int pm, pn, seg; };
struct Gemm { const bf16_t* A; const bf16_t* Bt; int lda, ldb, M, N, K; };

struct StaticOrder {
    int nM, nN, nwg, G, c;
    __device__ void init(int M_, int N_, int G_, int c_) { nM = M_ / BM; nN = N_ / BM; nwg = nM * nN; G = G_; c = c_; }
    __device__ __forceinline__ bool tile(int i, Unit& u) const {
        const long L = (long)i * G + c; if (L >= nwg) return false;
        int wgid = (int)L; { const int q = nwg / NXCD, r = nwg % NXCD, xcd = wgid % NXCD, off = wgid / NXCD; wgid = (xcd < r ? xcd * (q + 1) : r * (q + 1) + (xcd - r) * q) + off; }
        const int nig = WGM * nN, gid = wgid / nig, fm = gid * WGM, gsz = (nM - fm) < WGM ? (nM - fm) : WGM;
        u.pm = fm + ((wgid % nig) % gsz); u.pn = (wgid % nig) / gsz; return true;
    }
    __device__ __forceinline__ bool next(int i, Unit& u) const { u.seg = 0; return tile(i, u); }
    __device__ __forceinline__ const char* abase(const Gemm& g, const Unit& u) const { return (const char*)g.A + (size_t)u.pm * BM * g.lda * 2; }
    __device__ __forceinline__ const char* bbase(const Gemm& g, const Unit& u) const { return (const char*)g.Bt + (size_t)u.pn * BM * g.ldb * 2; }
    __device__ __forceinline__ int nt(const Gemm& g, const Unit&) const { return g.K / BK; }
};
struct SegOrder : StaticOrder {
    __device__ __forceinline__ bool next(int i, Unit& u) const { u.seg = i % 3; return tile(i / 3, u); }
    __device__ __forceinline__ const char* abase(const Gemm& g, const Unit& u) const { return (const char*)g.A + (size_t)u.pm * BM * g.lda * 2 + (size_t)u.seg * 2048; }
    __device__ __forceinline__ const char* bbase(const Gemm& g, const Unit& u) const { return (const char*)g.Bt + (size_t)u.pn * BM * g.ldb * 2 + (size_t)u.seg * 2048; }
    __device__ __forceinline__ int nt(const Gemm&, const Unit& u) const { return u.seg < 2 ? 16 : 8; }
};

__device__ __forceinline__ unsigned cvt_pk_bf16(float lo, float hi) { unsigned r; asm volatile("v_cvt_pk_bf16_f32 %0, %1, %2" : "=v"(r) : "v"(lo), "v"(hi)); return r; }

struct EpiIn {
    static constexpr bool PERM = true, AFTER_DRAIN = false;
    bf16_t* O; int ldc; const float* rstd; const float* cs; int mode;
    __device__ __forceinline__ void operator()(const f32x4 (&acc)[2][2][4][2], const Unit& u, int wr, int wc, int fr, int fq) const {
        const int row0 = u.pm * BM + wr * 64 + fr, col0 = u.pn * BM + wc * 32 + 8 * fq;
        const bool rot = (mode == 1) && (u.pn < 4);
        float sc = 1.0f;
        if (rot && u.pn >= 2) sc = 0.08838834764831845f;
        if (mode == 3 && u.pn < 4) sc = 0.18033688011112042f;
        if (mode == 4 && u.pn < 2) sc = 0.12751743082459868f;
        float rs[2][4];
#pragma unroll
        for (int ai = 0; ai < 2; ++ai)
#pragma unroll
            for (int m = 0; m < 4; ++m) rs[ai][m] = rstd[row0 + ai * HALF + m * 16];
        if (rot) {
#pragma unroll
            for (int ai = 0; ai < 2; ++ai) {
                f32x4 c01[4], c23[4];
#pragma unroll
                for (int m = 0; m < 4; ++m) { const f32x4* cp = (const f32x4*)(cs + ((size_t)((row0 + ai * HALF + m * 16) & (SEQ - 1)) * 64 + 16 * wc + 4 * fq) * 2); c01[m] = cp[0]; c23[m] = cp[1]; }
#pragma unroll
                for (int m = 0; m < 4; ++m) {
                    const float r = rs[ai][m] * sc;
                    bf16_t* rowp = O + (size_t)(row0 + ai * HALF + m * 16) * ldc + col0;
#pragma unroll
                    for (int bj = 0; bj < 2; ++bj) {
                        const f32x4 v0 = acc[ai][bj][m][0] * r, v1 = acc[ai][bj][m][1] * r;
                        u32x4 w;
                        w.x = cvtpk(v0[0] * c01[m][0] - v0[1] * c01[m][1], v0[0] * c01[m][1] + v0[1] * c01[m][0]);
                        w.y = cvtpk(v0[2] * c01[m][2] - v0[3] * c01[m][3], v0[2] * c01[m][3] + v0[3] * c01[m][2]);
                        w.z = cvtpk(v1[0] * c23[m][0] - v1[1] * c23[m][1], v1[0] * c23[m][1] + v1[1] * c23[m][0]);
                        w.w = cvtpk(v1[2] * c23[m][2] - v1[3] * c23[m][3], v1[2] * c23[m][3] + v1[3] * c23[m][2]);
                        *(u32x4*)(rowp + bj * HALF) = w;
                    }
                }
            }
        } else {
#pragma unroll
            for (int ai = 0; ai < 2; ++ai)
#pragma unroll
                for (int m = 0; m < 4; ++m) {
                    const float r = rs[ai][m] * sc;
                    bf16_t* rowp = O + (size_t)(row0 + ai * HALF + m * 16) * ldc + col0;
#pragma unroll
                    for (int bj = 0; bj < 2; ++bj) {
                        f32x4 v0 = acc[ai][bj][m][0] * r, v1 = acc[ai][bj][m][1] * r;
                        if (mode == 2) {
#pragma unroll
                            for (int j = 0; j < 4; ++j) { v0[j] = sigmoidf_(v0[j]); v1[j] = sigmoidf_(v1[j]); }
                        }
                        u32x4 w; w.x = cvtpk(v0[0], v0[1]); w.y = cvtpk(v0[2], v0[3]); w.z = cvtpk(v1[0], v1[1]); w.w = cvtpk(v1[2], v1[3]);
                        *(u32x4*)(rowp + bj * HALF) = w;
                    }
                }
        }
    }
};
struct EpiMerge {
    static constexpr bool PERM = true, AFTER_DRAIN = false;
    bf16_t* O; const bf16_t* Gt;
    __device__ __forceinline__ void operator()(const f32x4 (&acc)[2][2][4][2], const Unit& u, int wr, int wc, int fr, int fq) const {
        const int row0 = u.pm * BM + wr * 64 + fr, col0 = u.pn * BM + wc * 32 + 8 * fq;
#pragma unroll
        for (int ai = 0; ai < 2; ++ai) {
            u32x4 g[4][2], p[4][2];
#pragma unroll
            for (int m = 0; m < 4; ++m)
#pragma unroll
                for (int bj = 0; bj < 2; ++bj) {
                    const int row = row0 + ai * HALF + m * 16, col = col0 + bj * HALF;
                    g[m][bj] = *(const u32x4*)(Gt + (size_t)row * N_GATE + u.seg * 1024 + col);
                    p[m][bj] = (u.seg > 0) ? *(const u32x4*)(O + (size_t)row * D + col) : (u32x4){0u, 0u, 0u, 0u};
                }
#pragma unroll
            for (int m = 0; m < 4; ++m)
#pragma unroll
                for (int bj = 0; bj < 2; ++bj) {
                    const int row = row0 + ai * HALF + m * 16, col = col0 + bj * HALF;
                    const f32x4 a0 = acc[ai][bj][m][0], a1 = acc[ai][bj][m][1];
                    const u32x4 gg = g[m][bj], pp = p[m][bj];
                    u32x4 w;
                    w.x = cvtpk(a0[0] * bflo(gg.x) + bflo(pp.x), a0[1] * bfhi(gg.x) + bfhi(pp.x));
                    w.y = cvtpk(a0[2] * bflo(gg.y) + bflo(pp.y), a0[3] * bfhi(gg.y) + bfhi(pp.y));
                    w.z = cvtpk(a1[0] * bflo(gg.z) + bflo(pp.z), a1[1] * bfhi(gg.z) + bfhi(pp.z));
                    w.w = cvtpk(a1[2] * bflo(gg.w) + bflo(pp.w), a1[3] * bfhi(gg.w) + bfhi(pp.w));
                    *(u32x4*)(O + (size_t)row * D + col) = w;
                }
        }
    }
};
struct EpiRes {
    static constexpr bool PERM = false, AFTER_DRAIN = false;
    const float* res; float* xo; bf16_t* xb; float* rss;
    __device__ __forceinline__ void operator()(const f32x4 (&acc)[2][2][4][2], const Unit& u, int wr, int wc, int fr, int fq) const {
        const int row0 = u.pm * BM + wr * 64 + fr, col0 = u.pn * BM + wc * 32 + 4 * fq;
#pragma unroll
        for (int ai = 0; ai < 2; ++ai) {
            f32x4 r[4][2][2];
#pragma unroll
            for (int m = 0; m < 4; ++m)
#pragma unroll
                for (int bj = 0; bj < 2; ++bj)
#pragma unroll
                    for (int n = 0; n < 2; ++n) r[m][bj][n] = *(const f32x4*)(res + (size_t)(row0 + ai * HALF + m * 16) * D + col0 + bj * HALF + n * 16);
#pragma unroll
            for (int m = 0; m < 4; ++m) {
                const int row = row0 + ai * HALF + m * 16; float ss = 0.f;
#pragma unroll
                for (int bj = 0; bj < 2; ++bj)
#pragma unroll
                    for (int n = 0; n < 2; ++n) {
                        const size_t off = (size_t)row * D + col0 + bj * HALF + n * 16;
                        const f32x4 v = acc[ai][bj][m][n] + r[m][bj][n];
                        *(f32x4*)(xo + off) = v;
                        ss += (v[0] * v[0] + v[1] * v[1]) + (v[2] * v[2] + v[3] * v[3]);
                        u32x2 w; w.x = cvtpk(v[0], v[1]); w.y = cvtpk(v[2], v[3]);
                        *(u32x2*)(xb + off) = w;
                    }
                ss += __shfl_xor(ss, 16); ss += __shfl_xor(ss, 32);
                if (fq == 0) rss[(size_t)row * 16 + u.pn * 4 + wc] = ss;
            }
        }
    }
};
struct EpiSwiGLU {
    static constexpr bool PERM = true, AFTER_DRAIN = false;
    bf16_t* H; const float* rstd;
    __device__ __forceinline__ void operator()(const f32x4 (&acc)[2][2][4][2], const Unit& u, int wr, int wc, int fr, int fq) const {
        const int row0 = u.pm * BM + wr * 64 + fr, col0 = u.pn * HALF + wc * 32 + 8 * fq;
        float rsv[2][4];
#pragma unroll
        for (int ai = 0; ai < 2; ++ai)
#pragma unroll
            for (int m = 0; m < 4; ++m) rsv[ai][m] = rstd[row0 + ai * HALF + m * 16];
#pragma unroll
        for (int ai = 0; ai < 2; ++ai)
#pragma unroll
            for (int m = 0; m < 4; ++m) {
                const int row = row0 + ai * HALF + m * 16;
                const float rs = rsv[ai][m];
                f32x4 h0, h1;
#pragma unroll
                for (int j = 0; j < 4; ++j) {
                    const float g0 = acc[ai][0][m][0][j] * rs, g1 = acc[ai][0][m][1][j] * rs;
                    h0[j] = g0 * sigmoidf_(g0) * (acc[ai][1][m][0][j] * rs);
                    h1[j] = g1 * sigmoidf_(g1) * (acc[ai][1][m][1][j] * rs);
                }
                u32x4 w; w.x = cvtpk(h0[0], h0[1]); w.y = cvtpk(h0[2], h0[3]); w.z = cvtpk(h1[0], h1[1]); w.w = cvtpk(h1[2], h1[3]);
                *(u32x4*)(H + (size_t)row * FFN + col0) = w;
            }
    }
};

template <class Epi, class Sched, bool ALIGN_EPI>
__device__ __forceinline__ void gemm_phase(PG8_LAS unsigned char* lds, const Gemm g, const Sched& S, const Epi& E) {
    int tid_ = threadIdx.x; asm volatile("" : "+v"(tid_));
    const int tid = tid_, wid = __builtin_amdgcn_readfirstlane(tid >> 6), lane = tid & 63, wr = wid >> 2, wc = wid & 3, fr = lane & 15, fq = lane >> 4;
    unsigned voffA[2], voffB[2];
#pragma unroll
    for (int i = 0; i < 2; ++i) { int R, C; stage_rc(tid * 16 + i * 8192, R, C); const int Rb = Epi::PERM ? ((R & ~31) + perm32(R & 31)) : R;
        voffA[i] = (unsigned)(R * g.lda + C) * 2u; voffB[i] = (unsigned)(Rb * g.ldb + C) * 2u; }
    const size_t kstep = (size_t)(BK * 2);
    const size_t hstepA = (size_t)HALF * g.lda * 2, hstepB = (size_t)HALF * g.ldb * 2;
    const unsigned ldsw = (unsigned)wid * 1024u;
    const int aoff = lds_byte(wr * 64 + fr, fq * 8), boff = lds_byte(wc * 32 + fr, fq * 8);
#define PG8_SA(b, h) (((b) * 2 + (h)) * HTB)
#define PG8_SB(b, h) ((4 + (b) * 2 + (h)) * HTB)
#define PG8_STAGE(bufoff, gbase, voff) do { _Pragma("unroll") for (int _i = 0; _i < 2; ++_i) \
        __builtin_amdgcn_global_load_lds((const unsigned*)((const char*)(gbase) + (voff)[_i]), (PG8_LAS unsigned*)(lds + (bufoff) + ldsw + _i * 8192), 16, 0, 0); } while (0)
#define PG8_LDA(dst, b, h) do { _Pragma("unroll") for (int m = 0; m < 4; ++m) _Pragma("unroll") for (int k = 0; k < 2; ++k) dst[m][k] = *(const PG8_LAS bf16x8*)(lds + PG8_SA(b, h) + aoff + m * 2048 + k * 1024); } while (0)
#define PG8_LDB(dst, b, h) do { _Pragma("unroll") for (int n = 0; n < 2; ++n) _Pragma("unroll") for (int k = 0; k < 2; ++k) dst[n][k] = *(const PG8_LAS bf16x8*)(lds + PG8_SB(b, h) + boff + n * 2048 + k * 1024); } while (0)
#define PG8_MMA(ai, bj, At, Bt) do { __builtin_amdgcn_s_setprio(1); _Pragma("unroll") for (int m = 0; m < 4; ++m) _Pragma("unroll") for (int n = 0; n < 2; ++n) _Pragma("unroll") for (int k = 0; k < 2; ++k) \
        acc[ai][bj][m][n] = __builtin_amdgcn_mfma_f32_16x16x32_bf16(Bt[n][k], At[m][k], acc[ai][bj][m][n], 0, 0, 0); __builtin_amdgcn_s_setprio(0); } while (0)
#define PG8_WAIT_V(n) asm volatile("s_waitcnt vmcnt(" #n ")" ::: "memory")
#define PG8_WAIT_L(n) asm volatile("s_waitcnt lgkmcnt(" #n ")" ::: "memory")
#define PG8_BAR __builtin_amdgcn_s_barrier()
#define PG8_SCHED __builtin_amdgcn_sched_barrier(0)
    Unit cur, nxt; int ui = 0;
    if (!S.next(0, cur)) return;
    f32x4 acc[2][2][4][2];
#pragma unroll
    for (int a = 0; a < 2; ++a)
#pragma unroll
        for (int b = 0; b < 2; ++b)
#pragma unroll
            for (int m = 0; m < 4; ++m)
#pragma unroll
                for (int n = 0; n < 2; ++n) acc[a][b][m][n] = (f32x4){0.f, 0.f, 0.f, 0.f};
    bf16x8 At[4][2], B0[2][2], B1[2][2];
    const char* cA = S.abase(g, cur); const char* cB = S.bbase(g, cur);
    PG8_STAGE(PG8_SB(0, 0), cB, voffB); PG8_STAGE(PG8_SB(0, 1), cB + hstepB, voffB); PG8_STAGE(PG8_SA(0, 0), cA, voffA); PG8_STAGE(PG8_SA(0, 1), cA + hstepA, voffA);
    if (wr == 1) PG8_BAR;
    PG8_WAIT_V(2); PG8_BAR;
    PG8_STAGE(PG8_SB(1, 0), cB + kstep, voffB); PG8_STAGE(PG8_SA(1, 0), cA + kstep, voffA); PG8_STAGE(PG8_SB(1, 1), cB + hstepB + kstep, voffB);
    PG8_WAIT_V(6); PG8_BAR;
    for (;;) {
        const bool has_next = S.next(ui + 1, nxt);
        const int nt = S.nt(g, cur);
        const char* nA = has_next ? S.abase(g, nxt) : cA; const char* nB = has_next ? S.bbase(g, nxt) : cB;
        for (int t = 0; t < nt; t += 2) {
            const bool last = (t == nt - 2);
            const char* a1 = cA + (size_t)(t + 1) * kstep;
            const char* a2 = last ? nA : cA + (size_t)(t + 2) * kstep; const char* b2 = last ? nB : cB + (size_t)(t + 2) * kstep;
            const char* a3 = a2 + kstep; const char* b3 = b2 + kstep;
            PG8_LDB(B0, 0, 0); PG8_LDB(B1, 0, 1); PG8_SCHED; PG8_LDA(At, 0, 0); PG8_STAGE(PG8_SA(1, 1), a1 + hstepA, voffA);
            PG8_WAIT_V(8); PG8_WAIT_L(0); PG8_BAR; PG8_MMA(0, 0, At, B0); PG8_MMA(0, 1, At, B1); PG8_BAR; PG8_SCHED;
            PG8_LDA(At, 0, 1); PG8_STAGE(PG8_SB(0, 0), b2, voffB); PG8_STAGE(PG8_SB(0, 1), b2 + hstepB, voffB); PG8_STAGE(PG8_SA(0, 0), a2, voffA);
            PG8_WAIT_V(8); PG8_WAIT_L(0); PG8_BAR; PG8_MMA(1, 0, At, B0); PG8_MMA(1, 1, At, B1); PG8_BAR; PG8_SCHED;
            PG8_LDB(B0, 1, 0); PG8_LDB(B1, 1, 1); PG8_SCHED; PG8_LDA(At, 1, 0); PG8_STAGE(PG8_SA(0, 1), a2 + hstepA, voffA);
            PG8_WAIT_V(8); PG8_WAIT_L(0); PG8_BAR; PG8_MMA(0, 0, At, B0); PG8_MMA(0, 1, At, B1); PG8_BAR; PG8_SCHED;
            PG8_LDA(At, 1, 1); PG8_STAGE(PG8_SB(1, 0), b3, voffB); PG8_STAGE(PG8_SB(1, 1), b3 + hstepB, voffB); PG8_STAGE(PG8_SA(1, 0), a3, voffA);
            PG8_WAIT_V(8); PG8_WAIT_L(0); PG8_BAR; PG8_MMA(1, 0, At, B0); PG8_MMA(1, 1, At, B1); PG8_BAR; PG8_SCHED;
        }
        if constexpr (ALIGN_EPI) { if (wr == 0) PG8_BAR; }
        E(acc, cur, wr, wc, fr, fq);
        if (!has_next) break;
#pragma unroll
        for (int a = 0; a < 2; ++a)
#pragma unroll
            for (int b = 0; b < 2; ++b)
#pragma unroll
                for (int m = 0; m < 4; ++m)
#pragma unroll
                    for (int n = 0; n < 2; ++n) acc[a][b][m][n] = (f32x4){0.f, 0.f, 0.f, 0.f};
        cur = nxt; cA = nA; cB = nB; ++ui;
        if constexpr (ALIGN_EPI) { if (wr == 1) PG8_BAR; }
    }
    PG8_WAIT_V(0);
    if constexpr (!ALIGN_EPI) { if (wr == 0) PG8_BAR; }
    PG8_BAR;
#undef PG8_SA
#undef PG8_SB
#undef PG8_STAGE
#undef PG8_LDA
#undef PG8_LDB
#undef PG8_MMA
#undef PG8_WAIT_V
#undef PG8_WAIT_L
#undef PG8_BAR
#undef PG8_SCHED
}
}

#define XB_TMO      128
#define XB_XCNT(j)  (256  + 64 * (j))
#define XB_XSUB(j)  (1280 + 64 * (j))
#define XB_XGEN(j)  (2304 + 64 * (j))
#define XB_TOP      3328
#define XB_TOPGEN   3392
#define XCD_BAR_WORDS 3456
#define XB_SPIN_CAP (1u << 18)

__device__ __forceinline__ unsigned xb_ld(unsigned* p)              { return __hip_atomic_load(p, __ATOMIC_RELAXED, __HIP_MEMORY_SCOPE_AGENT); }
__device__ __forceinline__ unsigned xb_add(unsigned* p, unsigned v) { return __hip_atomic_fetch_add(p, v, __ATOMIC_RELAXED, __HIP_MEMORY_SCOPE_AGENT); }
__device__ __forceinline__ unsigned xb_xcc_id() { return (unsigned)__builtin_amdgcn_s_getreg((3 << 11) | 20) & 0xFu; }
#define XB_SPIN(cond, bar) do { unsigned _sp = 0; while (cond) { __builtin_amdgcn_s_sleep(1); \
    if ((++_sp & 255u) == 0u) { if (xb_ld(&(bar)[XB_TMO])) break; if (_sp > XB_SPIN_CAP) { atomicAdd(&(bar)[XB_TMO], 1u); break; } } } } while (0)

struct XcdBarrier { unsigned* bar; unsigned x; volatile LAS unsigned* st; };

__device__ __forceinline__ XcdBarrier xcd_barrier_post(unsigned* bar, volatile LAS unsigned* st) {
    XcdBarrier b; b.bar = bar; b.x = xb_xcc_id(); b.st = st;
    if (threadIdx.x == 0) (void)xb_add(&bar[XB_XCNT(b.x)], 1u);
    return b;
}
__device__ __forceinline__ void xcd_barrier_complete(unsigned* bar, unsigned x, unsigned& nloc, unsigned& nx) {
    const unsigned G = gridDim.x * gridDim.y * gridDim.z;
    unsigned sum, cnt, mine, sp = 0u;
    for (;;) {
        sum = 0u; cnt = 0u; mine = 0u;
#pragma unroll
        for (unsigned j = 0; j < 16; ++j) { const unsigned c = xb_ld(&bar[XB_XCNT(j)]); sum += c; cnt += (c > 0u) ? 1u : 0u; mine = (j == x) ? c : mine; }
        if (sum == G) break;
        __builtin_amdgcn_s_sleep(1);
        if ((++sp & 255u) == 0u) { if (xb_ld(&bar[XB_TMO])) break; if (sp > XB_SPIN_CAP) { atomicAdd(&bar[XB_TMO], 1u); break; } }
    }
    nloc = mine > 0u ? mine : 1u; nx = cnt > 0u ? cnt : 1u;
}
__device__ __forceinline__ void xcd_barrier(const XcdBarrier& b) {
    asm volatile("s_waitcnt vmcnt(0)" ::: "memory");
    __syncthreads();
    if (threadIdx.x == 0) {
        unsigned* bar = b.bar;
        __builtin_amdgcn_s_waitcnt(0);
        unsigned nloc = b.st[0], nx = b.st[1];
        if (nloc == 0u) { xcd_barrier_complete(bar, b.x, nloc, nx); b.st[0] = nloc; b.st[1] = nx; }
        const unsigned old = xb_add(&bar[XB_XSUB(b.x)], 1u);
        const unsigned gen = old / nloc;
        if (old + 1u == (gen + 1u) * nloc) {
            __builtin_amdgcn_fence(__ATOMIC_RELEASE, "agent");
            asm volatile("s_waitcnt vmcnt(0)" ::: "memory");
            const unsigned og = xb_add(&bar[XB_TOP], 1u);
            const unsigned tg = og / nx;
            if (og + 1u == (tg + 1u) * nx) xb_add(&bar[XB_TOPGEN], 1u);
            else XB_SPIN(xb_ld(&bar[XB_TOPGEN]) == tg, bar);
            __builtin_amdgcn_fence(__ATOMIC_ACQUIRE, "agent");
            xb_add(&bar[XB_XGEN(b.x)], 1u);
            asm volatile("s_waitcnt vmcnt(0)" ::: "memory");
        } else {
            XB_SPIN(xb_ld(&bar[XB_XGEN(b.x)]) == gen, bar);
            __builtin_amdgcn_fence(__ATOMIC_ACQUIRE, "agent");
            asm volatile("s_waitcnt vmcnt(0)" ::: "memory");
        }
    }
    __syncthreads();
}

struct Frame {
    LAS unsigned char* lds;
    volatile LAS unsigned* MISC;
    gu32* ctl;
    int wave;
    int vcu, G;
};

__device__ __forceinline__ int dst_row(int map, int n) {
    if (map == 1) { if (n < 1024) { const int d = n & 127; return (n & ~127) + 2 * (d & 63) + (d >> 6); } return n; }
    if (map == 2) return (n >> 7) * 256 + (n & 127);
    if (map == 3) return (n >> 7) * 256 + 128 + (n & 127);
    return n;
}
__device__ __forceinline__ void tr_item(const float* W, int N, bf16* WT, int ldw, int koff, int map, const float* gain, LAS float* scr, int item, int lane) {
    const int nblk = N / 32, kb = item / nblk, nb = item % nblk, k0 = 64 * kb, n0 = 32 * nb;
#pragma unroll 8
    for (int i = 0; i < 32; ++i) { const int kk = 2 * i + (lane >> 5); float v = W[(size_t)(k0 + kk) * N + n0 + (lane & 31)]; if (gain) v *= gain[k0 + kk]; scr[kk * 33 + (lane & 31)] = v; }
    LDS_WAIT(); asm volatile("" ::: "memory");
    const int c = lane & 7;
#pragma unroll
    for (int j = 0; j < 4; ++j) { const int n = (lane >> 3) + 8 * j; const LAS float* s = scr + (8 * c) * 33 + n;
        u32x4 o; o.x = pk2(s[0 * 33], s[1 * 33]); o.y = pk2(s[2 * 33], s[3 * 33]); o.z = pk2(s[4 * 33], s[5 * 33]); o.w = pk2(s[6 * 33], s[7 * 33]);
        *(u32x4*)(WT + (size_t)dst_row(map, n0 + n) * ldw + koff + k0 + 8 * c) = o; }
    LDS_WAIT(); asm volatile("" ::: "memory");
}

struct Args {
    const float* x; const float* w_in; const float* w_br_ret; const float* w_br_diff; const float* w_br_dil; const float* w_out;
    const float* norm_mix; const float* norm_ffn; const float* gn_gain; const float* diff_lambda; const float* subln; const float* rel_bias;
    const float* w_gate; const float* w_up; const float* w_down; const float* norm_final;
    float* out; unsigned char* ws; int ph_lo, ph_hi;
};

__device__ __forceinline__ void rstd_reduce(Frame& F, const float* rss, float* rstd) {
    int tid = threadIdx.x; asm volatile("" : "+v"(tid));
    for (int row = F.vcu * NWAVES * 64 + tid; row < M; row += F.G * NWAVES * 64) {
        const f32x4* rp = (const f32x4*)(rss + (size_t)row * 16);
        const f32x4 a = rp[0], b = rp[1], c = rp[2], d = rp[3];
        const float ss = (((a[0] + a[1]) + (a[2] + a[3])) + ((b[0] + b[1]) + (b[2] + b[3]))) + (((c[0] + c[1]) + (c[2] + c[3])) + ((d[0] + d[1]) + (d[2] + d[3])));
        rstd[row] = 1.0f / sqrtf(ss * (1.0f / 1024.0f) + 1e-6f);
    }
}
__device__ __forceinline__ void phase_convert(Frame& F, const Args& a, int l) {
    int tid = threadIdx.x; asm volatile("" : "+v"(tid));
    const int lane = tid & 63;
    LAS float* scr = (LAS float*)(F.lds + RING_OFF + F.wave * 16384);
    const int gw = F.vcu * NWAVES + F.wave, NGW = F.G * NWAVES;
    unsigned char* ws = a.ws;
    constexpr int I_IN = 16 * (IN_W / 32), I_BR = 16 * 32, I_BL = 8 * 32, I_O = 16 * 32, I_G = 16 * (FFN / 32), I_D = (FFN / 64) * 32;
    constexpr int NITEMS = I_IN + 2 * I_BR + I_BL + I_O + 2 * I_G + I_D;
    for (int it = gw; it < NITEMS; it += NGW) {
        int r = it; const float* W; int N; bf16* WT; int ldw, koff = 0, map = 0; const float* gain = nullptr;
        if (r < I_IN) { W = a.w_in + (size_t)l * D * IN_W; N = IN_W; WT = (bf16*)(ws + WS_WIN); ldw = D; map = 1; gain = a.norm_mix + l * D; }
        else if ((r -= I_IN) < I_BR) { W = a.w_br_ret + (size_t)l * 1024 * D; N = D; WT = (bf16*)(ws + WS_WBR); ldw = YW; }
        else if ((r -= I_BR) < I_BR) { W = a.w_br_diff + (size_t)l * 1024 * D; N = D; WT = (bf16*)(ws + WS_WBR); ldw = YW; koff = 1024; }
        else if ((r -= I_BR) < I_BL) { W = a.w_br_dil + (size_t)l * 512 * D; N = D; WT = (bf16*)(ws + WS_WBR); ldw = YW; koff = 2048; }
        else if ((r -= I_BL) < I_O) { W = a.w_out + (size_t)l * D * D; N = D; WT = (bf16*)(ws + WS_WOUT); ldw = D; }
        else if ((r -= I_O) < I_G) { W = a.w_gate + (size_t)l * D * FFN; N = FFN; WT = (bf16*)(ws + WS_WGU); ldw = D; map = 2; gain = a.norm_ffn + l * D; }
        else if ((r -= I_G) < I_G) { W = a.w_up + (size_t)l * D * FFN; N = FFN; WT = (bf16*)(ws + WS_WGU); ldw = D; map = 3; gain = a.norm_ffn + l * D; }
        else { r -= I_G; W = a.w_down + (size_t)l * FFN * D; N = D; WT = (bf16*)(ws + WS_WDN); ldw = FFN; }
        tr_item(W, N, WT, ldw, koff, map, gain, scr, r, lane);
    }
    if (l > 0) rstd_reduce(F, (const float*)(ws + WS_RSS), (float*)(ws + WS_RSTD));
    if (l == 0) {
        bf16* XB = (bf16*)(ws + WS_XB); float* rss = (float*)(ws + WS_RSS);
        for (int m = gw; m < M; m += NGW) {
            const f32x4* xr = (const f32x4*)(a.x + (size_t)m * D) + lane;
            u32x2* o8 = (u32x2*)(XB + (size_t)m * D) + lane;
            float s = 0.f;
#pragma unroll
            for (int j = 0; j < 4; ++j) { const f32x4 v = xr[64 * j]; s += (v[0] * v[0] + v[1] * v[1]) + (v[2] * v[2] + v[3] * v[3]); u32x2 w; w.x = pk2(v[0], v[1]); w.y = pk2(v[2], v[3]); o8[64 * j] = w; }
            s = wave_sum(s);
            if (lane == 0) ((float*)(ws + WS_RSTD))[m] = 1.0f / sqrtf(s * (1.0f / 1024.0f) + 1e-6f);
        }
        float* cs = (float*)(ws + WS_CS);
        const int gt = F.vcu * NWAVES * 64 + tid, NT = F.G * NWAVES * 64;
        for (int idx = gt; idx < SEQ * 64; idx += NT) {
            const int pos = idx >> 6, i = idx & 63;
            const double t = (double)pos * ROPE_INV[i] * 0.15915494309189535;
            const double fr = t - floor(t);
            const float f = (float)fr;
            cs[2 * idx] = __builtin_amdgcn_cosf(f); cs[2 * idx + 1] = __builtin_amdgcn_sinf(f);
        }
        float* blut = (float*)(ws + WS_BLUT);
        for (int idx = gt; idx < 20 * 128; idx += NT) { const int h = idx >> 7, dist = idx & 127; blut[idx] = a.rel_bias[REL_BUCKET[dist] * 20 + h]; }
    }
}

__device__ __forceinline__ float dot8(const u32x4 a, const u32x4 b, float acc) {
    acc += bflo(a.x) * bflo(b.x); acc += bfhi(a.x) * bfhi(b.x); acc += bflo(a.y) * bflo(b.y); acc += bfhi(a.y) * bfhi(b.y);
    acc += bflo(a.z) * bflo(b.z); acc += bfhi(a.z) * bfhi(b.z); acc += bflo(a.w) * bflo(b.w); acc += bfhi(a.w) * bfhi(b.w);
    return acc;
}

__device__ __forceinline__ void naive_ret(Frame& F, const bf16* R, const float* gn_gain, bf16* Y) {
    LAS unsigned* qs = (LAS unsigned*)(F.lds + RING_OFF + F.wave * 1024);
    int lane_ = threadIdx.x & 63; asm volatile("" : "+v"(lane_));
    const int gw = F.vcu * NWAVES + F.wave, NGW = F.G * NWAVES, lane = lane_;
    for (int it = gw; it < M * 4; it += NGW) {
        const int bh = it & 63, t = it >> 6, b = bh >> 2, h = bh & 3;
        const size_t row = (size_t)b * SEQ + t;
        LDS_WAIT();
        qs[lane] = *(const unsigned*)(R + row * N_RET + h * 128 + 2 * lane);
        LDS_WAIT(); asm volatile("" ::: "memory");
        const float l2g = log2f(1.0f - exp2f(-5.0f - (float)h));
        float y0 = 0.f, y1 = 0.f, y2 = 0.f, y3 = 0.f;
        for (int s0 = 0; s0 <= t; s0 += 64) {
            const int s = s0 + lane; const bool valid = s <= t; const int sc = valid ? s : t;
            const u32x4* kr = (const u32x4*)(R + ((size_t)b * SEQ + sc) * N_RET + 512 + h * 128);
            float dot = 0.f;
#pragma unroll
            for (int d8 = 0; d8 < 16; ++d8) { const u32x4 q8 = *(const LAS u32x4*)(qs + d8 * 4); dot = dot8(q8, kr[d8], dot); }
            const float w = valid ? dot * exp2f((float)(t - s) * l2g) : 0.f;
            const int ns = (t - s0 + 1) < 64 ? (t - s0 + 1) : 64;
            const bf16* vb = R + ((size_t)b * SEQ + s0) * N_RET + 1024 + h * 256 + 4 * lane;
            for (int j = 0; j < ns; ++j) {
                const float wj = rdlane(w, j);
                const u32x2 v = *(const u32x2*)(vb + (size_t)j * N_RET);
                y0 += wj * bflo(v.x); y1 += wj * bfhi(v.x); y2 += wj * bflo(v.y); y3 += wj * bfhi(v.y);
            }
        }
        const float mean = wave_sum((y0 + y1) + (y2 + y3)) * (1.0f / 256.0f);
        const float d0 = y0 - mean, d1 = y1 - mean, d2 = y2 - mean, d3 = y3 - mean;
        const float var = wave_sum((d0 * d0 + d1 * d1) + (d2 * d2 + d3 * d3)) * (1.0f / 256.0f);
        const float rstd = 1.0f / sqrtf(var + 1e-5f);
        const f32x4 gg = *(const f32x4*)(gn_gain + h * 256 + 4 * lane);
        const u32x2 gv = *(const u32x2*)(R + row * N_RET + 2048 + h * 256 + 4 * lane);
        const float g0 = bflo(gv.x), g1 = bfhi(gv.x), g2 = bflo(gv.y), g3 = bfhi(gv.y);
        const float o0 = d0 * rstd * gg[0] * (g0 * sigmoidf_(g0)), o1 = d1 * rstd * gg[1] * (g1 * sigmoidf_(g1));
        const float o2 = d2 * rstd * gg[2] * (g2 * sigmoidf_(g2)), o3 = d3 * rstd * gg[3] * (g3 * sigmoidf_(g3));
        u32x2 w; w.x = pk2(o0, o1); w.y = pk2(o2, o3);
        *(u32x2*)(Y + row * YW + h * 256 + 4 * lane) = w;
    }
}

__device__ __forceinline__ void naive_diff(Frame& F, const bf16* Sd, const float* lamp, float lam_init, const float* subln, const float* blut, bf16* Y) {
    LAS unsigned* qs = (LAS unsigned*)(F.lds + RING_OFF + F.wave * 1024);
    int lane_ = threadIdx.x & 63; asm volatile("" : "+v"(lane_));
    const int gw = F.vcu * NWAVES + F.wave, NGW = F.G * NWAVES, lane = lane_;
    const float lam = __expf(wave_sum(lamp[lane] * lamp[64 + lane])) - __expf(wave_sum(lamp[128 + lane] * lamp[192 + lane])) + lam_init;
    for (int it = gw; it < M * 8; it += NGW) {
        const int bh = it & 127, t = it >> 7, b = bh >> 3, h = bh & 7;
        const size_t row = (size_t)b * SEQ + t;
        LDS_WAIT();
        qs[lane] = *(const unsigned*)(Sd + row * N_DIFF + h * 128 + 2 * lane);
        LDS_WAIT(); asm volatile("" ::: "memory");
        float om0[2], om1[2];
#pragma unroll
        for (int mm = 0; mm < 2; ++mm) {
            float mrun = -3.0e38f, l = 0.f, o0 = 0.f, o1 = 0.f;
            for (int s0 = 0; s0 <= t; s0 += 64) {
                const int s = s0 + lane; const bool valid = s <= t; const int sc = valid ? s : t;
                const u32x4* kr = (const u32x4*)(Sd + ((size_t)b * SEQ + sc) * N_DIFF + 1024 + h * 128 + mm * 64);
                float dot = 0.f;
#pragma unroll
                for (int d8 = 0; d8 < 8; ++d8) { const u32x4 q8 = *(const LAS u32x4*)(qs + mm * 32 + d8 * 4); dot = dot8(q8, kr[d8], dot); }
                const int dist = (t - sc) < 127 ? (t - sc) : 127;
                const float scv = valid ? dot * 0.125f + blut[h * 128 + dist] : -3.0e38f;
                const float mnew = fmaxf(mrun, wave_max(scv));
                const float alpha = __expf(mrun - mnew);
                const float p = valid ? __expf(scv - mnew) : 0.f;
                l = l * alpha + wave_sum(p); o0 *= alpha; o1 *= alpha; mrun = mnew;
                const int ns = (t - s0 + 1) < 64 ? (t - s0 + 1) : 64;
                const bf16* vb = Sd + ((size_t)b * SEQ + s0) * N_DIFF + 2048 + h * 128 + 2 * lane;
                for (int j = 0; j < ns; ++j) {
                    const float pj = rdlane(p, j);
                    const unsigned v = *(const unsigned*)(vb + (size_t)j * N_DIFF);
                    o0 += pj * bflo(v); o1 += pj * bfhi(v);
                }
            }
            om0[mm] = o0 / l; om1[mm] = o1 / l;
        }
        const float a0 = om0[0] - lam * om0[1], a1 = om1[0] - lam * om1[1];
        const float ms = wave_sum(a0 * a0 + a1 * a1) * (1.0f / 128.0f);
        const float rs = (1.0f / sqrtf(ms + 1e-5f)) * (1.0f - lam_init);
        *(unsigned*)(Y + row * YW + 1024 + h * 128 + 2 * lane) = pk2(a0 * rs * subln[2 * lane], a1 * rs * subln[2 * lane + 1]);
    }
}

__device__ __forceinline__ void naive_dil(Frame& F, const bf16* Sl, int g, const float* blut, float* Pn, float* Ps, bf16* Y) {
    LAS unsigned* qs = (LAS unsigned*)(F.lds + RING_OFF + F.wave * 1024);
    int lane_ = threadIdx.x & 63; asm volatile("" : "+v"(lane_));
    const int gw = F.vcu * NWAVES + F.wave, NGW = F.G * NWAVES, lane = lane_;
    const int dl = (g == 0) ? 1 : (g == 1 ? 4 : 16);
    for (int it = gw; it < M * 4; it += NGW) {
        const int bh = it & 63, t = it >> 6, b = bh >> 2, h = bh & 3;
        const size_t row = (size_t)b * SEQ + t;
        LDS_WAIT();
        qs[lane] = *(const unsigned*)(Sl + row * N_DILG + h * 128 + 2 * lane);
        LDS_WAIT(); asm volatile("" ::: "memory");
        float sc[3];
#pragma unroll
        for (int tl = 0; tl < 3; ++tl) {
            const int mi = tl * 64 + lane; const int kp = t - mi * dl; const bool valid = (mi <= 128) && (kp >= 0);
            const u32x4* kr = (const u32x4*)(Sl + ((size_t)b * SEQ + (valid ? kp : t)) * N_DILG + 512 + h * 128);
            float dot = 0.f;
#pragma unroll
            for (int d8 = 0; d8 < 16; ++d8) { const u32x4 q8 = *(const LAS u32x4*)(qs + d8 * 4); dot = dot8(q8, kr[d8], dot); }
            const int dist = (mi * dl) < 127 ? (mi * dl) : 127;
            sc[tl] = valid ? dot * 0.08838834764831845f + blut[(8 + g * 4 + h) * 128 + dist] : -3.0e38f;
        }
        float mx = wave_max(fmaxf(fmaxf(sc[0], sc[1]), sc[2]));
        float p[3], den = 0.f;
#pragma unroll
        for (int tl = 0; tl < 3; ++tl) { p[tl] = (sc[tl] > -1.0e38f) ? __expf(sc[tl] - mx) : 0.f; den += p[tl]; }
        den = wave_sum(den);
        float n0 = 0.f, n1 = 0.f;
#pragma unroll
        for (int tl = 0; tl < 3; ++tl) {
            for (int j = 0; j < 64; ++j) {
                const int mi = tl * 64 + j; const int kp = t - mi * dl;
                if (mi > 128 || kp < 0) break;
                const float pj = rdlane(p[tl], j);
                const unsigned v = *(const unsigned*)(Sl + ((size_t)b * SEQ + kp) * N_DILG + 1024 + h * 128 + 2 * lane);
                n0 += pj * bflo(v); n1 += pj * bfhi(v);
            }
        }
        float* pn = Pn + (row * 4 + h) * 128 + 2 * lane; float* ps = Ps + (row * 4 + h) * 2;
        if (g > 0) {
            const f32x2 q = *(const f32x2*)pn; const float pm = ps[0], pd = ps[1];
            const float mnew = fmaxf(mx, pm), ea = __expf(mx - mnew), eb = __expf(pm - mnew);
            n0 = ea * n0 + eb * q[0]; n1 = ea * n1 + eb * q[1]; den = ea * den + eb * pd; mx = mnew;
        }
        if (g < 2) { *(f32x2*)pn = (f32x2){n0, n1}; if (lane == 0) { ps[0] = mx; ps[1] = den; } }
        else { const float inv = 1.0f / den; *(unsigned*)(Y + row * YW + 2048 + h * 128 + 2 * lane) = pk2(n0 * inv, n1 * inv); }
    }
}


typedef short v4i16 __attribute__((ext_vector_type(4)));
__device__ __forceinline__ float fexp2(float x) { return __builtin_amdgcn_exp2f(x); }
__device__ __forceinline__ float hmax4(const f32x4 a) { return fmaxf(fmaxf(a[0], a[1]), fmaxf(a[2], a[3])); }
__device__ __forceinline__ bf16x8 pack_p(const f32x4 a, const f32x4 b) { u32x4 w; w.x = cvtpk(a[0], a[1]); w.y = cvtpk(a[2], a[3]); w.z = cvtpk(b[0], b[1]); w.w = cvtpk(b[2], b[3]); return __builtin_bit_cast(bf16x8, w); }
constexpr int AT_PITCH = 288, AT_TILE = 64 * AT_PITCH, AT_BUF = 2 * AT_TILE, AT_LUT = 2 * AT_BUF, AT_XP = 132;
__device__ __forceinline__ bf16x8 tr16x2(const LAS unsigned char* p0, const LAS unsigned char* p1) {
    const v4i16 a = __builtin_amdgcn_ds_read_tr16_b64_v4i16((LAS v4i16*)p0), b = __builtin_amdgcn_ds_read_tr16_b64_v4i16((LAS v4i16*)p1);
    return __builtin_shufflevector(a, b, 0, 1, 2, 3, 4, 5, 6, 7);
}
#define PIN_Q4(a, b, c, d) asm volatile("" : "+v"(a), "+v"(b), "+v"(c), "+v"(d))
constexpr int DR_TILE = 16384, DR_BUF = 32768, DR_Q = 98304, DR_LUT = 132096, DR_SUBLN = DR_LUT + 4096;
#define VMWAIT(n) asm volatile("s_waitcnt vmcnt(" #n ")" ::: "memory")
__device__ __forceinline__ void vm_wait_n(int n) { if (n <= 0) VMWAIT(0); else if (n <= 4) VMWAIT(4); else VMWAIT(8); }
#define WG_BARRIER() do { asm volatile("" ::: "memory"); __builtin_amdgcn_s_barrier(); asm volatile("" ::: "memory"); } while (0)
__device__ __forceinline__ void dma16(const bf16* gsrc, LAS unsigned char* ldst) {
    unsigned keep; const unsigned dst = (unsigned)__builtin_amdgcn_readfirstlane((int)(unsigned)(uintptr_t)ldst);
    asm volatile("s_mov_b32 %0, m0\n\ts_mov_b32 m0, %2\n\ts_nop 0\n\tglobal_load_lds_dwordx4 %1, off\n\ts_mov_b32 m0, %0" : "=&s"(keep) : "v"(gsrc), "s"(dst) : "memory");
}

__device__ __forceinline__ float hmax16(const f32x4 (&x)[4]) {
    const float a = fmaxf(fmaxf(x[0][0], x[0][1]), x[0][2]), b = fmaxf(fmaxf(x[0][3], x[1][0]), x[1][1]), c = fmaxf(fmaxf(x[1][2], x[1][3]), x[2][0]);
    const float d = fmaxf(fmaxf(x[2][1], x[2][2]), x[2][3]), e = fmaxf(fmaxf(x[3][0], x[3][1]), x[3][2]);
    return fmaxf(fmaxf(fmaxf(a, b), c), fmaxf(fmaxf(d, e), x[3][3]));
}
__device__ __forceinline__ void diff_tile(const LAS unsigned char* Kt, const LAS unsigned char* Vt, int k0, int qw, int l15, int kg, bool first, const bf16x8 (&qf)[2][2],
                                          f32x4 (&O)[2][8], float (&beta)[2], float (&lsum)[2], const LAS float* lut, float c31, const int (&voff)[8]) {
    const int sw = (2 * l15) & 15;
    const int kl = l15 * 256 + 16 * (kg ^ sw);
    const bool nearT = (qw - k0 - 63) < 113;
    f32x4 Sx[2][4];
#pragma unroll
    for (int m = 0; m < 2; ++m) {
        const float i0 = nearT ? -beta[m] : c31 - beta[m];
#pragma unroll
        for (int kb = 0; kb < 4; ++kb) Sx[m][kb] = (f32x4){i0, i0, i0, i0};
    }
#pragma unroll
    for (int m = 0; m < 2; ++m) {
        bf16x8 kf[2][4];
#pragma unroll
        for (int ks = 0; ks < 2; ++ks)
#pragma unroll
            for (int kb = 0; kb < 4; ++kb) kf[ks][kb] = *(const LAS bf16x8*)(Kt + kb * 4096 + (kl ^ (128 * m + 64 * ks)));
        __builtin_amdgcn_sched_barrier(0);
#pragma unroll
        for (int ks = 0; ks < 2; ++ks)
#pragma unroll
            for (int kb = 0; kb < 4; ++kb) Sx[m][kb] = __builtin_amdgcn_mfma_f32_16x16x32_bf16(kf[ks][kb], qf[m][ks], Sx[m][kb], 0, 0, 0);
    }
#define DIFF_VLOAD(dst, j) do { _Pragma("unroll") for (int e4 = 0; e4 < 4; ++e4) dst[e4] = tr16x2(Vt + (32 * ((j) >> 1)) * 256 + voff[4 * ((j) & 1) + e4], Vt + (32 * ((j) >> 1) + 16) * 256 + voff[4 * ((j) & 1) + e4]); } while (0)
#define DIFF_VMMA(src, j) do { _Pragma("unroll") for (int e4 = 0; e4 < 4; ++e4) _Pragma("unroll") for (int m = 0; m < 2; ++m) \
        O[m][4 * ((j) & 1) + e4] = __builtin_amdgcn_mfma_f32_16x16x32_bf16(src[e4], pf[m][(j) >> 1], O[m][4 * ((j) & 1) + e4], 0, 0, 0); } while (0)
    bf16x8 va[4], vc[4];
    DIFF_VLOAD(va, 0);
    __builtin_amdgcn_sched_barrier(0);
    bf16x8 pf[2][2];
    if (nearT) {
        float bv[4][4];
        const int dq = qw + l15 - k0 - 4 * kg;
#pragma unroll
        for (int kb = 0; kb < 4; ++kb)
#pragma unroll
            for (int r = 0; r < 4; ++r) { int di = dq - 16 * kb - r; di = di < 0 ? 0 : (di > 127 ? 127 : di); bv[kb][r] = lut[di]; }
#pragma unroll
        for (int m = 0; m < 2; ++m)
#pragma unroll
            for (int kb = 0; kb < 4; ++kb)
#pragma unroll
                for (int r = 0; r < 4; ++r) Sx[m][kb][r] = (dq - 16 * kb - r < 0) ? -1.0e30f : Sx[m][kb][r] + bv[kb][r];
    }
#pragma unroll
    for (int m = 0; m < 2; ++m) {
        float mx = hmax16(Sx[m]);
        mx = fmaxf(mx, __shfl_xor(mx, 16)); mx = fmaxf(mx, __shfl_xor(mx, 32));
        if (first || __builtin_amdgcn_ballot_w64(mx > 8.0f) != 0ull) {
            const float dlt = (first || mx > 0.f) ? mx : 0.f, sc = fexp2(-dlt);
            beta[m] += dlt; lsum[m] *= sc;
#pragma unroll
            for (int kb = 0; kb < 4; ++kb) Sx[m][kb] = Sx[m][kb] - dlt;
#pragma unroll
            for (int eb = 0; eb < 8; ++eb) O[m][eb] = O[m][eb] * sc;
        }
#pragma unroll
        for (int kb = 0; kb < 4; ++kb) Sx[m][kb] = (f32x4){fexp2(Sx[m][kb][0]), fexp2(Sx[m][kb][1]), fexp2(Sx[m][kb][2]), fexp2(Sx[m][kb][3])};
        const f32x4 pv4 = (Sx[m][0] + Sx[m][1]) + (Sx[m][2] + Sx[m][3]);
        lsum[m] += (pv4[0] + pv4[1]) + (pv4[2] + pv4[3]);
        pf[m][0] = pack_p(Sx[m][0], Sx[m][1]); pf[m][1] = pack_p(Sx[m][2], Sx[m][3]);
    }
    DIFF_VLOAD(vc, 1);
    __builtin_amdgcn_sched_barrier(0);
    DIFF_VMMA(va, 0);
    DIFF_VLOAD(va, 2);
    __builtin_amdgcn_sched_barrier(0);
    DIFF_VMMA(vc, 1);
    DIFF_VLOAD(vc, 3);
    __builtin_amdgcn_sched_barrier(0);
    DIFF_VMMA(va, 2);
    DIFF_VMMA(vc, 3);
#undef DIFF_VLOAD
#undef DIFF_VMMA
}
__device__ __forceinline__ void diff_attn_phase(Frame& F, const bf16* Sd, const float* lamp, float lam_init, const float* subln, const float* blut, bf16* Yo) {
    int tid_ = threadIdx.x; asm volatile("" : "+v"(tid_));
    const int tid = tid_, lane = tid & 63, wave = F.wave, l15 = lane & 15, kg = lane >> 4, G = F.G;
    LAS unsigned char* lds = F.lds;
    const float lam = __expf(wave_sum(lamp[lane] * lamp[64 + lane])) - __expf(wave_sum(lamp[128 + lane] * lamp[192 + lane])) + lam_init;
    for (int i = tid; i < 1024; i += NWAVES * 64) ((LAS float*)(lds + DR_LUT))[i] = blut[i] * 1.4426950408889634f;
    if (tid < 128) ((LAS float*)(lds + DR_SUBLN))[tid] = subln[tid] * (1.0f - lam_init);
    VMWAIT(0);
    __syncthreads();
    const int nun = ((int)blockIdx.x < 2048) ? (2048 - (int)blockIdx.x + G - 1) / G : 0;
#define DIFF_UNIT(j, b_, h_, qb_) do { const int u_ = (int)blockIdx.x + (j) * G; const int bh_ = (u_ & 255) >> 1, hf_ = u_ & 1, jj_ = u_ >> 8; \
        qb_ = hf_ ? (14 - 2 * jj_ + (jj_ & 1)) : (15 - 2 * jj_ - (jj_ & 1)); b_ = bh_ >> 3; h_ = bh_ & 7; } while (0)
    int lo[4];
#pragma unroll
    for (int i = 0; i < 4; ++i) { const int ri = 4 * i + (lane >> 4); lo[i] = ri * N_DIFF + ((lane & 15) ^ ((2 * ri) & 15)) * 8; }
    const int kvrow0 = 16 * (wave & 3), kvcol = 1024 + (wave >> 2) * 1024;
    LAS unsigned char* const kvdst = lds + (wave >> 2) * DR_TILE + (wave & 3) * 4096;
    LAS unsigned char* const qdst = lds + DR_Q + wave * 4096;
    int iu = 0, it = 0, ib = 0, i_nt = 0, i_b = 0, i_h = 0;
    if (nun > 0) { int qb_; DIFF_UNIT(0, i_b, i_h, qb_); i_nt = 2 * qb_ + 2; }
#define DIFF_ISSUE() do { const bf16* src_ = Sd + ((size_t)i_b * SEQ + 64 * it + kvrow0) * N_DIFF + i_h * 128 + kvcol; \
        _Pragma("unroll") for (int i = 0; i < 4; ++i) dma16(src_ + lo[i], kvdst + ib * DR_BUF + i * 1024); \
        ib = (ib == 2) ? 0 : ib + 1; if (++it == i_nt) { it = 0; ++iu; if (iu < nun) { int qb_; DIFF_UNIT(iu, i_b, i_h, qb_); i_nt = 2 * qb_ + 2; } } } while (0)
#define DIFF_ISSUE_Q(b_, h_, Q0_) do { const bf16* src_ = Sd + ((size_t)(b_) * SEQ + (Q0_) + 16 * wave) * N_DIFF + (h_) * 128; \
        _Pragma("unroll") for (int i = 0; i < 4; ++i) dma16(src_ + lo[i], qdst + i * 1024); } while (0)
    if (nun > 0) {
        DIFF_ISSUE(); DIFF_ISSUE();
        { int b_, h_, qb_; DIFF_UNIT(0, b_, h_, qb_); DIFF_ISSUE_Q(b_, h_, qb_ * 128); }
    }
    int cb = 0;
    const int sw = (2 * l15) & 15;
    const int ql = (16 * wave + l15) * 256 + 16 * (kg ^ sw);
    int voff[8];
    { const int vq = 4 * kg + (l15 >> 2); const int vl = vq * 256 + 8 * (l15 & 3) + 16 * ((2 * vq) & 15);
#pragma unroll
      for (int eb = 0; eb < 8; ++eb) voff[eb] = vl ^ (32 * eb); }
    for (int ju = 0; ju < nun; ++ju) {
        int b, h, qb; DIFF_UNIT(ju, b, h, qb);
        const int Q0 = qb * 128, nt = 2 * qb + 2, qw = Q0 + 16 * wave;
        const LAS float* lut = (const LAS float*)(lds + DR_LUT) + h * 128;
        const float c31 = lut[127];
        bf16x8 qf[2][2];
        f32x4 O[2][8]; float mrun[2], lsum[2];
#pragma unroll
        for (int m = 0; m < 2; ++m) { mrun[m] = 0.f; lsum[m] = 0.f;
#pragma unroll
            for (int eb = 0; eb < 8; ++eb) O[m][eb] = (f32x4){0.f, 0.f, 0.f, 0.f}; }
        for (int t = 0; t < nt; ++t) {
            const bool has_next = !(ju == nun - 1 && t == nt - 1);
            if (t == 0) VMWAIT(0);
            else vm_wait_n((has_next ? 4 : 0) + (((t == 2 || t == 3) && ju + 1 < nun) ? 4 : 0));
            WG_BARRIER();
            if (iu < nun) DIFF_ISSUE();
            if (t == 1 && ju + 1 < nun) { int b_, h_, qb_; DIFF_UNIT(ju + 1, b_, h_, qb_); DIFF_ISSUE_Q(b_, h_, qb_ * 128); }
            if (t == 0) {
#pragma unroll
                for (int m = 0; m < 2; ++m)
#pragma unroll
                    for (int ks = 0; ks < 2; ++ks) qf[m][ks] = *(const LAS bf16x8*)(lds + DR_Q + (ql ^ (128 * m + 64 * ks)));
            }
            if (64 * t <= qw + 15) diff_tile(lds + cb * DR_BUF, lds + cb * DR_BUF + DR_TILE, 64 * t, qw, l15, kg, t == 0, qf, O, mrun, lsum, lut, c31, voff);
            cb = (cb == 2) ? 0 : cb + 1;
        }
        float inv[2];
#pragma unroll
        for (int m = 0; m < 2; ++m) { float l = lsum[m]; l += __shfl_xor(l, 16); l += __shfl_xor(l, 32); inv[m] = 1.0f / l; }
        const float i0 = inv[0], i1 = inv[1] * lam;
        float ss = 0.f;
#pragma unroll
        for (int eb = 0; eb < 8; ++eb) { const f32x4 a = O[0][eb] * i0 - O[1][eb] * i1; O[0][eb] = a; ss += (a[0] * a[0] + a[1] * a[1]) + (a[2] * a[2] + a[3] * a[3]); }
        ss += __shfl_xor(ss, 16); ss += __shfl_xor(ss, 32);
        const float rs = 1.0f / sqrtf(ss * (1.0f / 128.0f) + 1e-5f);
        bf16* orow = Yo + ((size_t)b * SEQ + qw + l15) * YW + 1024 + h * 128 + 4 * kg;
        const LAS float* sg = (const LAS float*)(lds + DR_SUBLN) + 4 * kg;
#pragma unroll
        for (int eb = 0; eb < 8; ++eb) { const f32x4 gq = *(const LAS f32x4*)(sg + 16 * eb); const f32x4 a = O[0][eb] * rs * gq;
            u32x2 w; w.x = cvtpk(a[0], a[1]); w.y = cvtpk(a[2], a[3]); *(u32x2*)(orow + 16 * eb) = w; }
    }
#undef DIFF_UNIT
#undef DIFF_ISSUE
#undef DIFF_ISSUE_Q
    VMWAIT(0);
    __syncthreads();
}

__device__ __forceinline__ void dil_attn_phase(Frame& F, const bf16* Sl, int g, const float* blut, float* Lse, bf16* Yo) {
    int tid_ = threadIdx.x; asm volatile("" : "+v"(tid_));
    const int tid = tid_, lane = tid & 63, wave = F.wave, l15 = lane & 15, kg = lane >> 4;
    const int dl = (g == 0) ? 1 : (g == 1 ? 4 : 16);
    LAS unsigned char* lds = F.lds;
    const LAS float* lut = (const LAS float*)(lds + AT_LUT);
    const int tlo = wave >> 2, thi = tlo + 2;
    for (int u = blockIdx.x; u < 1024; u += F.G) {
        const int bh = u & 63, idx = u >> 6, b = bh >> 2, h = bh & 3, r = idx % dl, nbi = idx / dl;
        __syncthreads();
        if (tid < 128) ((LAS float*)(lds + AT_LUT))[tid] = blut[(8 + g * 4 + h) * 128 + tid] * 1.4426950408889634f;
        const bf16* base = Sl + (size_t)b * SEQ * N_DILG + h * 128;
        const int qi = 16 * wave + l15;
        const int qpos = (nbi * 128 + qi) * dl + r;
        bf16x8 qf[4];
#pragma unroll
        for (int ks = 0; ks < 4; ++ks) qf[ks] = *(const bf16x8*)(base + (size_t)qpos * N_DILG + 32 * ks + 8 * kg);
        const int t0 = (nbi == 0) ? 2 : 0;
        const int sr0 = tid >> 4, sc = tid & 15;
        const int sl0 = sr0 * AT_PITCH + sc * 16;
        const bf16* kbase = base + 512 + sc * 8;
        const int krow0 = ((nbi - 1) * 128 + sr0) * dl + r, kstep32 = 32 * dl;
#define DIL_KPTR(j) (kbase + (size_t)(krow0 + (j) * kstep32) * N_DILG)
        u32x4 kr[2], vr[2];
#pragma unroll
        for (int i = 0; i < 2; ++i) { kr[i] = *(const u32x4*)DIL_KPTR(2 * t0 + i); vr[i] = *(const u32x4*)(DIL_KPTR(2 * t0 + i) + 512); }
        {
            LAS unsigned char* nb = lds + (t0 & 1) * AT_BUF;
#pragma unroll
            for (int i = 0; i < 2; ++i) { *(LAS u32x4*)(nb + sl0 + 32 * i * AT_PITCH) = kr[i]; *(LAS u32x4*)(nb + AT_TILE + sl0 + 32 * i * AT_PITCH) = vr[i]; }
        }
        __syncthreads();
        PIN_Q4(qf[0], qf[1], qf[2], qf[3]);
        f32x4 O[8]; float mrun = -1.0e30f, lsum = 0.f;
#pragma unroll
        for (int eb = 0; eb < 8; ++eb) O[eb] = (f32x4){0.f, 0.f, 0.f, 0.f};
        for (int tt = t0; tt < 4; ++tt) {
            const bool more = (tt + 1 < 4);
            if (more) {
#pragma unroll
                for (int i = 0; i < 2; ++i) { kr[i] = *(const u32x4*)DIL_KPTR(2 * (tt + 1) + i); vr[i] = *(const u32x4*)(DIL_KPTR(2 * (tt + 1) + i) + 512); }
            }
            const LAS unsigned char* Kt = lds + (tt & 1) * AT_BUF;
            const LAS unsigned char* Vt = Kt + AT_TILE;
            if (tt >= tlo && tt <= thi) {
                f32x4 Sx[4];
#pragma unroll
                for (int kb = 0; kb < 4; ++kb) Sx[kb] = (f32x4){0.f, 0.f, 0.f, 0.f};
#pragma unroll
                for (int ks = 0; ks < 4; ++ks)
#pragma unroll
                    for (int kb = 0; kb < 4; ++kb) {
                        const bf16x8 kf = *(const LAS bf16x8*)(Kt + (16 * kb + l15) * AT_PITCH + ks * 64 + kg * 16);
                        Sx[kb] = __builtin_amdgcn_mfma_f32_16x16x32_bf16(kf, qf[ks], Sx[kb], 0, 0, 0);
                    }
                {
                    const int m0 = qi + 128 - 64 * tt - 4 * kg;
                    float bv[4][4];
#pragma unroll
                    for (int kb = 0; kb < 4; ++kb)
#pragma unroll
                        for (int rr = 0; rr < 4; ++rr) { const int m = m0 - 16 * kb - rr; int di = m * dl; di = di < 0 ? 0 : (di > 127 ? 127 : di); bv[kb][rr] = lut[di]; }
#pragma unroll
                    for (int kb = 0; kb < 4; ++kb)
#pragma unroll
                        for (int rr = 0; rr < 4; ++rr) { const int m = m0 - 16 * kb - rr; Sx[kb][rr] = ((unsigned)m <= 128u) ? Sx[kb][rr] + bv[kb][rr] : -1.0e30f; }
                }
                float mx = fmaxf(fmaxf(hmax4(Sx[0]), hmax4(Sx[1])), fmaxf(hmax4(Sx[2]), hmax4(Sx[3])));
                mx = fmaxf(mx, __shfl_xor(mx, 16)); mx = fmaxf(mx, __shfl_xor(mx, 32));
                const float mnew = fmaxf(mrun, mx), alpha = fexp2(mrun - mnew);
                mrun = mnew;
#pragma unroll
                for (int kb = 0; kb < 4; ++kb)
#pragma unroll
                    for (int rr = 0; rr < 4; ++rr) Sx[kb][rr] = (Sx[kb][rr] < -1.0e29f) ? 0.f : fexp2(Sx[kb][rr] - mnew);
                const f32x4 pv4 = (Sx[0] + Sx[1]) + (Sx[2] + Sx[3]);
                lsum = lsum * alpha + ((pv4[0] + pv4[1]) + (pv4[2] + pv4[3]));
                if (__builtin_amdgcn_ballot_w64(alpha != 1.0f) != 0ull) {
#pragma unroll
                    for (int eb = 0; eb < 8; ++eb) O[eb] = O[eb] * alpha;
                }
                bf16x8 pf[2];
                pf[0] = pack_p(Sx[0], Sx[1]); pf[1] = pack_p(Sx[2], Sx[3]);
                const LAS unsigned char* vb = Vt + (4 * kg + (l15 >> 2)) * AT_PITCH + (l15 & 3) * 8;
#pragma unroll
                for (int c = 0; c < 2; ++c)
#pragma unroll
                    for (int eb = 0; eb < 8; ++eb) {
                        const bf16x8 vf = tr16x2(vb + (32 * c) * AT_PITCH + eb * 32, vb + (32 * c + 16) * AT_PITCH + eb * 32);
                        O[eb] = __builtin_amdgcn_mfma_f32_16x16x32_bf16(vf, pf[c], O[eb], 0, 0, 0);
                    }
            }
            if (more) {
                LAS unsigned char* nb = lds + ((tt + 1) & 1) * AT_BUF;
#pragma unroll
                for (int i = 0; i < 2; ++i) { *(LAS u32x4*)(nb + sl0 + 32 * i * AT_PITCH) = kr[i]; *(LAS u32x4*)(nb + AT_TILE + sl0 + 32 * i * AT_PITCH) = vr[i]; }
            }
            __syncthreads();
        }
        float l = lsum; l += __shfl_xor(l, 16); l += __shfl_xor(l, 32);
        float inv = 1.0f / l, lse = mrun + log2f(l);
        const size_t row = (size_t)b * SEQ + qpos;
        bf16* orow = Yo + row * YW + 2048 + h * 128 + 4 * kg;
        float wa = inv, wb = 0.f;
        if (g > 0) {
            const float lp = Lse[row * 4 + h];
            const float mm = fmaxf(lse, lp), ea = exp2f(lse - mm), eb_ = exp2f(lp - mm), tot = ea + eb_;
            wa = inv * ea / tot; wb = eb_ / tot; lse = mm + log2f(tot);
        }
#pragma unroll
        for (int eb = 0; eb < 8; ++eb) {
            f32x4 a = O[eb] * wa;
            if (g > 0) { const u32x2 p = *(const u32x2*)(orow + 16 * eb); a[0] += wb * bflo(p.x); a[1] += wb * bfhi(p.x); a[2] += wb * bflo(p.y); a[3] += wb * bfhi(p.y); }
            u32x2 w; w.x = cvtpk(a[0], a[1]); w.y = cvtpk(a[2], a[3]); *(u32x2*)(orow + 16 * eb) = w;
        }
        if (g < 2 && kg == 0) Lse[row * 4 + h] = lse;
    }
#undef DIL_KPTR
    __syncthreads();
}


constexpr int RS_VP = 160, RS_KT = 64 * AT_PITCH, RS_BUF = RS_KT + 64 * RS_VP;
constexpr size_t WS_ST = WS_S + 192 * MiB;
__device__ __forceinline__ void ret_state_phase(Frame& F, const bf16* R, bf16* ST) {
    int tid_ = threadIdx.x; asm volatile("" : "+v"(tid_));
    const int tid = tid_, lane = tid & 63, wave = F.wave, l15 = lane & 15, kg = lane >> 4;
    LAS unsigned char* lds = F.lds;
    for (int u = blockIdx.x; u < 256; u += F.G) {
        const int bh = u >> 2, es = u & 3, b = bh >> 2, h = bh & 3;
        const float l2g = log2f(1.0f - exp2f(-5.0f - (float)h));
        const float g256 = fexp2(256.0f * l2g);
        float cw[2][8];
#pragma unroll
        for (int c = 0; c < 2; ++c)
#pragma unroll
            for (int j = 0; j < 8; ++j) cw[c][j] = fexp2((float)(63 - (32 * c + 16 * (j >> 2) + 4 * kg + (j & 3))) * l2g);
        const bf16* base = R + (size_t)b * SEQ * N_RET;
        const int sr0 = tid >> 4, sc16 = tid & 15;
        const int vr0 = tid >> 3, vc = tid & 7;
        const bf16* kgp = base + (size_t)sr0 * N_RET + 512 + h * 128 + sc16 * 8;
        const bf16* vgp = base + (size_t)vr0 * N_RET + 1024 + h * 256 + es * 64 + vc * 8;
        const int ksl = sr0 * AT_PITCH + sc16 * 16, vsl = RS_KT + vr0 * RS_VP + vc * 16;
        u32x4 kr[2], vr;
#pragma unroll
        for (int i = 0; i < 2; ++i) kr[i] = *(const u32x4*)(kgp + (size_t)(32 * i) * N_RET);
        vr = *(const u32x4*)vgp;
        __syncthreads();
#pragma unroll
        for (int i = 0; i < 2; ++i) *(LAS u32x4*)(lds + ksl + 32 * i * AT_PITCH) = kr[i];
        *(LAS u32x4*)(lds + vsl) = vr;
        __syncthreads();
        f32x4 acc[4];
#pragma unroll
        for (int eb = 0; eb < 4; ++eb) acc[eb] = (f32x4){0.f, 0.f, 0.f, 0.f};
        for (int t = 0; t < 28; ++t) {
            const int k0 = t * 64;
            const bool more = (t + 1 < 28);
            if (more) {
#pragma unroll
                for (int i = 0; i < 2; ++i) kr[i] = *(const u32x4*)(kgp + (size_t)(k0 + 64 + 32 * i) * N_RET);
                vr = *(const u32x4*)(vgp + (size_t)(k0 + 64) * N_RET);
            }
            const LAS unsigned char* Kt = lds + (t & 1) * RS_BUF;
            const LAS unsigned char* Vt = Kt + RS_KT;
            const float tf = fexp2((float)(192 - 64 * (t & 3)) * l2g);
            const LAS unsigned char* kb_ = Kt + (4 * kg + (l15 >> 2)) * AT_PITCH + (16 * wave + 4 * (l15 & 3)) * 2;
            const LAS unsigned char* vb_ = Vt + (4 * kg + (l15 >> 2)) * RS_VP + (l15 & 3) * 8;
            bf16x8 kf[2], vf[2][4];
#pragma unroll
            for (int c = 0; c < 2; ++c) {
                kf[c] = tr16x2(kb_ + (32 * c) * AT_PITCH, kb_ + (32 * c + 16) * AT_PITCH);
#pragma unroll
                for (int eb = 0; eb < 4; ++eb) vf[c][eb] = tr16x2(vb_ + (32 * c) * RS_VP + eb * 32, vb_ + (32 * c + 16) * RS_VP + eb * 32);
            }
#pragma unroll
            for (int c = 0; c < 2; ++c) {
                const u32x4 w = __builtin_bit_cast(u32x4, kf[c]);
                u32x4 o;
                o.x = cvtpk(bflo(w.x) * (cw[c][0] * tf), bfhi(w.x) * (cw[c][1] * tf)); o.y = cvtpk(bflo(w.y) * (cw[c][2] * tf), bfhi(w.y) * (cw[c][3] * tf));
                o.z = cvtpk(bflo(w.z) * (cw[c][4] * tf), bfhi(w.z) * (cw[c][5] * tf)); o.w = cvtpk(bflo(w.w) * (cw[c][6] * tf), bfhi(w.w) * (cw[c][7] * tf));
                kf[c] = __builtin_bit_cast(bf16x8, o);
            }
#pragma unroll
            for (int c = 0; c < 2; ++c)
#pragma unroll
                for (int eb = 0; eb < 4; ++eb) acc[eb] = __builtin_amdgcn_mfma_f32_16x16x32_bf16(kf[c], vf[c][eb], acc[eb], 0, 0, 0);
            if ((t & 3) == 3) {
                bf16* st = ST + ((size_t)(bh * 7 + (t >> 2)) * 256 + es * 64 + l15) * 128 + 16 * wave + 4 * kg;
#pragma unroll
                for (int eb = 0; eb < 4; ++eb) { u32x2 w; w.x = cvtpk(acc[eb][0], acc[eb][1]); w.y = cvtpk(acc[eb][2], acc[eb][3]); *(u32x2*)(st + (size_t)(16 * eb) * 128) = w; acc[eb] = acc[eb] * g256; }
            }
            if (more) {
                LAS unsigned char* nb = lds + ((t + 1) & 1) * RS_BUF;
#pragma unroll
                for (int i = 0; i < 2; ++i) *(LAS u32x4*)(nb + ksl + 32 * i * AT_PITCH) = kr[i];
                *(LAS u32x4*)(nb + vsl) = vr;
            }
            __syncthreads();
        }
    }
    __syncthreads();
}

constexpr int RT_VP = 544, RT_KT = 64 * AT_PITCH, RT_BUF = RT_KT + 64 * RT_VP;
__device__ __forceinline__ void ret_phase(Frame& F, const bf16* R, const bf16* ST, const float* gn_gain, bf16* Yo) {
    int tid_ = threadIdx.x; asm volatile("" : "+v"(tid_));
    const int tid = tid_, lane = tid & 63, wave = F.wave, l15 = lane & 15, kg = lane >> 4;
    LAS unsigned char* lds = F.lds;
    for (int u = blockIdx.x; u < 1024; u += F.G) {
        const int bh = (u & 255) >> 2, qt = u & 3, jj = u >> 8;
        const int qb = 4 * jj + ((qt + jj) & 3);
        const int b = bh >> 2, h = bh & 3, Q0 = qb * 128, nt = Q0 / 64 + 2, scx = qb >> 1, t0 = 4 * scx;
        const int qw = Q0 + 16 * wave, tq = qw + l15;
        const float l2g = log2f(1.0f - exp2f(-5.0f - (float)h));
        f32x4 Bw[4];
#pragma unroll
        for (int kb = 0; kb < 4; ++kb)
#pragma unroll
            for (int rr = 0; rr < 4; ++rr) Bw[kb][rr] = fexp2((float)(63 - (16 * kb + 4 * kg + rr)) * l2g);
        const bf16* base = R + (size_t)b * SEQ * N_RET;
        bf16x8 qf[4];
#pragma unroll
        for (int ks = 0; ks < 4; ++ks) qf[ks] = *(const bf16x8*)(base + (size_t)tq * N_RET + h * 128 + 32 * ks + 8 * kg);
        const int sr0 = tid >> 4, sc = tid & 15;
        const int vr0 = tid >> 5, vc = tid & 31;
        const bf16* kgp = base + (size_t)sr0 * N_RET + 512 + h * 128 + sc * 8;
        const bf16* vgp = base + (size_t)vr0 * N_RET + 1024 + h * 256 + vc * 8;
        const int ksl = sr0 * AT_PITCH + sc * 16, vsl = RT_KT + vr0 * RT_VP + vc * 16;
        u32x4 kr[2], vr[4];
#pragma unroll
        for (int i = 0; i < 2; ++i) kr[i] = *(const u32x4*)(kgp + (size_t)(64 * t0 + 32 * i) * N_RET);
#pragma unroll
        for (int i = 0; i < 4; ++i) vr[i] = *(const u32x4*)(vgp + (size_t)(64 * t0 + 16 * i) * N_RET);
        f32x4 O[16];
#pragma unroll
        for (int eb = 0; eb < 16; ++eb) O[eb] = (f32x4){0.f, 0.f, 0.f, 0.f};
        if (scx > 0) {
            const bf16* stp = ST + ((size_t)(bh * 7 + scx - 1) * 256 + l15) * 128 + 8 * kg;
#pragma unroll
            for (int ebh = 0; ebh < 4; ++ebh) {
                bf16x8 sf[4][4];
#pragma unroll
                for (int e4 = 0; e4 < 4; ++e4)
#pragma unroll
                    for (int ks = 0; ks < 4; ++ks) sf[e4][ks] = *(const bf16x8*)(stp + (size_t)(16 * (4 * ebh + e4)) * 128 + 32 * ks);
#pragma unroll
                for (int ks = 0; ks < 4; ++ks)
#pragma unroll
                    for (int e4 = 0; e4 < 4; ++e4) O[4 * ebh + e4] = __builtin_amdgcn_mfma_f32_16x16x32_bf16(sf[e4][ks], qf[ks], O[4 * ebh + e4], 0, 0, 0);
            }
            const float fq = fexp2((float)(tq - 256 * scx + 1) * l2g);
#pragma unroll
            for (int eb = 0; eb < 16; ++eb) O[eb] = O[eb] * fq;
        }
        __syncthreads();
#pragma unroll
        for (int i = 0; i < 2; ++i) *(LAS u32x4*)(lds + (t0 & 1) * RT_BUF + ksl + 32 * i * AT_PITCH) = kr[i];
#pragma unroll
        for (int i = 0; i < 4; ++i) *(LAS u32x4*)(lds + (t0 & 1) * RT_BUF + vsl + 16 * i * RT_VP) = vr[i];
        __syncthreads();
        PIN_Q4(qf[0], qf[1], qf[2], qf[3]);
        for (int t = t0; t < nt; ++t) {
            const int k0 = t * 64;
            const bool more = (t + 1 < nt);
            if (more) {
#pragma unroll
                for (int i = 0; i < 2; ++i) kr[i] = *(const u32x4*)(kgp + (size_t)(k0 + 64 + 32 * i) * N_RET);
#pragma unroll
                for (int i = 0; i < 4; ++i) vr[i] = *(const u32x4*)(vgp + (size_t)(k0 + 64 + 16 * i) * N_RET);
            }
            const LAS unsigned char* Kt = lds + (t & 1) * RT_BUF;
            const LAS unsigned char* Vt = Kt + RT_KT;
            if (k0 <= qw + 15) {
                f32x4 Sx[4];
#pragma unroll
                for (int kb = 0; kb < 4; ++kb) Sx[kb] = (f32x4){0.f, 0.f, 0.f, 0.f};
#pragma unroll
                for (int ks = 0; ks < 4; ++ks)
#pragma unroll
                    for (int kb = 0; kb < 4; ++kb) {
                        const bf16x8 kf = *(const LAS bf16x8*)(Kt + (16 * kb + l15) * AT_PITCH + ks * 64 + kg * 16);
                        Sx[kb] = __builtin_amdgcn_mfma_f32_16x16x32_bf16(kf, qf[ks], Sx[kb], 0, 0, 0);
                    }
                const float at = fexp2((float)(tq - k0 - 63) * l2g);
#pragma unroll
                for (int kb = 0; kb < 4; ++kb) Sx[kb] = Sx[kb] * (Bw[kb] * at);
                if (k0 + 63 > qw) {
                    const int d0 = tq - k0 - 4 * kg;
#pragma unroll
                    for (int kb = 0; kb < 4; ++kb)
#pragma unroll
                        for (int rr = 0; rr < 4; ++rr) Sx[kb][rr] = (d0 - 16 * kb - rr >= 0) ? Sx[kb][rr] : 0.f;
                }
                bf16x8 pf[2];
                pf[0] = pack_p(Sx[0], Sx[1]); pf[1] = pack_p(Sx[2], Sx[3]);
                const LAS unsigned char* vb = Vt + (4 * kg + (l15 >> 2)) * RT_VP + (l15 & 3) * 8;
#pragma unroll
                for (int c = 0; c < 2; ++c)
#pragma unroll
                    for (int eb = 0; eb < 16; ++eb) {
                        const bf16x8 vf = tr16x2(vb + (32 * c) * RT_VP + eb * 32, vb + (32 * c + 16) * RT_VP + eb * 32);
                        O[eb] = __builtin_amdgcn_mfma_f32_16x16x32_bf16(vf, pf[c], O[eb], 0, 0, 0);
                    }
            }
            if (more) {
                LAS unsigned char* nb = lds + ((t + 1) & 1) * RT_BUF;
#pragma unroll
                for (int i = 0; i < 2; ++i) *(LAS u32x4*)(nb + ksl + 32 * i * AT_PITCH) = kr[i];
#pragma unroll
                for (int i = 0; i < 4; ++i) *(LAS u32x4*)(nb + vsl + 16 * i * RT_VP) = vr[i];
            }
            __syncthreads();
        }
        float sm = 0.f;
#pragma unroll
        for (int eb = 0; eb < 16; ++eb) sm += (O[eb][0] + O[eb][1]) + (O[eb][2] + O[eb][3]);
        sm += __shfl_xor(sm, 16); sm += __shfl_xor(sm, 32);
        const float mean = sm * (1.0f / 256.0f);
        float sq = 0.f;
#pragma unroll
        for (int eb = 0; eb < 16; ++eb) { O[eb] = O[eb] - mean; sq += (O[eb][0] * O[eb][0] + O[eb][1] * O[eb][1]) + (O[eb][2] * O[eb][2] + O[eb][3] * O[eb][3]); }
        sq += __shfl_xor(sq, 16); sq += __shfl_xor(sq, 32);
        const float rstd = 1.0f / sqrtf(sq * (1.0f / 256.0f) + 1e-5f);
        const size_t row = (size_t)b * SEQ + tq;
        const bf16* grow = R + row * N_RET + 2048 + h * 256 + 4 * kg;
        bf16* orow = Yo + row * YW + h * 256 + 4 * kg;
        const float* gg = gn_gain + h * 256 + 4 * kg;
#pragma unroll
        for (int eb = 0; eb < 16; ++eb) {
            const f32x4 gq = *(const f32x4*)(gg + 16 * eb);
            const u32x2 gv = *(const u32x2*)(grow + 16 * eb);
            const float g0 = bflo(gv.x), g1 = bfhi(gv.x), g2 = bflo(gv.y), g3 = bfhi(gv.y);
            const float o0 = O[eb][0] * rstd * gq[0] * (g0 * sigmoidf_(g0)), o1 = O[eb][1] * rstd * gq[1] * (g1 * sigmoidf_(g1));
            const float o2 = O[eb][2] * rstd * gq[2] * (g2 * sigmoidf_(g2)), o3 = O[eb][3] * rstd * gq[3] * (g3 * sigmoidf_(g3));
            u32x2 w; w.x = cvtpk(o0, o1); w.y = cvtpk(o2, o3);
            *(u32x2*)(orow + 16 * eb) = w;
        }
    }
    __syncthreads();
}

__device__ __forceinline__ void phase_final(Frame& F, float* out, const float* gain) {
    int lane = threadIdx.x & 63; asm volatile("" : "+v"(lane));
    const int gw = F.vcu * NWAVES + F.wave, NGW = F.G * NWAVES;
    for (int m = gw; m < M; m += NGW) {
        f32x4* xr = (f32x4*)(out + (size_t)m * D) + lane;
        f32x4 v[4]; float s = 0.f;
#pragma unroll
        for (int j = 0; j < 4; ++j) { v[j] = xr[64 * j]; s += (v[j][0] * v[j][0] + v[j][1] * v[j][1]) + (v[j][2] * v[j][2] + v[j][3] * v[j][3]); }
        const float rs = 1.0f / sqrtf(wave_sum(s) * (1.0f / D) + 1e-6f);
#pragma unroll
        for (int j = 0; j < 4; ++j) { const f32x4 gq = *((const f32x4*)gain + lane + 64 * j); xr[64 * j] = v[j] * rs * gq; }
    }
}

constexpr int PH_PER_LAYER = 18;
constexpr int N_PHASES = DEPTH * PH_PER_LAYER + 1;

__global__ void __launch_bounds__(NWAVES * 64, 2) mk_fwd(Args args) {
    extern __shared__ __attribute__((aligned(16))) unsigned char lds[];
    Frame F;
    F.lds = (LAS unsigned char*)lds;
    F.MISC = (volatile LAS unsigned*)(F.lds + MISC_OFF);
    F.wave = __builtin_amdgcn_readfirstlane((int)threadIdx.x >> 6);
    F.G = gridDim.x; { const int bx = blockIdx.x; F.vcu = (F.G % 8 == 0) ? (bx % 8) * (F.G / 8) + bx / 8 : bx; }
    unsigned char* ws = args.ws;
    F.ctl = (gu32*)(ws + WS_CTL);
    for (int u = threadIdx.x; u < (LDS_BYTES - LDSCTL_OFF) / 4; u += NWAVES * 64) ((LAS unsigned*)(F.lds + LDSCTL_OFF))[u] = 0u;
    __syncthreads();
#if MK_PER_PHASE
#define GRID_BAR() do { } while (0)
#else
    XcdBarrier bar = xcd_barrier_post((unsigned*)(F.ctl + CW_BAR), F.MISC + 8);
#define GRID_BAR() xcd_barrier(bar)
#endif
    const int lo = args.ph_lo, hi = args.ph_hi;
    int ph = 0;
#define PHASE_BEGIN if (ph >= lo && ph < hi) {
#define PHASE_END   if (ph + 1 < hi) GRID_BAR(); } ++ph;

#define WIN ((bf16*)(ws + WS_WIN))
#define WBR ((bf16*)(ws + WS_WBR))
#define WOUT ((bf16*)(ws + WS_WOUT))
#define WGU ((bf16*)(ws + WS_WGU))
#define WDN ((bf16*)(ws + WS_WDN))
#define XB ((bf16*)(ws + WS_XB))
#define Y ((bf16*)(ws + WS_Y))
#define S ((bf16*)(ws + WS_S))
#define XB2 ((bf16*)(ws + WS_XB2))
#define HID ((bf16*)(ws + WS_HID))
#define RSS ((float*)(ws + WS_RSS))
#define RSTD ((float*)(ws + WS_RSTD))
#define CS ((const float*)(ws + WS_CS))
#define BLUT ((const float*)(ws + WS_BLUT))
#define DILP ((float*)(ws + WS_DILP))
#define DILS ((float*)(ws + WS_DILS))

    for (int l = 0; l < DEPTH; ++l) {
        PHASE_BEGIN if (EN_CONV) phase_convert(F, args, l); PHASE_END

        for (int sub = 0; sub < 6; ++sub) {
            const int coff = (sub == 0) ? C_RET : (sub == 1) ? C_DIFF : (sub <= 4) ? (C_DIL + (sub - 2) * N_DILG) : C_GATE;
            const int nsub = (sub >= 2 && sub <= 4) ? N_DILG : 3072;
            PHASE_BEGIN {
                pg8::Gemm g{XB, WIN + (size_t)coff * D, D, D, M, nsub, D}; pg8::StaticOrder So; So.init(M, nsub, F.G, (int)blockIdx.x);
                pg8::EpiIn E{S, nsub, RSTD, CS, (sub == 0) ? 1 : (sub == 5 ? 2 : ((sub == 1 && DIFF_MFMA) ? 3 : ((sub >= 2 && sub <= 4 && DIL_MFMA) ? 4 : 0)))};
                if (EN_IN) for (int rep = 0; rep < REP_IN; ++rep) pg8::gemm_phase<pg8::EpiIn, pg8::StaticOrder, true>(F.lds + RING_OFF, g, So, E);
            } PHASE_END
            if (sub == 0) {
#if RET_MFMA
                PHASE_BEGIN if (EN_RET) ret_state_phase(F, S, (bf16*)(ws + WS_ST)); PHASE_END
                PHASE_BEGIN if (EN_RET) for (int rep = 0; rep < REP_RET; ++rep) ret_phase(F, S, (const bf16*)(ws + WS_ST), args.gn_gain + l * 1024, Y); PHASE_END
#else
                PHASE_BEGIN if (EN_RET) naive_ret(F, S, args.gn_gain + l * 1024, Y); PHASE_END
                PHASE_BEGIN PHASE_END
#endif
            } else if (sub == 1) {
                const float lam_init = (l == 0) ? 0.2f : 0.35550906759096934f;
#if DIFF_MFMA
                PHASE_BEGIN if (EN_DIFF) for (int rep = 0; rep < REP_DIFF; ++rep) diff_attn_phase(F, S, args.diff_lambda + l * 256, lam_init, args.subln + l * 128, BLUT, Y); PHASE_END
#else
                PHASE_BEGIN if (EN_DIFF) naive_diff(F, S, args.diff_lambda + l * 256, lam_init, args.subln + l * 128, BLUT, Y); PHASE_END
#endif
            } else if (sub <= 4) {
#if DIL_MFMA
                PHASE_BEGIN if (EN_DIL) dil_attn_phase(F, S, sub - 2, BLUT, DILS, Y); PHASE_END
#else
                PHASE_BEGIN if (EN_DIL) naive_dil(F, S, sub - 2, BLUT, DILP, DILS, Y); PHASE_END
#endif
            }
        }
        PHASE_BEGIN {
            pg8::Gemm g{Y, WBR, YW, YW, M, D, D}; pg8::SegOrder So; So.init(M, D, F.G, (int)blockIdx.x);
            pg8::EpiMerge E{XB, S};
            if (EN_MERGE) for (int rep = 0; rep < REP_MERGE; ++rep) pg8::gemm_phase<pg8::EpiMerge, pg8::SegOrder, true>(F.lds + RING_OFF, g, So, E);
        } PHASE_END
        PHASE_BEGIN {
            pg8::Gemm g{XB, WOUT, D, D, M, D, D}; pg8::StaticOrder So; So.init(M, D, F.G, (int)blockIdx.x);
            pg8::EpiRes E{(l == 0) ? args.x : args.out, args.out, XB2, RSS};
            if (EN_OUT) pg8::gemm_phase<pg8::EpiRes, pg8::StaticOrder, true>(F.lds + RING_OFF, g, So, E);
        } PHASE_END
        PHASE_BEGIN rstd_reduce(F, RSS, RSTD); PHASE_END
        PHASE_BEGIN {
            pg8::Gemm g{XB2, WGU, D, D, M, 2 * FFN, D}; pg8::StaticOrder So; So.init(M, 2 * FFN, F.G, (int)blockIdx.x);
            pg8::EpiSwiGLU E{HID, RSTD};
            if (EN_UP) for (int rep = 0; rep < REP_UP; ++rep) pg8::gemm_phase<pg8::EpiSwiGLU, pg8::StaticOrder, true>(F.lds + RING_OFF, g, So, E);
        } PHASE_END
        PHASE_BEGIN {
            pg8::Gemm g{HID, WDN, FFN, FFN, M, D, FFN}; pg8::StaticOrder So; So.init(M, D, F.G, (int)blockIdx.x);
            pg8::EpiRes E{args.out, args.out, XB, RSS};
            if (EN_DOWN) pg8::gemm_phase<pg8::EpiRes, pg8::StaticOrder, true>(F.lds + RING_OFF, g, So, E);
        } PHASE_END
    }
    PHASE_BEGIN if (EN_FIN) phase_final(F, args.out, args.norm_final); PHASE_END
#undef PHASE_BEGIN
#undef PHASE_END
}

extern "C" void kernel_launch(void* const* d_in, const int* in_sizes, int n_in, void* d_out, int out_size, void* d_ws, size_t ws_size, hipStream_t stream) {
    static int grid = 0;
    if (grid == 0) {
        if (n_in != 16 || in_sizes[0] != M * D || out_size != M * D || ws_size < WS_END) { fprintf(stderr, "kernel_launch: unexpected shapes (n_in %d, ws %zu)\n", n_in, ws_size); grid = -1; return; }
        int dev = 0, cus = 0, per_cu = 0;
        if (hipGetDevice(&dev) != hipSuccess || hipDeviceGetAttribute(&cus, hipDeviceAttributeMultiprocessorCount, dev) != hipSuccess) { grid = -1; return; }
        if (hipFuncSetAttribute((const void*)mk_fwd, hipFuncAttributeMaxDynamicSharedMemorySize, LDS_BYTES) != hipSuccess) { grid = -1; return; }
        if (hipOccupancyMaxActiveBlocksPerMultiprocessor(&per_cu, (const void*)mk_fwd, NWAVES * 64, LDS_BYTES) != hipSuccess || per_cu < 1) { fprintf(stderr, "kernel_launch: occupancy query says %d\n", per_cu); }
        (void)hipGetLastError();
        grid = cus;
    }
    if (grid < 0) return;
    if (hipMemsetAsync((char*)d_ws + WS_CTL, 0, CTL_ZERO_BYTES, stream) != hipSuccess) return;
    Args a{};
    a.x = (const float*)d_in[0]; a.w_in = (const float*)d_in[1]; a.w_br_ret = (const float*)d_in[2]; a.w_br_diff = (const float*)d_in[3]; a.w_br_dil = (const float*)d_in[4];
    a.w_out = (const float*)d_in[5]; a.norm_mix = (const float*)d_in[6]; a.norm_ffn = (const float*)d_in[7]; a.gn_gain = (const float*)d_in[8]; a.diff_lambda = (const float*)d_in[9];
    a.subln = (const float*)d_in[10]; a.rel_bias = (const float*)d_in[11]; a.w_gate = (const float*)d_in[12]; a.w_up = (const float*)d_in[13]; a.w_down = (const float*)d_in[14];
    a.norm_final = (const float*)d_in[15];
    a.out = (float*)d_out; a.ws = (unsigned char*)d_ws;
#if MK_PER_PHASE
    for (int p = 0; p < N_PHASES; ++p) {
        a.ph_lo = p; a.ph_hi = p + 1;
        hipLaunchKernelGGL(mk_fwd, dim3(grid), dim3(NWAVES * 64), LDS_BYTES, stream, a);
    }
#else
    a.ph_lo = 0; a.ph_hi = N_PHASES;
    hipLaunchKernelGGL(mk_fwd, dim3(grid), dim3(NWAVES * 64), LDS_BYTES, stream, a);
#endif
}
```

```cpp
#include <hip/hip_runtime.h>
#include <cstdio>
#include <cstdint>

#ifndef MK_PER_PHASE
#define MK_PER_PHASE 0
#endif


#ifndef DIFF_MFMA
#define DIFF_MFMA 1
#endif
#ifndef DIL_MFMA
#define DIL_MFMA 1
#endif
#ifndef RET_MFMA
#define RET_MFMA 1
#endif
#ifndef REP_IN
#define REP_IN 1
#endif
#ifndef REP_RET
#define REP_RET 1
#endif
#ifndef REP_DIFF
#define REP_DIFF 1
#endif
#ifndef REP_MERGE
#define REP_MERGE 1
#endif
#ifndef REP_UP
#define REP_UP 1
#endif
#ifndef PROBE_DIFF
#define PROBE_DIFF 0
#endif
#ifndef EN_ALL
#define EN_ALL 1
#endif
#ifndef EN_CONV
#define EN_CONV EN_ALL
#endif
#ifndef EN_IN
#define EN_IN EN_ALL
#endif
#ifndef EN_RET
#define EN_RET EN_ALL
#endif
#ifndef EN_DIFF
#define EN_DIFF EN_ALL
#endif
#ifndef EN_DIL
#define EN_DIL EN_ALL
#endif
#ifndef EN_MERGE
#define EN_MERGE EN_ALL
#endif
#ifndef EN_OUT
#define EN_OUT EN_ALL
#endif
#ifndef EN_UP
#define EN_UP EN_ALL
#endif
#ifndef EN_DOWN
#define EN_DOWN EN_ALL
#endif
#ifndef EN_FIN
#define EN_FIN EN_ALL
#endif
#define GAS __attribute__((address_space(1)))
#define LAS __attribute__((address_space(3)))
typedef unsigned short bf16;
typedef unsigned short bf16_t;
typedef short bf16x8 __attribute__((ext_vector_type(8)));
typedef float f32x4 __attribute__((ext_vector_type(4)));
typedef float f32x2 __attribute__((ext_vector_type(2)));
typedef unsigned u32x4 __attribute__((ext_vector_type(4)));
typedef unsigned u32x2 __attribute__((ext_vector_type(2)));

constexpr int BATCH = 16, SEQ = 2048, D = 1024, M = BATCH * SEQ, DEPTH = 2;
constexpr int IN_W = 13824, FFN = 2816;
constexpr int C_RET = 0, C_DIFF = 3072, C_DIL = 6144, C_GATE = 10752;
constexpr int N_RET = 3072, N_DIFF = 3072, N_DILG = 1536, N_GATE = 3072;
constexpr int YW = 2560;
constexpr int NWAVES = 8;

constexpr size_t MiB = 1u << 20;
constexpr size_t WS_CTL = 0, CTL_ZERO_BYTES = 1 * MiB;
constexpr size_t WS_CS = 1 * MiB;
constexpr size_t WS_BLUT = 2 * MiB;
constexpr size_t WS_RSS = 3 * MiB;
constexpr size_t WS_RSTD = 5 * MiB;
constexpr size_t WS_WIN = 8 * MiB;
constexpr size_t WS_WBR = 35 * MiB;
constexpr size_t WS_WOUT = 40 * MiB;
constexpr size_t WS_WGU = 42 * MiB;
constexpr size_t WS_WDN = 53 * MiB;
constexpr size_t WS_XB = 60 * MiB;
constexpr size_t WS_Y = 124 * MiB;
constexpr size_t WS_S = 284 * MiB;
constexpr size_t WS_XB2 = 300 * MiB;
constexpr size_t WS_HID = 124 * MiB;
constexpr size_t WS_DILP = WS_S + 96 * MiB;
constexpr size_t WS_DILS = WS_DILP + 64 * MiB;
constexpr size_t WS_END = 512 * MiB;

constexpr int CW_TMO = 0;
constexpr int CW_BAR = 4096;

constexpr int RING_OFF = 0, RING_BYTES = 131072;
constexpr int LDSCTL_OFF = RING_BYTES, MISC_OFF = LDSCTL_OFF + 320;
constexpr int LDS_BYTES = 147456;

typedef GAS unsigned gu32;
#define RLX_AGENT __ATOMIC_RELAXED, __HIP_MEMORY_SCOPE_AGENT
#define LDS_WAIT() asm volatile("s_waitcnt lgkmcnt(0)" ::: "memory")
#define VM_WAIT() asm volatile("s_waitcnt vmcnt(0)" ::: "memory")

__device__ __forceinline__ unsigned f2bf(float f) { unsigned u = __builtin_bit_cast(unsigned, f); return (u + 0x7fffu + ((u >> 16) & 1u)) >> 16; }
__device__ __forceinline__ unsigned pk2(float lo, float hi) { return f2bf(lo) | (f2bf(hi) << 16); }
__device__ __forceinline__ float bflo(unsigned w) { return __builtin_bit_cast(float, w << 16); }
__device__ __forceinline__ float bfhi(unsigned w) { return __builtin_bit_cast(float, w & 0xffff0000u); }
__device__ __forceinline__ float wave_sum(float v) {
#pragma unroll
    for (int o = 1; o < 64; o <<= 1) v += __shfl_xor(v, o);
    return v;
}
__device__ __forceinline__ float wave_max(float v) {
#pragma unroll
    for (int o = 1; o < 64; o <<= 1) v = fmaxf(v, __shfl_xor(v, o));
    return v;
}
__device__ __forceinline__ float rdlane(float v, int j) { return __builtin_bit_cast(float, __builtin_amdgcn_readlane(__builtin_bit_cast(int, v), j)); }
__device__ __forceinline__ float sigmoidf_(float x) { return 1.0f / (1.0f + __expf(-x)); }

__device__ __forceinline__ int lane_now() { int x; asm volatile("v_mbcnt_lo_u32_b32 %0, -1, 0\n\tv_mbcnt_hi_u32_b32 %0, -1, %0" : "=v"(x)); return x; }
#define TID_NOW(wave_) ((wave_) * 64 + lane_now())
__device__ const double ROPE_INV[64] = {1.0,0.8659643233600653,0.7498942093324559,0.6493816315762113,0.5623413251903491,0.4869675251658631,0.4216965034285822,0.3651741272548377,0.31622776601683794,0.27384196342643613,0.23713737056616552,0.2053525026457146,0.1778279410038923,0.1539926526059492,0.1333521432163324,0.11547819846894582,0.1,0.08659643233600653,0.07498942093324558,0.06493816315762113,0.05623413251903491,0.04869675251658631,0.042169650342858224,0.03651741272548377,0.03162277660168379,0.027384196342643614,0.023713737056616554,0.02053525026457146,0.01778279410038923,0.01539926526059492,0.01333521432163324,0.011547819846894581,0.01,0.008659643233600654,0.007498942093324558,0.006493816315762113,0.005623413251903491,0.004869675251658631,0.004216965034285823,0.003651741272548377,0.0031622776601683794,0.0027384196342643613,0.0023713737056616554,0.002053525026457146,0.0017782794100389228,0.001539926526059492,0.001333521432163324,0.0011547819846894581,0.001,0.0008659643233600654,0.0007498942093324559,0.0006493816315762113,0.0005623413251903491,0.0004869675251658631,0.00042169650342858224,0.0003651741272548377,0.00031622776601683794,0.0002738419634264361,0.00023713737056616554,0.0002053525026457146,0.00017782794100389227,0.0001539926526059492,0.0001333521432163324,0.00011547819846894582};
__device__ const unsigned char REL_BUCKET[128] = {0,1,2,3,4,5,6,7,8,9,10,11,12,13,14,15,16,16,16,17,17,18,18,18,19,19,19,20,20,20,20,21,21,21,21,22,22,22,22,22,23,23,23,23,23,23,24,24,24,24,24,24,25,25,25,25,25,25,25,26,26,26,26,26,26,26,26,27,27,27,27,27,27,27,27,27,27,28,28,28,28,28,28,28,28,28,28,29,29,29,29,29,29,29,29,29,29,29,29,30,30,30,30,30,30,30,30,30,30,30,30,30,30,31,31,31,31,31,31,31,31,31,31,31,31,31,31,31};

typedef __bf16 bf16x2_t __attribute__((ext_vector_type(2)));
__device__ __forceinline__ unsigned cvtpk(float lo, float hi) { const f32x2 v = {lo, hi}; const bf16x2_t b = __builtin_convertvector(v, bf16x2_t); return __builtin_bit_cast(unsigned, b); }
namespace pg8 {
#define PG8_LAS __attribute__((address_space(3)))
constexpr int BM = 256, BK = 64, HALF = 128, HTB = HALF * BK * 2, STAGE_BYTES = 8 * HTB, NXCD = 8, WGM = 8;
__host__ __device__ __forceinline__ int lds_byte(int r, int c) { const int st = (r >> 4) * 2 + (c >> 5), rr = r & 15, cc = c & 31, ob = rr * 64 + cc * 2; return st * 1024 + (ob ^ (((ob >> 9) & 1) << 5)); }
__host__ __device__ __forceinline__ void stage_rc(int b, int& R, int& C) { const int st = b / 1024, sb = b % 1024, swz = sb ^ (((sb >> 9) & 1) << 5); R = (st >> 1) * 16 + swz / 64; C = (st & 1) * 32 + (swz % 64) / 2; }
__host__ __device__ __forceinline__ int perm32(int rho) { const int n = rho >> 4, i = rho & 15; return 8 * (i >> 2) + 4 * n + (i & 3); }

struct Unit { int pm, pn, seg; };
struct Gemm { const bf16_t* A; const bf16_t* Bt; int lda, ldb, M, N, K; };

struct StaticOrder {
    int nM, nN, nwg, G, c;
    __device__ void init(int M_, int N_, int G_, int c_) { nM = M_ / BM; nN = N_ / BM; nwg = nM * nN; G = G_; c = c_; }
    __device__ __forceinline__ bool tile(int i, Unit& u) const {
        const long L = (long)i * G + c; if (L >= nwg) return false;
        int wgid = (int)L; { const int q = nwg / NXCD, r = nwg % NXCD, xcd = wgid % NXCD, off = wgid / NXCD; wgid = (xcd < r ? xcd * (q + 1) : r * (q + 1) + (xcd - r) * q) + off; }
        const int nig = WGM * nN, gid = wgid / nig, fm = gid * WGM, gsz = (nM - fm) < WGM ? (nM - fm) : WGM;
        u.pm = fm + ((wgid % nig) % gsz); u.pn = (wgid % nig) / gsz; return true;
    }
    __device__ __forceinline__ bool next(int i, Unit& u) const { u.seg = 0; return tile(i, u); }
    __device__ __forceinline__ const char* abase(const Gemm& g, const Unit& u) const { return (const char*)g.A + (size_t)u.pm * BM * g.lda * 2; }
    __device__ __forceinline__ const char* bbase(const Gemm& g, const Unit& u) const { return (const char*)g.Bt + (size_t)u.pn * BM * g.ldb * 2; }
    __device__ __forceinline__ int nt(const Gemm& g, const Unit&) const { return g.K / BK; }
};
struct SegOrder : StaticOrder {
    __device__ __forceinline__ bool next(int i, Unit& u) const { u.seg = i % 3; return tile(i / 3, u); }
    __device__ __forceinline__ const char* abase(const Gemm& g, const Unit& u) const { return (const char*)g.A + (size_t)u.pm * BM * g.lda * 2 + (size_t)u.seg * 2048; }
    __device__ __forceinline__ const char* bbase(const Gemm& g, const Unit& u) const { return (const char*)g.Bt + (size_t)u.pn * BM * g.ldb * 2 + (size_t)u.seg * 2048; }
    __device__ __forceinline__ int nt(const Gemm&, const Unit& u) const { return u.seg < 2 ? 16 : 8; }
};

__device__ __forceinline__ unsigned cvt_pk_bf16(float lo, float hi) { unsigned r; asm volatile("v_cvt_pk_bf16_f32 %0, %1, %2" : "=v"(r) : "v"(lo), "v"(hi)); return r; }

struct EpiIn {
    static constexpr bool PERM = true, AFTER_DRAIN = false;
    bf16_t* O; int ldc; const float* rstd; const float* cs; int mode;
    __device__ __forceinline__ void operator()(const f32x4 (&acc)[2][2][4][2], const Unit& u, int wr, int wc, int fr, int fq) const {
        const int row0 = u.pm * BM + wr * 64 + fr, col0 = u.pn * BM + wc * 32 + 8 * fq;
        const bool rot = (mode == 1) && (u.pn < 4);
        float sc = 1.0f;
        if (rot && u.pn >= 2) sc = 0.08838834764831845f;
        if (mode == 3 && u.pn < 4) sc = 0.18033688011112042f;
        if (mode == 4 && u.pn < 2) sc = 0.12751743082459868f;
        float rs[2][4];
#pragma unroll
        for (int ai = 0; ai < 2; ++ai)
#pragma unroll
            for (int m = 0; m < 4; ++m) rs[ai][m] = rstd[row0 + ai * HALF + m * 16];
        if (rot) {
#pragma unroll
            for (int ai = 0; ai < 2; ++ai) {
                f32x4 c01[4], c23[4];
#pragma unroll
                for (int m = 0; m < 4; ++m) { const f32x4* cp = (const f32x4*)(cs + ((size_t)((row0 + ai * HALF + m * 16) & (SEQ - 1)) * 64 + 16 * wc + 4 * fq) * 2); c01[m] = cp[0]; c23[m] = cp[1]; }
#pragma unroll
                for (int m = 0; m < 4; ++m) {
                    const float r = rs[ai][m] * sc;
                    bf16_t* rowp = O + (size_t)(row0 + ai * HALF + m * 16) * ldc + col0;
#pragma unroll
                    for (int bj = 0; bj < 2; ++bj) {
                        const f32x4 v0 = acc[ai][bj][m][0] * r, v1 = acc[ai][bj][m][1] * r;
                        u32x4 w;
                        w.x = cvtpk(v0[0] * c01[m][0] - v0[1] * c01[m][1], v0[0] * c01[m][1] + v0[1] * c01[m][0]);
                        w.y = cvtpk(v0[2] * c01[m][2] - v0[3] * c01[m][3], v0[2] * c01[m][3] + v0[3] * c01[m][2]);
                        w.z = cvtpk(v1[0] * c23[m][0] - v1[1] * c23[m][1], v1[0] * c23[m][1] + v1[1] * c23[m][0]);
                        w.w = cvtpk(v1[2] * c23[m][2] - v1[3] * c23[m][3], v1[2] * c23[m][3] + v1[3] * c23[m][2]);
                        *(u32x4*)(rowp + bj * HALF) = w;
                    }
                }
            }
        } else {
#pragma unroll
            for (int ai = 0; ai < 2; ++ai)
#pragma unroll
                for (int m = 0; m < 4; ++m) {
                    const float r = rs[ai][m] * sc;
                    bf16_t* rowp = O + (size_t)(row0 + ai * HALF + m * 16) * ldc + col0;
#pragma unroll
                    for (int bj = 0; bj < 2; ++bj) {
                        f32x4 v0 = acc[ai][bj][m][0] * r, v1 = acc[ai][bj][m][1] * r;
                        if (mode == 2) {
#pragma unroll
                            for (int j = 0; j < 4; ++j) { v0[j] = sigmoidf_(v0[j]); v1[j] = sigmoidf_(v1[j]); }
                        }
                        u32x4 w; w.x = cvtpk(v0[0], v0[1]); w.y = cvtpk(v0[2], v0[3]); w.z = cvtpk(v1[0], v1[1]); w.w = cvtpk(v1[2], v1[3]);
                        *(u32x4*)(rowp + bj * HALF) = w;
                    }
                }
        }
    }
};
struct EpiMerge {
    static constexpr bool PERM = true, AFTER_DRAIN = false;
    bf16_t* O; const bf16_t* Gt;
    __device__ __forceinline__ void operator()(const f32x4 (&acc)[2][2][4][2], const Unit& u, int wr, int wc, int fr, int fq) const {
        const int row0 = u.pm * BM + wr * 64 + fr, col0 = u.pn * BM + wc * 32 + 8 * fq;
#pragma unroll
        for (int ai = 0; ai < 2; ++ai) {
            u32x4 g[4][2], p[4][2];
#pragma unroll
            for (int m = 0; m < 4; ++m)
#pragma unroll
                for (int bj = 0; bj < 2; ++bj) {
                    const int row = row0 + ai * HALF + m * 16, col = col0 + bj * HALF;
                    g[m][bj] = *(const u32x4*)(Gt + (size_t)row * N_GATE + u.seg * 1024 + col);
                    p[m][bj] = (u.seg > 0) ? *(const u32x4*)(O + (size_t)row * D + col) : (u32x4){0u, 0u, 0u, 0u};
                }
#pragma unroll
            for (int m = 0; m < 4; ++m)
#pragma unroll
                for (int bj = 0; bj < 2; ++bj) {
                    const int row = row0 + ai * HALF + m * 16, col = col0 + bj * HALF;
                    const f32x4 a0 = acc[ai][bj][m][0], a1 = acc[ai][bj][m][1];
                    const u32x4 gg = g[m][bj], pp = p[m][bj];
                    u32x4 w;
                    w.x = cvtpk(a0[0] * bflo(gg.x) + bflo(pp.x), a0[1] * bfhi(gg.x) + bfhi(pp.x));
                    w.y = cvtpk(a0[2] * bflo(gg.y) + bflo(pp.y), a0[3] * bfhi(gg.y) + bfhi(pp.y));
                    w.z = cvtpk(a1[0] * bflo(gg.z) + bflo(pp.z), a1[1] * bfhi(gg.z) + bfhi(pp.z));
                    w.w = cvtpk(a1[2] * bflo(gg.w) + bflo(pp.w), a1[3] * bfhi(gg.w) + bfhi(pp.w));
                    *(u32x4*)(O + (size_t)row * D + col) = w;
                }
        }
    }
};
struct EpiRes {
    static constexpr bool PERM = true, AFTER_DRAIN = false;
    const void* res; bf16_t* xb; float* rss; int res32;
    __device__ __forceinline__ void operator()(const f32x4 (&acc)[2][2][4][2], const Unit& u, int wr, int wc, int fr, int fq) const {
        const int row0 = u.pm * BM + wr * 64 + fr, col0 = u.pn * BM + wc * 32 + 8 * fq;
#pragma unroll
        for (int ai = 0; ai < 2; ++ai) {
            f32x4 r[4][2][2];
            if (res32) {
#pragma unroll
                for (int m = 0; m < 4; ++m)
#pragma unroll
                    for (int bj = 0; bj < 2; ++bj) { const f32x4* p = (const f32x4*)((const float*)res + (size_t)(row0 + ai * HALF + m * 16) * D + col0 + bj * HALF); r[m][bj][0] = p[0]; r[m][bj][1] = p[1]; }
            } else {
                u32x4 q[4][2];
#pragma unroll
                for (int m = 0; m < 4; ++m)
#pragma unroll
                    for (int bj = 0; bj < 2; ++bj) q[m][bj] = *(const u32x4*)((const bf16_t*)res + (size_t)(row0 + ai * HALF + m * 16) * D + col0 + bj * HALF);
#pragma unroll
                for (int m = 0; m < 4; ++m)
#pragma unroll
                    for (int bj = 0; bj < 2; ++bj) { const u32x4 w = q[m][bj]; r[m][bj][0] = (f32x4){bflo(w.x), bfhi(w.x), bflo(w.y), bfhi(w.y)}; r[m][bj][1] = (f32x4){bflo(w.z), bfhi(w.z), bflo(w.w), bfhi(w.w)}; }
            }
#pragma unroll
            for (int m = 0; m < 4; ++m) {
                const int row = row0 + ai * HALF + m * 16; float ss = 0.f;
#pragma unroll
                for (int bj = 0; bj < 2; ++bj) {
                    const f32x4 v0 = acc[ai][bj][m][0] + r[m][bj][0], v1 = acc[ai][bj][m][1] + r[m][bj][1];
                    ss += ((v0[0] * v0[0] + v0[1] * v0[1]) + (v0[2] * v0[2] + v0[3] * v0[3])) + ((v1[0] * v1[0] + v1[1] * v1[1]) + (v1[2] * v1[2] + v1[3] * v1[3]));
                    u32x4 w; w.x = cvtpk(v0[0], v0[1]); w.y = cvtpk(v0[2], v0[3]); w.z = cvtpk(v1[0], v1[1]); w.w = cvtpk(v1[2], v1[3]);
                    *(u32x4*)(xb + (size_t)row * D + col0 + bj * HALF) = w;
                }
                ss += __shfl_xor(ss, 16); ss += __shfl_xor(ss, 32);
                if (fq == 0) rss[(size_t)row * 16 + u.pn * 4 + wc] = ss;
            }
        }
    }
};
struct EpiSwiGLU {
    static constexpr bool PERM = true, AFTER_DRAIN = false;
    bf16_t* H; const float* rstd;
    __device__ __forceinline__ void operator()(const f32x4 (&acc)[2][2][4][2], const Unit& u, int wr, int wc, int fr, int fq) const {
        const int row0 = u.pm * BM + wr * 64 + fr, col0 = u.pn * HALF + wc * 32 + 8 * fq;
        float rsv[2][4];
#pragma unroll
        for (int ai = 0; ai < 2; ++ai)
#pragma unroll
            for (int m = 0; m < 4; ++m) rsv[ai][m] = rstd[row0 + ai * HALF + m * 16];
#pragma unroll
        for (int ai = 0; ai < 2; ++ai)
#pragma unroll
            for (int m = 0; m < 4; ++m) {
                const int row = row0 + ai * HALF + m * 16;
                const float rs = rsv[ai][m];
                f32x4 h0, h1;
#pragma unroll
                for (int j = 0; j < 4; ++j) {
                    const float g0 = acc[ai][0][m][0][j] * rs, g1 = acc[ai][0][m][1][j] * rs;
                    h0[j] = g0 * sigmoidf_(g0) * (acc[ai][1][m][0][j] * rs);
                    h1[j] = g1 * sigmoidf_(g1) * (acc[ai][1][m][1][j] * rs);
                }
                u32x4 w; w.x = cvtpk(h0[0], h0[1]); w.y = cvtpk(h0[2], h0[3]); w.z = cvtpk(h1[0], h1[1]); w.w = cvtpk(h1[2], h1[3]);
                *(u32x4*)(H + (size_t)row * FFN + col0) = w;
            }
    }
};

template <class Epi, class Sched, bool ALIGN_EPI>
__device__ __forceinline__ void gemm_phase(PG8_LAS unsigned char* lds, const Gemm g, const Sched& S, const Epi& E, const int wv) {
    int tid_ = TID_NOW(wv); asm volatile("" : "+v"(tid_));
    const int tid = tid_, wid = __builtin_amdgcn_readfirstlane(tid >> 6), lane = tid & 63, wr = wid >> 2, wc = wid & 3, fr = lane & 15, fq = lane >> 4;
    unsigned voffA[2], voffB[2];
#pragma unroll
    for (int i = 0; i < 2; ++i) { int R, C; stage_rc(tid * 16 + i * 8192, R, C); const int Rb = Epi::PERM ? ((R & ~31) + perm32(R & 31)) : R;
        voffA[i] = (unsigned)(R * g.lda + C) * 2u; voffB[i] = (unsigned)(Rb * g.ldb + C) * 2u; }
    const size_t kstep = (size_t)(BK * 2);
    const size_t hstepA = (size_t)HALF * g.lda * 2, hstepB = (size_t)HALF * g.ldb * 2;
    const unsigned ldsw = (unsigned)wid * 1024u;
    const int aoff = lds_byte(wr * 64 + fr, fq * 8), boff = lds_byte(wc * 32 + fr, fq * 8);
#define PG8_SA(b, h) (((b) * 2 + (h)) * HTB)
#define PG8_SB(b, h) ((4 + (b) * 2 + (h)) * HTB)
#define PG8_STAGE(bufoff, gbase, voff) do { _Pragma("unroll") for (int _i = 0; _i < 2; ++_i) \
        __builtin_amdgcn_global_load_lds((const unsigned*)((const char*)(gbase) + (voff)[_i]), (PG8_LAS unsigned*)(lds + (bufoff) + ldsw + _i * 8192), 16, 0, 0); } while (0)
#define PG8_LDA(dst, b, h) do { _Pragma("unroll") for (int m = 0; m < 4; ++m) _Pragma("unroll") for (int k = 0; k < 2; ++k) dst[m][k] = *(const PG8_LAS bf16x8*)(lds + PG8_SA(b, h) + aoff + m * 2048 + k * 1024); } while (0)
#define PG8_LDB(dst, b, h) do { _Pragma("unroll") for (int n = 0; n < 2; ++n) _Pragma("unroll") for (int k = 0; k < 2; ++k) dst[n][k] = *(const PG8_LAS bf16x8*)(lds + PG8_SB(b, h) + boff + n * 2048 + k * 1024); } while (0)
#define PG8_MMA(ai, bj, At, Bt) do { __builtin_amdgcn_s_setprio(1); _Pragma("unroll") for (int m = 0; m < 4; ++m) _Pragma("unroll") for (int n = 0; n < 2; ++n) _Pragma("unroll") for (int k = 0; k < 2; ++k) \
        acc[ai][bj][m][n] = __builtin_amdgcn_mfma_f32_16x16x32_bf16(Bt[n][k], At[m][k], acc[ai][bj][m][n], 0, 0, 0); __builtin_amdgcn_s_setprio(0); } while (0)
#define PG8_WAIT_V(n) asm volatile("s_waitcnt vmcnt(" #n ")" ::: "memory")
#define PG8_WAIT_L(n) asm volatile("s_waitcnt lgkmcnt(" #n ")" ::: "memory")
#define PG8_BAR __builtin_amdgcn_s_barrier()
#define PG8_SCHED __builtin_amdgcn_sched_barrier(0)
    Unit cur, nxt; int ui = 0;
    if (!S.next(0, cur)) return;
    f32x4 acc[2][2][4][2];
#pragma unroll
    for (int a = 0; a < 2; ++a)
#pragma unroll
        for (int b = 0; b < 2; ++b)
#pragma unroll
            for (int m = 0; m < 4; ++m)
#pragma unroll
                for (int n = 0; n < 2; ++n) acc[a][b][m][n] = (f32x4){0.f, 0.f, 0.f, 0.f};
    bf16x8 At[4][2], B0[2][2], B1[2][2];
    const char* cA = S.abase(g, cur); const char* cB = S.bbase(g, cur);
    PG8_STAGE(PG8_SB(0, 0), cB, voffB); PG8_STAGE(PG8_SB(0, 1), cB + hstepB, voffB); PG8_STAGE(PG8_SA(0, 0), cA, voffA); PG8_STAGE(PG8_SA(0, 1), cA + hstepA, voffA);
    if (wr == 1) PG8_BAR;
    PG8_WAIT_V(2); PG8_BAR;
    PG8_STAGE(PG8_SB(1, 0), cB + kstep, voffB); PG8_STAGE(PG8_SA(1, 0), cA + kstep, voffA); PG8_STAGE(PG8_SB(1, 1), cB + hstepB + kstep, voffB);
    PG8_WAIT_V(6); PG8_BAR;
    for (;;) {
        const bool has_next = S.next(ui + 1, nxt);
        const int nt = S.nt(g, cur);
        const char* nA = has_next ? S.abase(g, nxt) : cA; const char* nB = has_next ? S.bbase(g, nxt) : cB;
        for (int t = 0; t < nt; t += 2) {
            const bool last = (t == nt - 2);
            const char* a1 = cA + (size_t)(t + 1) * kstep;
            const char* a2 = last ? nA : cA + (size_t)(t + 2) * kstep; const char* b2 = last ? nB : cB + (size_t)(t + 2) * kstep;
            const char* a3 = a2 + kstep; const char* b3 = b2 + kstep;
            PG8_LDB(B0, 0, 0); PG8_LDB(B1, 0, 1); PG8_SCHED; PG8_LDA(At, 0, 0); PG8_STAGE(PG8_SA(1, 1), a1 + hstepA, voffA);
            PG8_WAIT_V(8); PG8_WAIT_L(0); PG8_BAR; PG8_MMA(0, 0, At, B0); PG8_MMA(0, 1, At, B1); PG8_BAR; PG8_SCHED;
            PG8_LDA(At, 0, 1); PG8_STAGE(PG8_SB(0, 0), b2, voffB); PG8_STAGE(PG8_SB(0, 1), b2 + hstepB, voffB); PG8_STAGE(PG8_SA(0, 0), a2, voffA);
            PG8_WAIT_V(8); PG8_WAIT_L(0); PG8_BAR; PG8_MMA(1, 0, At, B0); PG8_MMA(1, 1, At, B1); PG8_BAR; PG8_SCHED;
            PG8_LDB(B0, 1, 0); PG8_LDB(B1, 1, 1); PG8_SCHED; PG8_LDA(At, 1, 0); PG8_STAGE(PG8_SA(0, 1), a2 + hstepA, voffA);
            PG8_WAIT_V(8); PG8_WAIT_L(0); PG8_BAR; PG8_MMA(0, 0, At, B0); PG8_MMA(0, 1, At, B1); PG8_BAR; PG8_SCHED;
            PG8_LDA(At, 1, 1); PG8_STAGE(PG8_SB(1, 0), b3, voffB); PG8_STAGE(PG8_SB(1, 1), b3 + hstepB, voffB); PG8_STAGE(PG8_SA(1, 0), a3, voffA);
            PG8_WAIT_V(8); PG8_WAIT_L(0); PG8_BAR; PG8_MMA(1, 0, At, B0); PG8_MMA(1, 1, At, B1); PG8_BAR; PG8_SCHED;
        }
        if constexpr (ALIGN_EPI) { if (wr == 0) PG8_BAR; }
        E(acc, cur, wr, wc, fr, fq);
        if (!has_next) break;
#pragma unroll
        for (int a = 0; a < 2; ++a)
#pragma unroll
            for (int b = 0; b < 2; ++b)
#pragma unroll
                for (int m = 0; m < 4; ++m)
#pragma unroll
                    for (int n = 0; n < 2; ++n) acc[a][b][m][n] = (f32x4){0.f, 0.f, 0.f, 0.f};
        cur = nxt; cA = nA; cB = nB; ++ui;
        if constexpr (ALIGN_EPI) { if (wr == 1) PG8_BAR; }
    }
    PG8_WAIT_V(0);
    if constexpr (!ALIGN_EPI) { if (wr == 0) PG8_BAR; }
    PG8_BAR;
#undef PG8_SA
#undef PG8_SB
#undef PG8_STAGE
#undef PG8_LDA
#undef PG8_LDB
#undef PG8_MMA
#undef PG8_WAIT_V
#undef PG8_WAIT_L
#undef PG8_BAR
#undef PG8_SCHED
}
}

#define XB_TMO      128
#define XB_XCNT(j)  (256  + 64 * (j))
#define XB_XSUB(j)  (1280 + 64 * (j))
#define XB_XGEN(j)  (2304 + 64 * (j))
#define XB_TOP      3328
#define XB_TOPGEN   3392
#define XCD_BAR_WORDS 3456
#define XB_SPIN_CAP (1u << 18)

__device__ __forceinline__ unsigned xb_ld(unsigned* p)              { return __hip_atomic_load(p, __ATOMIC_RELAXED, __HIP_MEMORY_SCOPE_AGENT); }
__device__ __forceinline__ unsigned xb_add(unsigned* p, unsigned v) { return __hip_atomic_fetch_add(p, v, __ATOMIC_RELAXED, __HIP_MEMORY_SCOPE_AGENT); }
__device__ __forceinline__ unsigned xb_xcc_id() { return (unsigned)__builtin_amdgcn_s_getreg((3 << 11) | 20) & 0xFu; }
#define XB_SPIN(cond, bar) do { unsigned _sp = 0; while (cond) { __builtin_amdgcn_s_sleep(1); \
    if ((++_sp & 255u) == 0u) { if (xb_ld(&(bar)[XB_TMO])) break; if (_sp > XB_SPIN_CAP) { atomicAdd(&(bar)[XB_TMO], 1u); break; } } } } while (0)

struct XcdBarrier { unsigned* bar; unsigned x; volatile LAS unsigned* st; int wave; };

__device__ __forceinline__ XcdBarrier xcd_barrier_post(unsigned* bar, volatile LAS unsigned* st, int wave) {
    XcdBarrier b; b.bar = bar; b.x = xb_xcc_id(); b.st = st; b.wave = wave;
    if (TID_NOW(wave) == 0) (void)xb_add(&bar[XB_XCNT(b.x)], 1u);
    return b;
}
__device__ __forceinline__ void xcd_barrier_complete(unsigned* bar, unsigned x, unsigned& nloc, unsigned& nx) {
    const unsigned G = gridDim.x * gridDim.y * gridDim.z;
    unsigned sum, cnt, mine, sp = 0u;
    for (;;) {
        sum = 0u; cnt = 0u; mine = 0u;
#pragma unroll
        for (unsigned j = 0; j < 16; ++j) { const unsigned c = xb_ld(&bar[XB_XCNT(j)]); sum += c; cnt += (c > 0u) ? 1u : 0u; mine = (j == x) ? c : mine; }
        if (sum == G) break;
        __builtin_amdgcn_s_sleep(1);
        if ((++sp & 255u) == 0u) { if (xb_ld(&bar[XB_TMO])) break; if (sp > XB_SPIN_CAP) { atomicAdd(&bar[XB_TMO], 1u); break; } }
    }
    nloc = mine > 0u ? mine : 1u; nx = cnt > 0u ? cnt : 1u;
}
__device__ __forceinline__ void xcd_barrier(const XcdBarrier& b) {
    asm volatile("s_waitcnt vmcnt(0)" ::: "memory");
    __syncthreads();
    if (TID_NOW(b.wave) == 0) {
        unsigned* bar = b.bar;
        __builtin_amdgcn_s_waitcnt(0);
        unsigned nloc = b.st[0], nx = b.st[1];
        if (nloc == 0u) { xcd_barrier_complete(bar, b.x, nloc, nx); b.st[0] = nloc; b.st[1] = nx; }
        const unsigned old = xb_add(&bar[XB_XSUB(b.x)], 1u);
        const unsigned gen = old / nloc;
        if (old + 1u == (gen + 1u) * nloc) {
            __builtin_amdgcn_fence(__ATOMIC_RELEASE, "agent");
            asm volatile("s_waitcnt vmcnt(0)" ::: "memory");
            const unsigned og = xb_add(&bar[XB_TOP], 1u);
            const unsigned tg = og / nx;
            if (og + 1u == (tg + 1u) * nx) xb_add(&bar[XB_TOPGEN], 1u);
            else XB_SPIN(xb_ld(&bar[XB_TOPGEN]) == tg, bar);
            __builtin_amdgcn_fence(__ATOMIC_ACQUIRE, "agent");
            xb_add(&bar[XB_XGEN(b.x)], 1u);
            asm volatile("s_waitcnt vmcnt(0)" ::: "memory");
        } else {
            XB_SPIN(xb_ld(&bar[XB_XGEN(b.x)]) == gen, bar);
            __builtin_amdgcn_fence(__ATOMIC_ACQUIRE, "agent");
            asm volatile("s_waitcnt vmcnt(0)" ::: "memory");
        }
    }
    __syncthreads();
}

struct Frame {
    LAS unsigned char* lds;
    volatile LAS unsigned* MISC;
    gu32* ctl;
    int wave;
    int vcu, G;
};

__device__ __forceinline__ int dst_row(int map, int n) {
    if (map == 1) { if (n < 1024) { const int d = n & 127; return (n & ~127) + 2 * (d & 63) + (d >> 6); } return n; }
    if (map == 2) return (n >> 7) * 256 + (n & 127);
    if (map == 3) return (n >> 7) * 256 + 128 + (n & 127);
    return n;
}
__device__ __forceinline__ void tr_item(const float* W, int N, bf16* WT, int ldw, int koff, int map, const float* gain, LAS float* scr, int item, int lane) {
    const int nblk = N / 32, kb = item / nblk, nb = item % nblk, k0 = 64 * kb, n0 = 32 * nb;
    float wv[32];
#pragma unroll
    for (int i = 0; i < 32; ++i) wv[i] = W[(size_t)(k0 + 2 * i + (lane >> 5)) * N + n0 + (lane & 31)];
    if (gain) {
#pragma unroll
        for (int i = 0; i < 32; ++i) wv[i] *= gain[k0 + 2 * i + (lane >> 5)];
    }
#pragma unroll
    for (int i = 0; i < 32; ++i) scr[(2 * i + (lane >> 5)) * 33 + (lane & 31)] = wv[i];
    LDS_WAIT(); asm volatile("" ::: "memory");
    const int c = lane & 7;
#pragma unroll
    for (int j = 0; j < 4; ++j) { const int n = (lane >> 3) + 8 * j; const LAS float* s = scr + (8 * c) * 33 + n;
        u32x4 o; o.x = pk2(s[0 * 33], s[1 * 33]); o.y = pk2(s[2 * 33], s[3 * 33]); o.z = pk2(s[4 * 33], s[5 * 33]); o.w = pk2(s[6 * 33], s[7 * 33]);
        *(u32x4*)(WT + (size_t)dst_row(map, n0 + n) * ldw + koff + k0 + 8 * c) = o; }
    LDS_WAIT(); asm volatile("" ::: "memory");
}

struct Args {
    const float* x; const float* w_in; const float* w_br_ret; const float* w_br_diff; const float* w_br_dil; const float* w_out;
    const float* norm_mix; const float* norm_ffn; const float* gn_gain; const float* diff_lambda; const float* subln; const float* rel_bias;
    const float* w_gate; const float* w_up; const float* w_down; const float* norm_final;
    float* out; unsigned char* ws; int ph_lo, ph_hi;
};

__device__ __forceinline__ void rstd_reduce(Frame& F, const float* rss, float* rstd) {
    int tid = TID_NOW(F.wave); asm volatile("" : "+v"(tid));
    for (int row = F.vcu * NWAVES * 64 + tid; row < M; row += F.G * NWAVES * 64) {
        const f32x4* rp = (const f32x4*)(rss + (size_t)row * 16);
        const f32x4 a = rp[0], b = rp[1], c = rp[2], d = rp[3];
        const float ss = (((a[0] + a[1]) + (a[2] + a[3])) + ((b[0] + b[1]) + (b[2] + b[3]))) + (((c[0] + c[1]) + (c[2] + c[3])) + ((d[0] + d[1]) + (d[2] + d[3])));
        rstd[row] = 1.0f / sqrtf(ss * (1.0f / 1024.0f) + 1e-6f);
    }
}
__device__ __forceinline__ void phase_convert(Frame& F, const Args& a, int l) {
    int tid = TID_NOW(F.wave); asm volatile("" : "+v"(tid));
    const int lane = tid & 63;
    LAS float* scr = (LAS float*)(F.lds + RING_OFF + F.wave * 16384);
    const int gw = F.vcu * NWAVES + F.wave, NGW = F.G * NWAVES;
    unsigned char* ws = a.ws;
    constexpr int I_IN = 16 * (IN_W / 32), I_BR = 16 * 32, I_BL = 8 * 32, I_O = 16 * 32, I_G = 16 * (FFN / 32), I_D = (FFN / 64) * 32;
    constexpr int NITEMS = I_IN + 2 * I_BR + I_BL + I_O + 2 * I_G + I_D;
    for (int it = gw; it < NITEMS; it += NGW) {
        int r = it; const float* W; int N; bf16* WT; int ldw, koff = 0, map = 0; const float* gain = nullptr;
        if (r < I_IN) { W = a.w_in + (size_t)l * D * IN_W; N = IN_W; WT = (bf16*)(ws + WS_WIN); ldw = D; map = 1; gain = a.norm_mix + l * D; }
        else if ((r -= I_IN) < I_BR) { W = a.w_br_ret + (size_t)l * 1024 * D; N = D; WT = (bf16*)(ws + WS_WBR); ldw = YW; }
        else if ((r -= I_BR) < I_BR) { W = a.w_br_diff + (size_t)l * 1024 * D; N = D; WT = (bf16*)(ws + WS_WBR); ldw = YW; koff = 1024; }
        else if ((r -= I_BR) < I_BL) { W = a.w_br_dil + (size_t)l * 512 * D; N = D; WT = (bf16*)(ws + WS_WBR); ldw = YW; koff = 2048; }
        else if ((r -= I_BL) < I_O) { W = a.w_out + (size_t)l * D * D; N = D; WT = (bf16*)(ws + WS_WOUT); ldw = D; }
        else if ((r -= I_O) < I_G) { W = a.w_gate + (size_t)l * D * FFN; N = FFN; WT = (bf16*)(ws + WS_WGU); ldw = D; map = 2; gain = a.norm_ffn + l * D; }
        else if ((r -= I_G) < I_G) { W = a.w_up + (size_t)l * D * FFN; N = FFN; WT = (bf16*)(ws + WS_WGU); ldw = D; map = 3; gain = a.norm_ffn + l * D; }
        else { r -= I_G; W = a.w_down + (size_t)l * FFN * D; N = D; WT = (bf16*)(ws + WS_WDN); ldw = FFN; }
        tr_item(W, N, WT, ldw, koff, map, gain, scr, r, lane);
    }
    if (l > 0) rstd_reduce(F, (const float*)(ws + WS_RSS), (float*)(ws + WS_RSTD));
    if (l == 0) {
        bf16* XB = (bf16*)(ws + WS_XB); float* rss = (float*)(ws + WS_RSS);
        for (int m = gw; m < M; m += NGW) {
            const f32x4* xr = (const f32x4*)(a.x + (size_t)m * D) + lane;
            u32x2* o8 = (u32x2*)(XB + (size_t)m * D) + lane;
            float s = 0.f;
#pragma unroll
            for (int j = 0; j < 4; ++j) { const f32x4 v = xr[64 * j]; s += (v[0] * v[0] + v[1] * v[1]) + (v[2] * v[2] + v[3] * v[3]); u32x2 w; w.x = pk2(v[0], v[1]); w.y = pk2(v[2], v[3]); o8[64 * j] = w; }
            s = wave_sum(s);
            if (lane == 0) ((float*)(ws + WS_RSTD))[m] = 1.0f / sqrtf(s * (1.0f / 1024.0f) + 1e-6f);
        }
        float* cs = (float*)(ws + WS_CS);
        const int gt = F.vcu * NWAVES * 64 + tid, NT = F.G * NWAVES * 64;
        for (int idx = gt; idx < SEQ * 64; idx += NT) {
            const int pos = idx >> 6, i = idx & 63;
            const double t = (double)pos * ROPE_INV[i] * 0.15915494309189535;
            const double fr = t - floor(t);
            const float f = (float)fr;
            cs[2 * idx] = __builtin_amdgcn_cosf(f); cs[2 * idx + 1] = __builtin_amdgcn_sinf(f);
        }
        float* blut = (float*)(ws + WS_BLUT);
        for (int idx = gt; idx < 20 * 128; idx += NT) { const int h = idx >> 7, dist = idx & 127; blut[idx] = a.rel_bias[REL_BUCKET[dist] * 20 + h]; }
    }
}

__device__ __forceinline__ float dot8(const u32x4 a, const u32x4 b, float acc) {
    acc += bflo(a.x) * bflo(b.x); acc += bfhi(a.x) * bfhi(b.x); acc += bflo(a.y) * bflo(b.y); acc += bfhi(a.y) * bfhi(b.y);
    acc += bflo(a.z) * bflo(b.z); acc += bfhi(a.z) * bfhi(b.z); acc += bflo(a.w) * bflo(b.w); acc += bfhi(a.w) * bfhi(b.w);
    return acc;
}

__device__ __forceinline__ void naive_ret(Frame& F, const bf16* R, const float* gn_gain, bf16* Y) {
    LAS unsigned* qs = (LAS unsigned*)(F.lds + RING_OFF + F.wave * 1024);
    int lane_ = lane_now(); asm volatile("" : "+v"(lane_));
    const int gw = F.vcu * NWAVES + F.wave, NGW = F.G * NWAVES, lane = lane_;
    for (int it = gw; it < M * 4; it += NGW) {
        const int bh = it & 63, t = it >> 6, b = bh >> 2, h = bh & 3;
        const size_t row = (size_t)b * SEQ + t;
        LDS_WAIT();
        qs[lane] = *(const unsigned*)(R + row * N_RET + h * 128 + 2 * lane);
        LDS_WAIT(); asm volatile("" ::: "memory");
        const float l2g = log2f(1.0f - exp2f(-5.0f - (float)h));
        float y0 = 0.f, y1 = 0.f, y2 = 0.f, y3 = 0.f;
        for (int s0 = 0; s0 <= t; s0 += 64) {
            const int s = s0 + lane; const bool valid = s <= t; const int sc = valid ? s : t;
            const u32x4* kr = (const u32x4*)(R + ((size_t)b * SEQ + sc) * N_RET + 512 + h * 128);
            float dot = 0.f;
#pragma unroll
            for (int d8 = 0; d8 < 16; ++d8) { const u32x4 q8 = *(const LAS u32x4*)(qs + d8 * 4); dot = dot8(q8, kr[d8], dot); }
            const float w = valid ? dot * exp2f((float)(t - s) * l2g) : 0.f;
            const int ns = (t - s0 + 1) < 64 ? (t - s0 + 1) : 64;
            const bf16* vb = R + ((size_t)b * SEQ + s0) * N_RET + 1024 + h * 256 + 4 * lane;
            for (int j = 0; j < ns; ++j) {
                const float wj = rdlane(w, j);
                const u32x2 v = *(const u32x2*)(vb + (size_t)j * N_RET);
                y0 += wj * bflo(v.x); y1 += wj * bfhi(v.x); y2 += wj * bflo(v.y); y3 += wj * bfhi(v.y);
            }
        }
        const float mean = wave_sum((y0 + y1) + (y2 + y3)) * (1.0f / 256.0f);
        const float d0 = y0 - mean, d1 = y1 - mean, d2 = y2 - mean, d3 = y3 - mean;
        const float var = wave_sum((d0 * d0 + d1 * d1) + (d2 * d2 + d3 * d3)) * (1.0f / 256.0f);
        const float rstd = 1.0f / sqrtf(var + 1e-5f);
        const f32x4 gg = *(const f32x4*)(gn_gain + h * 256 + 4 * lane);
        const u32x2 gv = *(const u32x2*)(R + row * N_RET + 2048 + h * 256 + 4 * lane);
        const float g0 = bflo(gv.x), g1 = bfhi(gv.x), g2 = bflo(gv.y), g3 = bfhi(gv.y);
        const float o0 = d0 * rstd * gg[0] * (g0 * sigmoidf_(g0)), o1 = d1 * rstd * gg[1] * (g1 * sigmoidf_(g1));
        const float o2 = d2 * rstd * gg[2] * (g2 * sigmoidf_(g2)), o3 = d3 * rstd * gg[3] * (g3 * sigmoidf_(g3));
        u32x2 w; w.x = pk2(o0, o1); w.y = pk2(o2, o3);
        *(u32x2*)(Y + row * YW + h * 256 + 4 * lane) = w;
    }
}

__device__ __forceinline__ void naive_diff(Frame& F, const bf16* Sd, const float* lamp, float lam_init, const float* subln, const float* blut, bf16* Y) {
    LAS unsigned* qs = (LAS unsigned*)(F.lds + RING_OFF + F.wave * 1024);
    int lane_ = lane_now(); asm volatile("" : "+v"(lane_));
    const int gw = F.vcu * NWAVES + F.wave, NGW = F.G * NWAVES, lane = lane_;
    const float lam = __expf(wave_sum(lamp[lane] * lamp[64 + lane])) - __expf(wave_sum(lamp[128 + lane] * lamp[192 + lane])) + lam_init;
    for (int it = gw; it < M * 8; it += NGW) {
        const int bh = it & 127, t = it >> 7, b = bh >> 3, h = bh & 7;
        const size_t row = (size_t)b * SEQ + t;
        LDS_WAIT();
        qs[lane] = *(const unsigned*)(Sd + row * N_DIFF + h * 128 + 2 * lane);
        LDS_WAIT(); asm volatile("" ::: "memory");
        float om0[2], om1[2];
#pragma unroll
        for (int mm = 0; mm < 2; ++mm) {
            float mrun = -3.0e38f, l = 0.f, o0 = 0.f, o1 = 0.f;
            for (int s0 = 0; s0 <= t; s0 += 64) {
                const int s = s0 + lane; const bool valid = s <= t; const int sc = valid ? s : t;
                const u32x4* kr = (const u32x4*)(Sd + ((size_t)b * SEQ + sc) * N_DIFF + 1024 + h * 128 + mm * 64);
                float dot = 0.f;
#pragma unroll
                for (int d8 = 0; d8 < 8; ++d8) { const u32x4 q8 = *(const LAS u32x4*)(qs + mm * 32 + d8 * 4); dot = dot8(q8, kr[d8], dot); }
                const int dist = (t - sc) < 127 ? (t - sc) : 127;
                const float scv = valid ? dot * 0.125f + blut[h * 128 + dist] : -3.0e38f;
                const float mnew = fmaxf(mrun, wave_max(scv));
                const float alpha = __expf(mrun - mnew);
                const float p = valid ? __expf(scv - mnew) : 0.f;
                l = l * alpha + wave_sum(p); o0 *= alpha; o1 *= alpha; mrun = mnew;
                const int ns = (t - s0 + 1) < 64 ? (t - s0 + 1) : 64;
                const bf16* vb = Sd + ((size_t)b * SEQ + s0) * N_DIFF + 2048 + h * 128 + 2 * lane;
                for (int j = 0; j < ns; ++j) {
                    const float pj = rdlane(p, j);
                    const unsigned v = *(const unsigned*)(vb + (size_t)j * N_DIFF);
                    o0 += pj * bflo(v); o1 += pj * bfhi(v);
                }
            }
            om0[mm] = o0 / l; om1[mm] = o1 / l;
        }
        const float a0 = om0[0] - lam * om0[1], a1 = om1[0] - lam * om1[1];
        const float ms = wave_sum(a0 * a0 + a1 * a1) * (1.0f / 128.0f);
        const float rs = (1.0f / sqrtf(ms + 1e-5f)) * (1.0f - lam_init);
        *(unsigned*)(Y + row * YW + 1024 + h * 128 + 2 * lane) = pk2(a0 * rs * subln[2 * lane], a1 * rs * subln[2 * lane + 1]);
    }
}

__device__ __forceinline__ void naive_dil(Frame& F, const bf16* Sl, int g, const float* blut, float* Pn, float* Ps, bf16* Y) {
    LAS unsigned* qs = (LAS unsigned*)(F.lds + RING_OFF + F.wave * 1024);
    int lane_ = lane_now(); asm volatile("" : "+v"(lane_));
    const int gw = F.vcu * NWAVES + F.wave, NGW = F.G * NWAVES, lane = lane_;
    const int dl = (g == 0) ? 1 : (g == 1 ? 4 : 16);
    for (int it = gw; it < M * 4; it += NGW) {
        const int bh = it & 63, t = it >> 6, b = bh >> 2, h = bh & 3;
        const size_t row = (size_t)b * SEQ + t;
        LDS_WAIT();
        qs[lane] = *(const unsigned*)(Sl + row * N_DILG + h * 128 + 2 * lane);
        LDS_WAIT(); asm volatile("" ::: "memory");
        float sc[3];
#pragma unroll
        for (int tl = 0; tl < 3; ++tl) {
            const int mi = tl * 64 + lane; const int kp = t - mi * dl; const bool valid = (mi <= 128) && (kp >= 0);
            const u32x4* kr = (const u32x4*)(Sl + ((size_t)b * SEQ + (valid ? kp : t)) * N_DILG + 512 + h * 128);
            float dot = 0.f;
#pragma unroll
            for (int d8 = 0; d8 < 16; ++d8) { const u32x4 q8 = *(const LAS u32x4*)(qs + d8 * 4); dot = dot8(q8, kr[d8], dot); }
            const int dist = (mi * dl) < 127 ? (mi * dl) : 127;
            sc[tl] = valid ? dot * 0.08838834764831845f + blut[(8 + g * 4 + h) * 128 + dist] : -3.0e38f;
        }
        float mx = wave_max(fmaxf(fmaxf(sc[0], sc[1]), sc[2]));
        float p[3], den = 0.f;
#pragma unroll
        for (int tl = 0; tl < 3; ++tl) { p[tl] = (sc[tl] > -1.0e38f) ? __expf(sc[tl] - mx) : 0.f; den += p[tl]; }
        den = wave_sum(den);
        float n0 = 0.f, n1 = 0.f;
#pragma unroll
        for (int tl = 0; tl < 3; ++tl) {
            for (int j = 0; j < 64; ++j) {
                const int mi = tl * 64 + j; const int kp = t - mi * dl;
                if (mi > 128 || kp < 0) break;
                const float pj = rdlane(p[tl], j);
                const unsigned v = *(const unsigned*)(Sl + ((size_t)b * SEQ + kp) * N_DILG + 1024 + h * 128 + 2 * lane);
                n0 += pj * bflo(v); n1 += pj * bfhi(v);
            }
        }
        float* pn = Pn + (row * 4 + h) * 128 + 2 * lane; float* ps = Ps + (row * 4 + h) * 2;
        if (g > 0) {
            const f32x2 q = *(const f32x2*)pn; const float pm = ps[0], pd = ps[1];
            const float mnew = fmaxf(mx, pm), ea = __expf(mx - mnew), eb = __expf(pm - mnew);
            n0 = ea * n0 + eb * q[0]; n1 = ea * n1 + eb * q[1]; den = ea * den + eb * pd; mx = mnew;
        }
        if (g < 2) { *(f32x2*)pn = (f32x2){n0, n1}; if (lane == 0) { ps[0] = mx; ps[1] = den; } }
        else { const float inv = 1.0f / den; *(unsigned*)(Y + row * YW + 2048 + h * 128 + 2 * lane) = pk2(n0 * inv, n1 * inv); }
    }
}


typedef short v4i16 __attribute__((ext_vector_type(4)));
__device__ __forceinline__ float fexp2(float x) { return __builtin_amdgcn_exp2f(x); }
__device__ __forceinline__ float hmax4(const f32x4 a) { return fmaxf(fmaxf(a[0], a[1]), fmaxf(a[2], a[3])); }
__device__ __forceinline__ bf16x8 pack_p(const f32x4 a, const f32x4 b) { u32x4 w; w.x = cvtpk(a[0], a[1]); w.y = cvtpk(a[2], a[3]); w.z = cvtpk(b[0], b[1]); w.w = cvtpk(b[2], b[3]); return __builtin_bit_cast(bf16x8, w); }
constexpr int AT_PITCH = 288, AT_TILE = 64 * AT_PITCH, AT_BUF = 2 * AT_TILE, AT_LUT = 2 * AT_BUF, AT_XP = 132;
__device__ __forceinline__ bf16x8 tr16x2(const LAS unsigned char* p0, const LAS unsigned char* p1) {
    const v4i16 a = __builtin_amdgcn_ds_read_tr16_b64_v4i16((LAS v4i16*)p0), b = __builtin_amdgcn_ds_read_tr16_b64_v4i16((LAS v4i16*)p1);
    return __builtin_shufflevector(a, b, 0, 1, 2, 3, 4, 5, 6, 7);
}
#define PIN_Q4(a, b, c, d) asm volatile("" : "+v"(a), "+v"(b), "+v"(c), "+v"(d))
constexpr int DR_TILE = 16384, DR_BUF = 32768, DR_Q = 98304, DR_LUT = 132096, DR_SUBLN = DR_LUT + 4096;
#define VMWAIT(n) asm volatile("s_waitcnt vmcnt(" #n ")" ::: "memory")
__device__ __forceinline__ void vm_wait_n(int n) { if (n <= 0) VMWAIT(0); else if (n <= 4) VMWAIT(4); else VMWAIT(8); }
#define WG_BARRIER() do { asm volatile("" ::: "memory"); __builtin_amdgcn_s_barrier(); asm volatile("" ::: "memory"); } while (0)
__device__ __forceinline__ void dma16(const bf16* gsrc, LAS unsigned char* ldst) {
    unsigned keep; const unsigned dst = (unsigned)__builtin_amdgcn_readfirstlane((int)(unsigned)(uintptr_t)ldst);
    asm volatile("s_mov_b32 %0, m0\n\ts_mov_b32 m0, %2\n\ts_nop 0\n\tglobal_load_lds_dwordx4 %1, off\n\ts_mov_b32 m0, %0" : "=&s"(keep) : "v"(gsrc), "s"(dst) : "memory");
}

__device__ __forceinline__ float hmax16(const f32x4 (&x)[4]) {
    const float a = fmaxf(fmaxf(x[0][0], x[0][1]), x[0][2]), b = fmaxf(fmaxf(x[0][3], x[1][0]), x[1][1]), c = fmaxf(fmaxf(x[1][2], x[1][3]), x[2][0]);
    const float d = fmaxf(fmaxf(x[2][1], x[2][2]), x[2][3]), e = fmaxf(fmaxf(x[3][0], x[3][1]), x[3][2]);
    return fmaxf(fmaxf(fmaxf(a, b), c), fmaxf(fmaxf(d, e), x[3][3]));
}
__device__ __forceinline__ void diff_tile(const LAS unsigned char* Kt, const LAS unsigned char* Vt, int k0, int qw, int l15, int kg, bool first, const bf16x8 (&qf)[2][2],
                                          f32x4 (&O)[2][8], float (&beta)[2], float (&lsum)[2], const LAS float* lut, float c31, const int (&voff)[8]) {
    const int sw = (2 * l15) & 15;
    const int kl = l15 * 256 + 16 * (kg ^ sw);
    const bool nearT = (qw - k0 - 63) < 113;
    f32x4 Sx[2][4];
#pragma unroll
    for (int m = 0; m < 2; ++m) {
        const float i0 = nearT ? -beta[m] : c31 - beta[m];
#pragma unroll
        for (int kb = 0; kb < 4; ++kb) Sx[m][kb] = (f32x4){i0, i0, i0, i0};
    }
#pragma unroll
    for (int m = 0; m < 2; ++m) {
        bf16x8 kf[2][4];
#pragma unroll
        for (int ks = 0; ks < 2; ++ks)
#pragma unroll
            for (int kb = 0; kb < 4; ++kb) kf[ks][kb] = *(const LAS bf16x8*)(Kt + kb * 4096 + (kl ^ (128 * m + 64 * ks)));
        __builtin_amdgcn_sched_barrier(0);
#pragma unroll
        for (int ks = 0; ks < 2; ++ks)
#pragma unroll
            for (int kb = 0; kb < 4; ++kb) Sx[m][kb] = __builtin_amdgcn_mfma_f32_16x16x32_bf16(kf[ks][kb], qf[m][ks], Sx[m][kb], 0, 0, 0);
    }
#define DIFF_VLOAD(dst, j) do { _Pragma("unroll") for (int e4 = 0; e4 < 4; ++e4) dst[e4] = tr16x2(Vt + (32 * ((j) >> 1)) * 256 + voff[4 * ((j) & 1) + e4], Vt + (32 * ((j) >> 1) + 16) * 256 + voff[4 * ((j) & 1) + e4]); } while (0)
#define DIFF_VMMA(src, j) do { _Pragma("unroll") for (int e4 = 0; e4 < 4; ++e4) _Pragma("unroll") for (int m = 0; m < 2; ++m) \
        O[m][4 * ((j) & 1) + e4] = __builtin_amdgcn_mfma_f32_16x16x32_bf16(src[e4], pf[m][(j) >> 1], O[m][4 * ((j) & 1) + e4], 0, 0, 0); } while (0)
    bf16x8 va[4], vc[4];
    DIFF_VLOAD(va, 0);
    __builtin_amdgcn_sched_barrier(0);
    bf16x8 pf[2][2];
    if (nearT) {
        float bv[4][4];
        const int dq = qw + l15 - k0 - 4 * kg;
#pragma unroll
        for (int kb = 0; kb < 4; ++kb)
#pragma unroll
            for (int r = 0; r < 4; ++r) { int di = dq - 16 * kb - r; di = di < 0 ? 0 : (di > 127 ? 127 : di); bv[kb][r] = lut[di]; }
#pragma unroll
        for (int m = 0; m < 2; ++m)
#pragma unroll
            for (int kb = 0; kb < 4; ++kb)
#pragma unroll
                for (int r = 0; r < 4; ++r) Sx[m][kb][r] = (dq - 16 * kb - r < 0) ? -1.0e30f : Sx[m][kb][r] + bv[kb][r];
    }
#pragma unroll
    for (int m = 0; m < 2; ++m) {
        float mx = hmax16(Sx[m]);
        mx = fmaxf(mx, __shfl_xor(mx, 16)); mx = fmaxf(mx, __shfl_xor(mx, 32));
        if (first || __builtin_amdgcn_ballot_w64(mx > 8.0f) != 0ull) {
            const float dlt = (first || mx > 0.f) ? mx : 0.f, sc = fexp2(-dlt);
            beta[m] += dlt; lsum[m] *= sc;
#pragma unroll
            for (int kb = 0; kb < 4; ++kb) Sx[m][kb] = Sx[m][kb] - dlt;
#pragma unroll
            for (int eb = 0; eb < 8; ++eb) O[m][eb] = O[m][eb] * sc;
        }
#pragma unroll
        for (int kb = 0; kb < 4; ++kb) Sx[m][kb] = (f32x4){fexp2(Sx[m][kb][0]), fexp2(Sx[m][kb][1]), fexp2(Sx[m][kb][2]), fexp2(Sx[m][kb][3])};
        const f32x4 pv4 = (Sx[m][0] + Sx[m][1]) + (Sx[m][2] + Sx[m][3]);
        lsum[m] += (pv4[0] + pv4[1]) + (pv4[2] + pv4[3]);
        pf[m][0] = pack_p(Sx[m][0], Sx[m][1]); pf[m][1] = pack_p(Sx[m][2], Sx[m][3]);
    }
    DIFF_VLOAD(vc, 1);
    __builtin_amdgcn_sched_barrier(0);
    DIFF_VMMA(va, 0);
    DIFF_VLOAD(va, 2);
    __builtin_amdgcn_sched_barrier(0);
    DIFF_VMMA(vc, 1);
    DIFF_VLOAD(vc, 3);
    __builtin_amdgcn_sched_barrier(0);
    DIFF_VMMA(va, 2);
    DIFF_VMMA(vc, 3);
#undef DIFF_VLOAD
#undef DIFF_VMMA
}
__device__ __forceinline__ void diff_attn_phase(Frame& F, const bf16* Sd, const float* lamp, float lam_init, const float* subln, const float* blut, bf16* Yo) {
    int tid_ = TID_NOW(F.wave); asm volatile("" : "+v"(tid_));
    const int tid = tid_, lane = tid & 63, wave = F.wave, l15 = lane & 15, kg = lane >> 4, G = F.G;
    LAS unsigned char* lds = F.lds;
    const float lam = __expf(wave_sum(lamp[lane] * lamp[64 + lane])) - __expf(wave_sum(lamp[128 + lane] * lamp[192 + lane])) + lam_init;
    for (int i = tid; i < 1024; i += NWAVES * 64) ((LAS float*)(lds + DR_LUT))[i] = blut[i] * 1.4426950408889634f;
    if (tid < 128) ((LAS float*)(lds + DR_SUBLN))[tid] = subln[tid] * (1.0f - lam_init);
    VMWAIT(0);
    __syncthreads();
    const int nun = ((int)blockIdx.x < 2048) ? (2048 - (int)blockIdx.x + G - 1) / G : 0;
#define DIFF_UNIT(j, b_, h_, qb_) do { const int u_ = (int)blockIdx.x + (j) * G; const int bh_ = (u_ & 255) >> 1, hf_ = u_ & 1, jj_ = u_ >> 8; \
        qb_ = hf_ ? (14 - 2 * jj_ + (jj_ & 1)) : (15 - 2 * jj_ - (jj_ & 1)); b_ = bh_ >> 3; h_ = bh_ & 7; } while (0)
    int lo[4];
#pragma unroll
    for (int i = 0; i < 4; ++i) { const int ri = 4 * i + (lane >> 4); lo[i] = ri * N_DIFF + ((lane & 15) ^ ((2 * ri) & 15)) * 8; }
    const int kvrow0 = 16 * (wave & 3), kvcol = 1024 + (wave >> 2) * 1024;
    LAS unsigned char* const kvdst = lds + (wave >> 2) * DR_TILE + (wave & 3) * 4096;
    LAS unsigned char* const qdst = lds + DR_Q + wave * 4096;
    int iu = 0, it = 0, ib = 0, i_nt = 0, i_b = 0, i_h = 0;
    if (nun > 0) { int qb_; DIFF_UNIT(0, i_b, i_h, qb_); i_nt = 2 * qb_ + 2; }
#define DIFF_ISSUE() do { const bf16* src_ = Sd + ((size_t)i_b * SEQ + 64 * it + kvrow0) * N_DIFF + i_h * 128 + kvcol; \
        _Pragma("unroll") for (int i = 0; i < 4; ++i) dma16(src_ + lo[i], kvdst + ib * DR_BUF + i * 1024); \
        ib = (ib == 2) ? 0 : ib + 1; if (++it == i_nt) { it = 0; ++iu; if (iu < nun) { int qb_; DIFF_UNIT(iu, i_b, i_h, qb_); i_nt = 2 * qb_ + 2; } } } while (0)
#define DIFF_ISSUE_Q(b_, h_, Q0_) do { const bf16* src_ = Sd + ((size_t)(b_) * SEQ + (Q0_) + 16 * wave) * N_DIFF + (h_) * 128; \
        _Pragma("unroll") for (int i = 0; i < 4; ++i) dma16(src_ + lo[i], qdst + i * 1024); } while (0)
    if (nun > 0) {
        DIFF_ISSUE(); DIFF_ISSUE();
        { int b_, h_, qb_; DIFF_UNIT(0, b_, h_, qb_); DIFF_ISSUE_Q(b_, h_, qb_ * 128); }
    }
    int cb = 0;
    const int sw = (2 * l15) & 15;
    const int ql = (16 * wave + l15) * 256 + 16 * (kg ^ sw);
    int voff[8];
    { const int vq = 4 * kg + (l15 >> 2); const int vl = vq * 256 + 8 * (l15 & 3) + 16 * ((2 * vq) & 15);
#pragma unroll
      for (int eb = 0; eb < 8; ++eb) voff[eb] = vl ^ (32 * eb); }
    for (int ju = 0; ju < nun; ++ju) {
        int b, h, qb; DIFF_UNIT(ju, b, h, qb);
        const int Q0 = qb * 128, nt = 2 * qb + 2, qw = Q0 + 16 * wave;
        const LAS float* lut = (const LAS float*)(lds + DR_LUT) + h * 128;
        const float c31 = lut[127];
        bf16x8 qf[2][2];
        f32x4 O[2][8]; float mrun[2], lsum[2];
#pragma unroll
        for (int m = 0; m < 2; ++m) { mrun[m] = 0.f; lsum[m] = 0.f;
#pragma unroll
            for (int eb = 0; eb < 8; ++eb) O[m][eb] = (f32x4){0.f, 0.f, 0.f, 0.f}; }
        for (int t = 0; t < nt; ++t) {
            const bool has_next = !(ju == nun - 1 && t == nt - 1);
            if (t == 0) VMWAIT(0);
            else vm_wait_n((has_next ? 4 : 0) + (((t == 2 || t == 3) && ju + 1 < nun) ? 4 : 0));
            WG_BARRIER();
            if (iu < nun) DIFF_ISSUE();
            if (t == 1 && ju + 1 < nun) { int b_, h_, qb_; DIFF_UNIT(ju + 1, b_, h_, qb_); DIFF_ISSUE_Q(b_, h_, qb_ * 128); }
            if (t == 0) {
#pragma unroll
                for (int m = 0; m < 2; ++m)
#pragma unroll
                    for (int ks = 0; ks < 2; ++ks) qf[m][ks] = *(const LAS bf16x8*)(lds + DR_Q + (ql ^ (128 * m + 64 * ks)));
            }
            if (64 * t <= qw + 15) diff_tile(lds + cb * DR_BUF, lds + cb * DR_BUF + DR_TILE, 64 * t, qw, l15, kg, t == 0, qf, O, mrun, lsum, lut, c31, voff);
            cb = (cb == 2) ? 0 : cb + 1;
        }
        float inv[2];
#pragma unroll
        for (int m = 0; m < 2; ++m) { float l = lsum[m]; l += __shfl_xor(l, 16); l += __shfl_xor(l, 32); inv[m] = 1.0f / l; }
        const float i0 = inv[0], i1 = inv[1] * lam;
        float ss = 0.f;
#pragma unroll
        for (int eb = 0; eb < 8; ++eb) { const f32x4 a = O[0][eb] * i0 - O[1][eb] * i1; O[0][eb] = a; ss += (a[0] * a[0] + a[1] * a[1]) + (a[2] * a[2] + a[3] * a[3]); }
        ss += __shfl_xor(ss, 16); ss += __shfl_xor(ss, 32);
        const float rs = 1.0f / sqrtf(ss * (1.0f / 128.0f) + 1e-5f);
        bf16* orow = Yo + ((size_t)b * SEQ + qw + l15) * YW + 1024 + h * 128 + 4 * kg;
        const LAS float* sg = (const LAS float*)(lds + DR_SUBLN) + 4 * kg;
#pragma unroll
        for (int eb = 0; eb < 8; ++eb) { const f32x4 gq = *(const LAS f32x4*)(sg + 16 * eb); const f32x4 a = O[0][eb] * rs * gq;
            u32x2 w; w.x = cvtpk(a[0], a[1]); w.y = cvtpk(a[2], a[3]); *(u32x2*)(orow + 16 * eb) = w; }
    }
#undef DIFF_UNIT
#undef DIFF_ISSUE
#undef DIFF_ISSUE_Q
    VMWAIT(0);
    __syncthreads();
}

__device__ __forceinline__ void dil_tile(const LAS unsigned char* Kt, const LAS unsigned char* Vt, int m0, int l15, int kg, bool first, const bf16x8 (&qf)[4],
                                         f32x4 (&O)[8], float& beta, float& lsum, const LAS float* lutm, const int (&voff)[8]) {
    const int sw = (2 * l15) & 15;
    const int kl = l15 * 256 + 16 * (kg ^ sw);
    f32x4 Sx[4];
    const float i0 = -beta;
#pragma unroll
    for (int kb = 0; kb < 4; ++kb) Sx[kb] = (f32x4){i0, i0, i0, i0};
#pragma unroll
    for (int h2 = 0; h2 < 2; ++h2) {
        bf16x8 kf[2][4];
#pragma unroll
        for (int ks = 0; ks < 2; ++ks)
#pragma unroll
            for (int kb = 0; kb < 4; ++kb) kf[ks][kb] = *(const LAS bf16x8*)(Kt + kb * 4096 + (kl ^ (64 * (2 * h2 + ks))));
        __builtin_amdgcn_sched_barrier(0);
#pragma unroll
        for (int ks = 0; ks < 2; ++ks)
#pragma unroll
            for (int kb = 0; kb < 4; ++kb) Sx[kb] = __builtin_amdgcn_mfma_f32_16x16x32_bf16(kf[ks][kb], qf[2 * h2 + ks], Sx[kb], 0, 0, 0);
    }
#define DIL_VLOAD(dst, j) do { _Pragma("unroll") for (int e4 = 0; e4 < 4; ++e4) dst[e4] = tr16x2(Vt + (32 * ((j) >> 1)) * 256 + voff[4 * ((j) & 1) + e4], Vt + (32 * ((j) >> 1) + 16) * 256 + voff[4 * ((j) & 1) + e4]); } while (0)
#define DIL_VMMA(src, j) do { _Pragma("unroll") for (int e4 = 0; e4 < 4; ++e4) O[4 * ((j) & 1) + e4] = __builtin_amdgcn_mfma_f32_16x16x32_bf16(src[e4], pf[(j) >> 1], O[4 * ((j) & 1) + e4], 0, 0, 0); } while (0)
    bf16x8 va[4], vc[4];
    DIL_VLOAD(va, 0);
    __builtin_amdgcn_sched_barrier(0);
    {
        const LAS float* lp = lutm + (m0 + 64);
#pragma unroll
        for (int kb = 0; kb < 4; ++kb) { const f32x4 bv = (f32x4){lp[-16 * kb], lp[-16 * kb - 1], lp[-16 * kb - 2], lp[-16 * kb - 3]}; Sx[kb] = Sx[kb] + bv; }
    }
    float mx = hmax16(Sx);
    mx = fmaxf(mx, __shfl_xor(mx, 16)); mx = fmaxf(mx, __shfl_xor(mx, 32));
    if (first || __builtin_amdgcn_ballot_w64(mx > 8.0f) != 0ull) {
        const float dlt = (first || mx > 0.f) ? mx : 0.f, sc = fexp2(-dlt);
        beta += dlt; lsum *= sc;
#pragma unroll
        for (int kb = 0; kb < 4; ++kb) Sx[kb] = Sx[kb] - dlt;
#pragma unroll
        for (int eb = 0; eb < 8; ++eb) O[eb] = O[eb] * sc;
    }
#pragma unroll
    for (int kb = 0; kb < 4; ++kb) Sx[kb] = (f32x4){fexp2(Sx[kb][0]), fexp2(Sx[kb][1]), fexp2(Sx[kb][2]), fexp2(Sx[kb][3])};
    const f32x4 pv4 = (Sx[0] + Sx[1]) + (Sx[2] + Sx[3]);
    lsum += (pv4[0] + pv4[1]) + (pv4[2] + pv4[3]);
    bf16x8 pf[2];
    pf[0] = pack_p(Sx[0], Sx[1]); pf[1] = pack_p(Sx[2], Sx[3]);
    DIL_VLOAD(vc, 1);
    __builtin_amdgcn_sched_barrier(0);
    DIL_VMMA(va, 0);
    DIL_VLOAD(va, 2);
    __builtin_amdgcn_sched_barrier(0);
    DIL_VMMA(vc, 1);
    DIL_VLOAD(vc, 3);
    __builtin_amdgcn_sched_barrier(0);
    DIL_VMMA(va, 2);
    DIL_VMMA(vc, 3);
#undef DIL_VLOAD
#undef DIL_VMMA
}
__device__ __forceinline__ void dil_attn_phase(Frame& F, const bf16* Sl, int g, const float* blut, float* Lse, bf16* Yo) {
    int tid_ = TID_NOW(F.wave); asm volatile("" : "+v"(tid_));
    const int tid = tid_, lane = tid & 63, wave = F.wave, l15 = lane & 15, kg = lane >> 4, G = F.G;
    const int dl = (g == 0) ? 1 : (g == 1 ? 4 : 16);
    LAS unsigned char* lds = F.lds;
    for (int i = tid; i < 1024; i += NWAVES * 64) {
        const int hh = i >> 8, m = (i & 255) - 64; int di = m * dl; di = di < 0 ? 0 : (di > 127 ? 127 : di);
        ((LAS float*)(lds + DR_LUT))[i] = (m >= 0 && m <= 128) ? blut[(8 + g * 4 + hh) * 128 + di] * 1.4426950408889634f : -1.0e30f;
    }
    VMWAIT(0);
    __syncthreads();
    const int nun = ((int)blockIdx.x < 1024) ? (1024 - (int)blockIdx.x + G - 1) / G : 0;
#define DIL_UNIT(j, b_, h_, r_, nbi_) do { const int u_ = (int)blockIdx.x + (j) * G; const int bh_ = u_ & 63, idx_ = u_ >> 6; b_ = bh_ >> 2; h_ = bh_ & 3; r_ = idx_ % dl; nbi_ = idx_ / dl; } while (0)
    int lo[4];
#pragma unroll
    for (int i = 0; i < 4; ++i) { const int ri = 4 * i + (lane >> 4); lo[i] = ri * dl * N_DILG + ((lane & 15) ^ ((2 * ri) & 15)) * 8; }
    const int kvrow0 = 16 * (wave & 3), kvcol = 512 + (wave >> 2) * 512;
    LAS unsigned char* const kvdst = lds + (wave >> 2) * DR_TILE + (wave & 3) * 4096;
    LAS unsigned char* const qdst = lds + DR_Q + wave * 4096;
    int iu = 0, it = 0, ib = 0, i_nt = 0, i_t0 = 0, i_b = 0, i_h = 0, i_r = 0, i_nbi = 0;
    if (nun > 0) { DIL_UNIT(0, i_b, i_h, i_r, i_nbi); i_t0 = (i_nbi == 0) ? 2 : 0; i_nt = 4 - i_t0; }
#define DIL_ISSUE() do { const bf16* src_ = Sl + ((size_t)i_b * SEQ + (size_t)(((i_nbi - 1) * 128 + 64 * (i_t0 + it) + kvrow0) * dl + i_r)) * N_DILG + i_h * 128 + kvcol; \
        _Pragma("unroll") for (int i = 0; i < 4; ++i) dma16(src_ + lo[i], kvdst + ib * DR_BUF + i * 1024); \
        ib = (ib == 2) ? 0 : ib + 1; if (++it == i_nt) { it = 0; ++iu; if (iu < nun) { DIL_UNIT(iu, i_b, i_h, i_r, i_nbi); i_t0 = (i_nbi == 0) ? 2 : 0; i_nt = 4 - i_t0; } } } while (0)
#define DIL_ISSUE_Q(b_, h_, r_, nbi_) do { const bf16* src_ = Sl + ((size_t)(b_) * SEQ + (size_t)(((nbi_) * 128 + 16 * wave) * dl + (r_))) * N_DILG + (h_) * 128; \
        _Pragma("unroll") for (int i = 0; i < 4; ++i) dma16(src_ + lo[i], qdst + i * 1024); } while (0)
    if (nun > 0) {
        DIL_ISSUE(); DIL_ISSUE();
        { int b_, h_, r_, n_; DIL_UNIT(0, b_, h_, r_, n_); DIL_ISSUE_Q(b_, h_, r_, n_); }
    }
    int cb = 0;
    const int sw = (2 * l15) & 15;
    const int ql = (16 * wave + l15) * 256 + 16 * (kg ^ sw);
    int voff[8];
    { const int vq = 4 * kg + (l15 >> 2); const int vl = vq * 256 + 8 * (l15 & 3) + 16 * ((2 * vq) & 15);
#pragma unroll
      for (int eb = 0; eb < 8; ++eb) voff[eb] = vl ^ (32 * eb); }
    const int tlo = wave >> 2, thi = tlo + 2, qi = 16 * wave + l15;
    for (int ju = 0; ju < nun; ++ju) {
        int b, h, r, nbi; DIL_UNIT(ju, b, h, r, nbi);
        const int t0 = (nbi == 0) ? 2 : 0, nt = 4 - t0, tfirst = tlo > t0 ? tlo : t0;
        const LAS float* lutm = (const LAS float*)(lds + DR_LUT) + h * 256;
        const int qpos = (nbi * 128 + qi) * dl + r;
        const size_t row = (size_t)b * SEQ + qpos;
        bf16* orow = Yo + row * YW + 2048 + h * 128 + 4 * kg;
        bf16x8 qf[4];
        f32x4 O[8]; float beta = 0.f, lsum = 0.f;
#pragma unroll
        for (int eb = 0; eb < 8; ++eb) O[eb] = (f32x4){0.f, 0.f, 0.f, 0.f};
        u32x2 pv[8]; float lp = 0.f;
        for (int t = 0; t < nt; ++t) {
            const int tt = t0 + t;
            const bool has_next = !(ju == nun - 1 && t == nt - 1);
            if (t == 0) VMWAIT(0);
            else vm_wait_n((has_next ? 4 : 0) + (((t == 2 || t == 3) && ju + 1 < nun) ? 4 : 0));
            WG_BARRIER();
            if (iu < nun) DIL_ISSUE();
            if (t == 1 && ju + 1 < nun) { int b_, h_, r_, n_; DIL_UNIT(ju + 1, b_, h_, r_, n_); DIL_ISSUE_Q(b_, h_, r_, n_); }
            if (t == 0) {
#pragma unroll
                for (int ks = 0; ks < 4; ++ks) qf[ks] = *(const LAS bf16x8*)(lds + DR_Q + (ql ^ (64 * ks)));
            }
            if (t == nt - 1 && g > 0) {
#pragma unroll
                for (int eb = 0; eb < 8; ++eb) pv[eb] = *(const u32x2*)(orow + 16 * eb);
                lp = Lse[row * 4 + h];
            }
            if (tt >= tlo && tt <= thi) dil_tile(lds + cb * DR_BUF, lds + cb * DR_BUF + DR_TILE, qi + 128 - 64 * tt - 4 * kg, l15, kg, tt == tfirst, qf, O, beta, lsum, lutm, voff);
            cb = (cb == 2) ? 0 : cb + 1;
        }
        float l = lsum; l += __shfl_xor(l, 16); l += __shfl_xor(l, 32);
        float inv = 1.0f / l, lse = beta + log2f(l);
        float wa = inv, wb = 0.f;
        if (g > 0) {
            const float mm = fmaxf(lse, lp), ea = fexp2(lse - mm), eb_ = fexp2(lp - mm), tot = ea + eb_;
            wa = inv * ea / tot; wb = eb_ / tot; lse = mm + log2f(tot);
        }
#pragma unroll
        for (int eb = 0; eb < 8; ++eb) {
            f32x4 a = O[eb] * wa;
            if (g > 0) { a[0] += wb * bflo(pv[eb].x); a[1] += wb * bfhi(pv[eb].x); a[2] += wb * bflo(pv[eb].y); a[3] += wb * bfhi(pv[eb].y); }
            u32x2 w; w.x = cvtpk(a[0], a[1]); w.y = cvtpk(a[2], a[3]); *(u32x2*)(orow + 16 * eb) = w;
        }
        if (g < 2 && kg == 0) Lse[row * 4 + h] = lse;
    }
#undef DIL_UNIT
#undef DIL_ISSUE
#undef DIL_ISSUE_Q
    VMWAIT(0);
    __syncthreads();
}

constexpr int RS_VP = 160, RS_KT = 64 * AT_PITCH, RS_BUF = RS_KT + 64 * RS_VP;
constexpr size_t WS_ST = WS_S + 192 * MiB;
__device__ __forceinline__ void ret_state_phase(Frame& F, const bf16* R, bf16* ST) {
    int tid_ = TID_NOW(F.wave); asm volatile("" : "+v"(tid_));
    const int tid = tid_, lane = tid & 63, wave = F.wave, l15 = lane & 15, kg = lane >> 4;
    LAS unsigned char* lds = F.lds;
    for (int u = blockIdx.x; u < 256; u += F.G) {
        const int bh = u >> 2, es = u & 3, b = bh >> 2, h = bh & 3;
        const float l2g = log2f(1.0f - exp2f(-5.0f - (float)h));
        const float g256 = fexp2(256.0f * l2g);
        float cw[2][8];
#pragma unroll
        for (int c = 0; c < 2; ++c)
#pragma unroll
            for (int j = 0; j < 8; ++j) cw[c][j] = fexp2((float)(63 - (32 * c + 16 * (j >> 2) + 4 * kg + (j & 3))) * l2g);
        const bf16* base = R + (size_t)b * SEQ * N_RET;
        const int sr0 = tid >> 4, sc16 = tid & 15;
        const int vr0 = tid >> 3, vc = tid & 7;
        const bf16* kgp = base + (size_t)sr0 * N_RET + 512 + h * 128 + sc16 * 8;
        const bf16* vgp = base + (size_t)vr0 * N_RET + 1024 + h * 256 + es * 64 + vc * 8;
        const int ksl = sr0 * AT_PITCH + sc16 * 16, vsl = RS_KT + vr0 * RS_VP + vc * 16;
        u32x4 kr[2], vr;
#pragma unroll
        for (int i = 0; i < 2; ++i) kr[i] = *(const u32x4*)(kgp + (size_t)(32 * i) * N_RET);
        vr = *(const u32x4*)vgp;
        __syncthreads();
#pragma unroll
        for (int i = 0; i < 2; ++i) *(LAS u32x4*)(lds + ksl + 32 * i * AT_PITCH) = kr[i];
        *(LAS u32x4*)(lds + vsl) = vr;
        __syncthreads();
        f32x4 acc[4];
#pragma unroll
        for (int eb = 0; eb < 4; ++eb) acc[eb] = (f32x4){0.f, 0.f, 0.f, 0.f};
        for (int t = 0; t < 28; ++t) {
            const int k0 = t * 64;
            const bool more = (t + 1 < 28);
            if (more) {
#pragma unroll
                for (int i = 0; i < 2; ++i) kr[i] = *(const u32x4*)(kgp + (size_t)(k0 + 64 + 32 * i) * N_RET);
                vr = *(const u32x4*)(vgp + (size_t)(k0 + 64) * N_RET);
            }
            const LAS unsigned char* Kt = lds + (t & 1) * RS_BUF;
            const LAS unsigned char* Vt = Kt + RS_KT;
            const float tf = fexp2((float)(192 - 64 * (t & 3)) * l2g);
            const LAS unsigned char* kb_ = Kt + (4 * kg + (l15 >> 2)) * AT_PITCH + (16 * wave + 4 * (l15 & 3)) * 2;
            const LAS unsigned char* vb_ = Vt + (4 * kg + (l15 >> 2)) * RS_VP + (l15 & 3) * 8;
            bf16x8 kf[2], vf[2][4];
#pragma unroll
            for (int c = 0; c < 2; ++c) {
                kf[c] = tr16x2(kb_ + (32 * c) * AT_PITCH, kb_ + (32 * c + 16) * AT_PITCH);
#pragma unroll
                for (int eb = 0; eb < 4; ++eb) vf[c][eb] = tr16x2(vb_ + (32 * c) * RS_VP + eb * 32, vb_ + (32 * c + 16) * RS_VP + eb * 32);
            }
#pragma unroll
            for (int c = 0; c < 2; ++c) {
                const u32x4 w = __builtin_bit_cast(u32x4, kf[c]);
                u32x4 o;
                o.x = cvtpk(bflo(w.x) * (cw[c][0] * tf), bfhi(w.x) * (cw[c][1] * tf)); o.y = cvtpk(bflo(w.y) * (cw[c][2] * tf), bfhi(w.y) * (cw[c][3] * tf));
                o.z = cvtpk(bflo(w.z) * (cw[c][4] * tf), bfhi(w.z) * (cw[c][5] * tf)); o.w = cvtpk(bflo(w.w) * (cw[c][6] * tf), bfhi(w.w) * (cw[c][7] * tf));
                kf[c] = __builtin_bit_cast(bf16x8, o);
            }
#pragma unroll
            for (int c = 0; c < 2; ++c)
#pragma unroll
                for (int eb = 0; eb < 4; ++eb) acc[eb] = __builtin_amdgcn_mfma_f32_16x16x32_bf16(vf[c][eb], kf[c], acc[eb], 0, 0, 0);
            if ((t & 3) == 3) {
                bf16* st = ST + ((size_t)(bh * 7 + (t >> 2)) * 128 + 16 * wave + l15) * 256 + es * 64 + 4 * kg;
#pragma unroll
                for (int eb = 0; eb < 4; ++eb) { u32x2 w; w.x = cvtpk(acc[eb][0], acc[eb][1]); w.y = cvtpk(acc[eb][2], acc[eb][3]); *(u32x2*)(st + 16 * eb) = w; acc[eb] = acc[eb] * g256; }
            }
            if (more) {
                LAS unsigned char* nb = lds + ((t + 1) & 1) * RS_BUF;
#pragma unroll
                for (int i = 0; i < 2; ++i) *(LAS u32x4*)(nb + ksl + 32 * i * AT_PITCH) = kr[i];
                *(LAS u32x4*)(nb + vsl) = vr;
            }
            __syncthreads();
        }
    }
    __syncthreads();
}

constexpr int RC_KT = 16384, RC_BUF = 49152, RC_GAIN = DR_LUT;
__device__ __forceinline__ void ret_phase(Frame& F, const bf16* R, const bf16* ST, const float* gn_gain, bf16* Yo) {
    int tid_ = TID_NOW(F.wave); asm volatile("" : "+v"(tid_));
    const int tid = tid_, lane = tid & 63, wave = F.wave, l15 = lane & 15, kg = lane >> 4, G = F.G;
    LAS unsigned char* lds = F.lds;
    for (int i = tid; i < 1024; i += NWAVES * 64) ((LAS float*)(lds + RC_GAIN))[i] = gn_gain[i];
    VMWAIT(0);
    __syncthreads();
    const int nun = ((int)blockIdx.x < 1024) ? (1024 - (int)blockIdx.x + G - 1) / G : 0;
#define RC_UNIT(j, b_, h_, qb_) do { const int u_ = (int)blockIdx.x + (j) * G; const int bh_ = (u_ & 255) >> 2, qt_ = u_ & 3, jj_ = u_ >> 8; qb_ = 4 * jj_ + ((qt_ + jj_) & 3); b_ = bh_ >> 2; h_ = bh_ & 3; } while (0)
#define RC_LOK(i) ((4 * (i) + (ln_ >> 4)) * N_RET + ((((ln_ & 15) ^ (2 * (ln_ >> 4))) * 8) ^ (64 * ((i) & 1))))
#define RC_LOV(i, pitch) ((2 * (i) + (ln_ >> 5)) * (pitch) + ((((ln_ & 31) ^ (2 * (ln_ >> 5))) * 8) ^ (32 * (i))))
    LAS unsigned char* const kdst = lds + wave * 2048;
    LAS unsigned char* const vdst = lds + RC_KT + wave * 4096;
    LAS unsigned char* const qdst = lds + DR_Q + wave * 4096;
    int iu = 0, it = 0, ib = 0, i_n = 0, i_ns = 0, i_t0 = 0, i_b = 0, i_h = 0, i_sc = 0;
#define RC_SETUP(j) do { int qb_; RC_UNIT(j, i_b, i_h, qb_); i_sc = qb_ >> 1; i_ns = (i_sc > 0) ? 2 : 0; i_t0 = 4 * i_sc; i_n = i_ns + 2 * qb_ + 2 - i_t0; } while (0)
    if (nun > 0) RC_SETUP(0);
#define RC_ISSUE() do { int ln_ = lane; asm volatile("" : "+v"(ln_)); LAS unsigned char* kd_ = kdst + ib * RC_BUF; LAS unsigned char* vd_ = vdst + ib * RC_BUF; \
        if (it < i_ns) { const bf16* src_ = ST + ((size_t)((i_b * 4 + i_h) * 7 + i_sc - 1) * 128 + 64 * it + 8 * wave) * 256; \
            _Pragma("unroll") for (int i = 0; i < 4; ++i) dma16(src_ + RC_LOV(i, 256), vd_ + i * 1024); } \
        else { const bf16* src_ = R + ((size_t)i_b * SEQ + 64 * (i_t0 + it - i_ns) + 8 * wave) * N_RET; \
            _Pragma("unroll") for (int i = 0; i < 2; ++i) dma16(src_ + 512 + i_h * 128 + RC_LOK(i), kd_ + i * 1024); \
            _Pragma("unroll") for (int i = 0; i < 4; ++i) dma16(src_ + 1024 + i_h * 256 + RC_LOV(i, N_RET), vd_ + i * 1024); } \
        ib ^= 1; if (++it == i_n) { it = 0; ++iu; if (iu < nun) RC_SETUP(iu); } } while (0)
#define RC_ISSUE_Q(b_, h_, Q0_) do { int ln_ = lane; asm volatile("" : "+v"(ln_)); const bf16* src_ = R + ((size_t)(b_) * SEQ + (Q0_) + 16 * wave) * N_RET + (h_) * 128; \
        _Pragma("unroll") for (int i = 0; i < 4; ++i) dma16(src_ + RC_LOK(i), qdst + i * 1024); } while (0)
    if (nun > 0) { RC_ISSUE(); { int b_, h_, qb_; RC_UNIT(0, b_, h_, qb_); RC_ISSUE_Q(b_, h_, qb_ * 128); } }
    int cb = 0;
    const int sw = (2 * l15) & 15;
    const int ql = (16 * wave + l15) * 256 + 16 * (kg ^ sw);
    const int kl = l15 * 256 + 16 * (kg ^ sw);
    const int vl = (4 * kg + (l15 >> 2)) * 512 + 8 * (l15 & 3) + 16 * ((2 * (4 * kg + (l15 >> 2))) & 15);
#define RC_VLOAD(dst, Vt_, c_, q_) do { _Pragma("unroll") for (int e4 = 0; e4 < 4; ++e4) dst[e4] = tr16x2((Vt_) + (32 * (c_)) * 512 + (vl ^ (32 * (4 * (q_) + e4))), (Vt_) + (32 * (c_) + 16) * 512 + (vl ^ (32 * (4 * (q_) + e4)))); } while (0)
#define RC_VMMA(src, pb_, q_) do { _Pragma("unroll") for (int e4 = 0; e4 < 4; ++e4) O[4 * (q_) + e4] = __builtin_amdgcn_mfma_f32_16x16x32_bf16(src[e4], (pb_), O[4 * (q_) + e4], 0, 0, 0); } while (0)
#define RC_PV(Vt_, p0_, p1_) do { bf16x8 va[4], vc[4]; \
        RC_VLOAD(va, Vt_, 0, 0); RC_VLOAD(vc, Vt_, 0, 1); __builtin_amdgcn_sched_barrier(0); \
        RC_VMMA(va, p0_, 0); RC_VLOAD(va, Vt_, 0, 2); __builtin_amdgcn_sched_barrier(0); \
        RC_VMMA(vc, p0_, 1); RC_VLOAD(vc, Vt_, 0, 3); __builtin_amdgcn_sched_barrier(0); \
        RC_VMMA(va, p0_, 2); RC_VLOAD(va, Vt_, 1, 0); __builtin_amdgcn_sched_barrier(0); \
        RC_VMMA(vc, p0_, 3); RC_VLOAD(vc, Vt_, 1, 1); __builtin_amdgcn_sched_barrier(0); \
        RC_VMMA(va, p1_, 0); RC_VLOAD(va, Vt_, 1, 2); __builtin_amdgcn_sched_barrier(0); \
        RC_VMMA(vc, p1_, 1); RC_VLOAD(vc, Vt_, 1, 3); __builtin_amdgcn_sched_barrier(0); \
        RC_VMMA(va, p1_, 2); RC_VMMA(vc, p1_, 3); } while (0)
    for (int ju = 0; ju < nun; ++ju) {
        int b, h, qb; RC_UNIT(ju, b, h, qb);
        const int Q0 = qb * 128, scx = qb >> 1, ns = (scx > 0) ? 2 : 0, t0 = 4 * scx, n = ns + 2 * qb + 2 - t0;
        const int qw = Q0 + 16 * wave, tq = qw + l15;
        const float l2g = log2f(1.0f - exp2f(-5.0f - (float)h));
        const float lbase = fexp2((float)(63 - 4 * kg) * l2g);
        const f32x4 frv = (f32x4){1.0f, fexp2(-l2g), fexp2(-2.0f * l2g), fexp2(-3.0f * l2g)};
        float fk[4];
#pragma unroll
        for (int kb = 0; kb < 4; ++kb) fk[kb] = __builtin_bit_cast(float, __builtin_amdgcn_readfirstlane(__builtin_bit_cast(int, fexp2(-16.0f * (float)kb * l2g))));
        const size_t row = (size_t)b * SEQ + tq;
        const bf16* grow = R + row * N_RET + 2048 + h * 256 + 4 * kg;
        bf16x8 qf[4];
        f32x4 O[16];
#pragma unroll
        for (int eb = 0; eb < 16; ++eb) O[eb] = (f32x4){0.f, 0.f, 0.f, 0.f};
        for (int it2 = 0; it2 < n; ++it2) {
            VMWAIT(0);
            WG_BARRIER();
            if (iu < nun) RC_ISSUE();

            if (it2 == 0) {
#pragma unroll
                for (int ks = 0; ks < 4; ++ks) qf[ks] = *(const LAS bf16x8*)(lds + DR_Q + (ql ^ (64 * ks)));
            }
            const LAS unsigned char* Kt = lds + cb * RC_BUF;
            const LAS unsigned char* Vt = Kt + RC_KT;
            if (it2 < ns) {
                const float fq = fexp2((float)(tq - 256 * scx + 1) * l2g);
                bf16x8 pq[2];
#pragma unroll
                for (int c = 0; c < 2; ++c) {
                    const int ch = 8 * it2 + 4 * c + (kg >> 1);
                    const LAS unsigned char* qb_ = lds + DR_Q + (16 * wave + l15) * 256 + 8 * (kg & 1);
                    const u32x2 x0 = *(const LAS u32x2*)(qb_ + 16 * (ch ^ sw)), x1 = *(const LAS u32x2*)(qb_ + 16 * ((ch + 2) ^ sw));
                    u32x4 w; w.x = cvtpk(bflo(x0.x) * fq, bfhi(x0.x) * fq); w.y = cvtpk(bflo(x0.y) * fq, bfhi(x0.y) * fq);
                    w.z = cvtpk(bflo(x1.x) * fq, bfhi(x1.x) * fq); w.w = cvtpk(bflo(x1.y) * fq, bfhi(x1.y) * fq);
                    pq[c] = __builtin_bit_cast(bf16x8, w);
                }
                RC_PV(Vt, pq[0], pq[1]);
            } else {
                const int k0 = 64 * (t0 + it2 - ns);
                if (k0 <= qw + 15) {
                    f32x4 Sx[4];
#pragma unroll
                    for (int kb = 0; kb < 4; ++kb) Sx[kb] = (f32x4){0.f, 0.f, 0.f, 0.f};
#pragma unroll
                    for (int ks = 0; ks < 4; ++ks) {
                        bf16x8 kf[4];
#pragma unroll
                        for (int kb = 0; kb < 4; ++kb) kf[kb] = *(const LAS bf16x8*)(Kt + kb * 4096 + (kl ^ (64 * ks)));
                        __builtin_amdgcn_sched_barrier(0);
#pragma unroll
                        for (int kb = 0; kb < 4; ++kb) Sx[kb] = __builtin_amdgcn_mfma_f32_16x16x32_bf16(kf[kb], qf[ks], Sx[kb], 0, 0, 0);
                    }
                    const float at = fexp2((float)(tq - k0 - 63) * l2g) * lbase;
#pragma unroll
                    for (int kb = 0; kb < 4; ++kb) Sx[kb] = Sx[kb] * (frv * (at * fk[kb]));
                    if (k0 + 63 > qw) {
                        const int d0 = tq - k0 - 4 * kg;
#pragma unroll
                        for (int kb = 0; kb < 4; ++kb)
#pragma unroll
                            for (int rr = 0; rr < 4; ++rr) Sx[kb][rr] = (d0 - 16 * kb - rr >= 0) ? Sx[kb][rr] : 0.f;
                    }
                    const bf16x8 p0 = pack_p(Sx[0], Sx[1]), p1 = pack_p(Sx[2], Sx[3]);
                    RC_PV(Vt, p0, p1);
                }
            }
            if (it2 == n - 1 && ju + 1 < nun) { int b_, h_, qb_; RC_UNIT(ju + 1, b_, h_, qb_); RC_ISSUE_Q(b_, h_, qb_ * 128); }
            cb ^= 1;
        }
        float sm = 0.f;
#pragma unroll
        for (int eb = 0; eb < 16; ++eb) sm += (O[eb][0] + O[eb][1]) + (O[eb][2] + O[eb][3]);
        sm += __shfl_xor(sm, 16); sm += __shfl_xor(sm, 32);
        const float mean = sm * (1.0f / 256.0f);
        float sq = 0.f;
#pragma unroll
        for (int eb = 0; eb < 16; ++eb) { O[eb] = O[eb] - mean; sq += (O[eb][0] * O[eb][0] + O[eb][1] * O[eb][1]) + (O[eb][2] * O[eb][2] + O[eb][3] * O[eb][3]); }
        sq += __shfl_xor(sq, 16); sq += __shfl_xor(sq, 32);
        const float rstd = 1.0f / sqrtf(sq * (1.0f / 256.0f) + 1e-5f);
        bf16* orow = Yo + row * YW + h * 256 + 4 * kg;
        const LAS float* gg = (const LAS float*)(lds + RC_GAIN) + h * 256 + 4 * kg;
#pragma unroll
        for (int half = 0; half < 2; ++half) {
            u32x2 gv[8];
#pragma unroll
            for (int e8 = 0; e8 < 8; ++e8) gv[e8] = *(const u32x2*)(grow + 16 * (8 * half + e8));
#pragma unroll
            for (int e8 = 0; e8 < 8; ++e8) {
                const int eb = 8 * half + e8;
                const f32x4 gq = *(const LAS f32x4*)(gg + 16 * eb);
                const float g0 = bflo(gv[e8].x), g1 = bfhi(gv[e8].x), g2 = bflo(gv[e8].y), g3 = bfhi(gv[e8].y);
                const float o0 = O[eb][0] * rstd * gq[0] * (g0 * sigmoidf_(g0)), o1 = O[eb][1] * rstd * gq[1] * (g1 * sigmoidf_(g1));
                const float o2 = O[eb][2] * rstd * gq[2] * (g2 * sigmoidf_(g2)), o3 = O[eb][3] * rstd * gq[3] * (g3 * sigmoidf_(g3));
                u32x2 w; w.x = cvtpk(o0, o1); w.y = cvtpk(o2, o3);
                *(u32x2*)(orow + 16 * eb) = w;
            }
        }
    }
#undef RC_UNIT
#undef RC_SETUP
#undef RC_ISSUE
#undef RC_ISSUE_Q
#undef RC_LOK
#undef RC_LOV
#undef RC_VLOAD
#undef RC_VMMA
#undef RC_PV
    VMWAIT(0);
    __syncthreads();
}

__device__ __forceinline__ void phase_final(Frame& F, const bf16* xb, float* out, const float* gain) {
    int lane = lane_now(); asm volatile("" : "+v"(lane));
    const int gw = F.vcu * NWAVES + F.wave, NGW = F.G * NWAVES;
    for (int m = gw; m < M; m += NGW) {
        const u32x4* xr = (const u32x4*)(xb + (size_t)m * D) + lane;
        f32x4 v[2][2]; float s = 0.f;
#pragma unroll
        for (int j = 0; j < 2; ++j) { const u32x4 w = xr[64 * j]; v[j][0] = (f32x4){bflo(w.x), bfhi(w.x), bflo(w.y), bfhi(w.y)}; v[j][1] = (f32x4){bflo(w.z), bfhi(w.z), bflo(w.w), bfhi(w.w)};
            s += ((v[j][0][0] * v[j][0][0] + v[j][0][1] * v[j][0][1]) + (v[j][0][2] * v[j][0][2] + v[j][0][3] * v[j][0][3])) + ((v[j][1][0] * v[j][1][0] + v[j][1][1] * v[j][1][1]) + (v[j][1][2] * v[j][1][2] + v[j][1][3] * v[j][1][3])); }
        const float rs = 1.0f / sqrtf(wave_sum(s) * (1.0f / D) + 1e-6f);
#pragma unroll
        for (int j = 0; j < 2; ++j) { const f32x4* gq = (const f32x4*)(gain + 8 * lane + 512 * j); f32x4* o = (f32x4*)(out + (size_t)m * D + 8 * lane + 512 * j);
            o[0] = v[j][0] * rs * gq[0]; o[1] = v[j][1] * rs * gq[1]; }
    }
}

constexpr int PH_PER_LAYER = 18;
constexpr int N_PHASES = DEPTH * PH_PER_LAYER + 1;

__global__ void __launch_bounds__(NWAVES * 64, 2) mk_fwd(Args args) {
    extern __shared__ __attribute__((aligned(16))) unsigned char lds[];
    Frame F;
    F.lds = (LAS unsigned char*)lds;
    F.MISC = (volatile LAS unsigned*)(F.lds + MISC_OFF);
    F.wave = __builtin_amdgcn_readfirstlane((int)threadIdx.x >> 6);
    F.G = gridDim.x; { const int bx = blockIdx.x; F.vcu = (F.G % 8 == 0) ? (bx % 8) * (F.G / 8) + bx / 8 : bx; }
    unsigned char* ws = args.ws;
    F.ctl = (gu32*)(ws + WS_CTL);
    for (int u = threadIdx.x; u < (LDS_BYTES - LDSCTL_OFF) / 4; u += NWAVES * 64) ((LAS unsigned*)(F.lds + LDSCTL_OFF))[u] = 0u;
    __syncthreads();
#if MK_PER_PHASE
#define GRID_BAR() do { } while (0)
#else
    XcdBarrier bar = xcd_barrier_post((unsigned*)(F.ctl + CW_BAR), F.MISC + 8, F.wave);
#define GRID_BAR() xcd_barrier(bar)
#endif
    const int lo = args.ph_lo, hi = args.ph_hi;
    int ph = 0;
#define PHASE_BEGIN if (ph >= lo && ph < hi) {
#define PHASE_END   if (ph + 1 < hi) GRID_BAR(); } ++ph;

#define WIN ((bf16*)(ws + WS_WIN))
#define WBR ((bf16*)(ws + WS_WBR))
#define WOUT ((bf16*)(ws + WS_WOUT))
#define WGU ((bf16*)(ws + WS_WGU))
#define WDN ((bf16*)(ws + WS_WDN))
#define XB ((bf16*)(ws + WS_XB))
#define Y ((bf16*)(ws + WS_Y))
#define S ((bf16*)(ws + WS_S))
#define XB2 ((bf16*)(ws + WS_XB2))
#define HID ((bf16*)(ws + WS_HID))
#define RSS ((float*)(ws + WS_RSS))
#define RSTD ((float*)(ws + WS_RSTD))
#define CS ((const float*)(ws + WS_CS))
#define BLUT ((const float*)(ws + WS_BLUT))
#define DILP ((float*)(ws + WS_DILP))
#define DILS ((float*)(ws + WS_DILS))

    for (int l = 0; l < DEPTH; ++l) {
        PHASE_BEGIN if (EN_CONV) phase_convert(F, args, l); PHASE_END

        for (int sub = 0; sub < 6; ++sub) {
            const int coff = (sub == 0) ? C_RET : (sub == 1) ? C_DIFF : (sub <= 4) ? (C_DIL + (sub - 2) * N_DILG) : C_GATE;
            const int nsub = (sub >= 2 && sub <= 4) ? N_DILG : 3072;
            PHASE_BEGIN {
                pg8::Gemm g{XB, WIN + (size_t)coff * D, D, D, M, nsub, D}; pg8::StaticOrder So; So.init(M, nsub, F.G, (int)blockIdx.x);
                pg8::EpiIn E{S, nsub, RSTD, CS, (sub == 0) ? 1 : (sub == 5 ? 2 : ((sub == 1 && DIFF_MFMA) ? 3 : ((sub >= 2 && sub <= 4 && DIL_MFMA) ? 4 : 0)))};
                if (EN_IN) for (int rep = 0; rep < REP_IN; ++rep) pg8::gemm_phase<pg8::EpiIn, pg8::StaticOrder, true>(F.lds + RING_OFF, g, So, E, F.wave);
            } PHASE_END
            if (sub == 0) {
#if RET_MFMA
                PHASE_BEGIN if (EN_RET) ret_state_phase(F, S, (bf16*)(ws + WS_ST)); PHASE_END
                PHASE_BEGIN if (EN_RET) for (int rep = 0; rep < REP_RET; ++rep) ret_phase(F, S, (const bf16*)(ws + WS_ST), args.gn_gain + l * 1024, Y); PHASE_END
#else
                PHASE_BEGIN if (EN_RET) naive_ret(F, S, args.gn_gain + l * 1024, Y); PHASE_END
                PHASE_BEGIN PHASE_END
#endif
            } else if (sub == 1) {
                const float lam_init = __builtin_bit_cast(float, __builtin_amdgcn_readfirstlane(__builtin_bit_cast(int, (l == 0) ? 0.2f : 0.35550906759096934f)));
#if DIFF_MFMA
                PHASE_BEGIN if (EN_DIFF) for (int rep = 0; rep < REP_DIFF; ++rep) diff_attn_phase(F, S, args.diff_lambda + l * 256, lam_init, args.subln + l * 128, BLUT, Y); PHASE_END
#else
                PHASE_BEGIN if (EN_DIFF) naive_diff(F, S, args.diff_lambda + l * 256, lam_init, args.subln + l * 128, BLUT, Y); PHASE_END
#endif
            } else if (sub <= 4) {
#if DIL_MFMA
                PHASE_BEGIN if (EN_DIL) dil_attn_phase(F, S, sub - 2, BLUT, DILS, Y); PHASE_END
#else
                PHASE_BEGIN if (EN_DIL) naive_dil(F, S, sub - 2, BLUT, DILP, DILS, Y); PHASE_END
#endif
            }
        }
        PHASE_BEGIN {
            pg8::Gemm g{Y, WBR, YW, YW, M, D, D}; pg8::SegOrder So; So.init(M, D, F.G, (int)blockIdx.x);
            pg8::EpiMerge E{(bf16*)args.out, S};
            if (EN_MERGE) for (int rep = 0; rep < REP_MERGE; ++rep) pg8::gemm_phase<pg8::EpiMerge, pg8::SegOrder, true>(F.lds + RING_OFF, g, So, E, F.wave);
        } PHASE_END
        PHASE_BEGIN {
            pg8::Gemm g{(const bf16*)args.out, WOUT, D, D, M, D, D}; pg8::StaticOrder So; So.init(M, D, F.G, (int)blockIdx.x);
            pg8::EpiRes E{(l == 0) ? (const void*)args.x : (const void*)XB, XB2, RSS, (l == 0) ? 1 : 0};
            if (EN_OUT) pg8::gemm_phase<pg8::EpiRes, pg8::StaticOrder, true>(F.lds + RING_OFF, g, So, E, F.wave);
        } PHASE_END
        PHASE_BEGIN rstd_reduce(F, RSS, RSTD); PHASE_END
        PHASE_BEGIN {
            pg8::Gemm g{XB2, WGU, D, D, M, 2 * FFN, D}; pg8::StaticOrder So; So.init(M, 2 * FFN, F.G, (int)blockIdx.x);
            pg8::EpiSwiGLU E{HID, RSTD};
            if (EN_UP) for (int rep = 0; rep < REP_UP; ++rep) pg8::gemm_phase<pg8::EpiSwiGLU, pg8::StaticOrder, true>(F.lds + RING_OFF, g, So, E, F.wave);
        } PHASE_END
        PHASE_BEGIN {
            pg8::Gemm g{HID, WDN, FFN, FFN, M, D, FFN}; pg8::StaticOrder So; So.init(M, D, F.G, (int)blockIdx.x);
            pg8::EpiRes E{(const void*)XB2, XB, RSS, 0};
            if (EN_DOWN) pg8::gemm_phase<pg8::EpiRes, pg8::StaticOrder, true>(F.lds + RING_OFF, g, So, E, F.wave);
        } PHASE_END
    }
    PHASE_BEGIN if (EN_FIN) phase_final(F, XB, args.out, args.norm_final); PHASE_END
#undef PHASE_BEGIN
#undef PHASE_END
}

extern "C" void kernel_launch(void* const* d_in, const int* in_sizes, int n_in, void* d_out, int out_size, void* d_ws, size_t ws_size, hipStream_t stream) {
    static int grid = 0;
    if (grid == 0) {
        if (n_in != 16 || in_sizes[0] != M * D || out_size != M * D || ws_size < WS_END) { fprintf(stderr, "kernel_launch: unexpected shapes (n_in %d, ws %zu)\n", n_in, ws_size); grid = -1; return; }
        int dev = 0, cus = 0, per_cu = 0;
        if (hipGetDevice(&dev) != hipSuccess || hipDeviceGetAttribute(&cus, hipDeviceAttributeMultiprocessorCount, dev) != hipSuccess) { grid = -1; return; }
        if (hipFuncSetAttribute((const void*)mk_fwd, hipFuncAttributeMaxDynamicSharedMemorySize, LDS_BYTES) != hipSuccess) { grid = -1; return; }
        if (hipOccupancyMaxActiveBlocksPerMultiprocessor(&per_cu, (const void*)mk_fwd, NWAVES * 64, LDS_BYTES) != hipSuccess || per_cu < 1) { fprintf(stderr, "kernel_launch: occupancy query says %d\n", per_cu); }
        (void)hipGetLastError();
        grid = cus;
    }
    if (grid < 0) return;
    if (hipMemsetAsync((char*)d_ws + WS_CTL, 0, CTL_ZERO_BYTES, stream) != hipSuccess) return;
    Args a{};
    a.x = (const float*)d_in[0]; a.w_in = (const float*)d_in[1]; a.w_br_ret = (const float*)d_in[2]; a.w_br_diff = (const float*)d_in[3]; a.w_br_dil = (const float*)d_in[4];
    a.w_out = (const float*)d_in[5]; a.norm_mix = (const float*)d_in[6]; a.norm_ffn = (const float*)d_in[7]; a.gn_gain = (const float*)d_in[8]; a.diff_lambda = (const float*)d_in[9];
    a.subln = (const float*)d_in[10]; a.rel_bias = (const float*)d_in[11]; a.w_gate = (const float*)d_in[12]; a.w_up = (const float*)d_in[13]; a.w_down = (const float*)d_in[14];
    a.norm_final = (const float*)d_in[15];
    a.out = (float*)d_out; a.ws = (unsigned char*)d_ws;
#if MK_PER_PHASE
    for (int p = 0; p < N_PHASES; ++p) {
        a.ph_lo = p; a.ph_hi = p + 1;
        hipLaunchKernelGGL(mk_fwd, dim3(grid), dim3(NWAVES * 64), LDS_BYTES, stream, a);
    }
#else
    a.ph_lo = 0; a.ph_hi = N_PHASES;
    hipLaunchKernelGGL(mk_fwd, dim3(grid), dim3(NWAVES * 64), LDS_BYTES, stream, a);
#endif
}
```

```cpp
#include <hip/hip_runtime.h>
#include <cstdio>
#include <cstdint>

#ifndef MK_PER_PHASE
#define MK_PER_PHASE 0
#endif


#ifndef DIFF_MFMA
#define DIFF_MFMA 1
#endif
#ifndef DIL_MFMA
#define DIL_MFMA 1
#endif
#ifndef RET_MFMA
#define RET_MFMA 1
#endif
#ifndef REP_IN
#define REP_IN 1
#endif
#ifndef REP_RET
#define REP_RET 1
#endif
#ifndef REP_DIFF
#define REP_DIFF 1
#endif
#ifndef REP_MERGE
#define REP_MERGE 1
#endif
#ifndef REP_UP
#define REP_UP 1
#endif
#ifndef PROBE_DIFF
#define PROBE_DIFF 0
#endif
#ifndef EN_ALL
#define EN_ALL 1
#endif
#ifndef EN_CONV
#define EN_CONV EN_ALL
#endif
#ifndef EN_IN
#define EN_IN EN_ALL
#endif
#ifndef EN_RET
#define EN_RET EN_ALL
#endif
#ifndef EN_DIFF
#define EN_DIFF EN_ALL
#endif
#ifndef EN_DIL
#define EN_DIL EN_ALL
#endif
#ifndef EN_MERGE
#define EN_MERGE EN_ALL
#endif
#ifndef EN_OUT
#define EN_OUT EN_ALL
#endif
#ifndef EN_UP
#define EN_UP EN_ALL
#endif
#ifndef EN_DOWN
#define EN_DOWN EN_ALL
#endif
#ifndef EN_FIN
#define EN_FIN EN_ALL
#endif
#define GAS __attribute__((address_space(1)))
#define LAS __attribute__((address_space(3)))
typedef unsigned short bf16;
typedef unsigned short bf16_t;
typedef short bf16x8 __attribute__((ext_vector_type(8)));
typedef float f32x4 __attribute__((ext_vector_type(4)));
typedef float f32x2 __attribute__((ext_vector_type(2)));
typedef unsigned u32x4 __attribute__((ext_vector_type(4)));
typedef unsigned u32x2 __attribute__((ext_vector_type(2)));

constexpr int BATCH = 16, SEQ = 2048, D = 1024, M = BATCH * SEQ, DEPTH = 2;
constexpr int IN_W = 13824, FFN = 2816;
constexpr int C_RET = 0, C_DIFF = 3072, C_DIL = 6144, C_GATE = 10752;
constexpr int N_RET = 3072, N_DIFF = 3072, N_DILG = 1536, N_GATE = 3072;
constexpr int YW = 2560;
constexpr int NWAVES = 8;

constexpr size_t MiB = 1u << 20;
constexpr size_t WS_CTL = 0, CTL_ZERO_BYTES = 1 * MiB;
constexpr size_t WS_CS = 1 * MiB;
constexpr size_t WS_BLUT = 2 * MiB;
constexpr size_t WS_RSS = 3 * MiB;
constexpr size_t WS_RSTD = 5 * MiB;
constexpr size_t WS_WIN = 8 * MiB;
constexpr size_t WS_WBR = 35 * MiB;
constexpr size_t WS_WOUT = 40 * MiB;
constexpr size_t WS_WGU = 42 * MiB;
constexpr size_t WS_WDN = 53 * MiB;
constexpr size_t WS_XB = 60 * MiB;
constexpr size_t WS_Y = 124 * MiB;
constexpr size_t WS_S = 284 * MiB;
constexpr size_t WS_XB2 = 300 * MiB;
constexpr size_t WS_HID = 124 * MiB;
constexpr size_t WS_DILP = WS_S + 96 * MiB;
constexpr size_t WS_DILS = WS_DILP + 64 * MiB;
constexpr size_t WS_END = 512 * MiB;

constexpr int CW_TMO = 0;
constexpr int CW_BAR = 4096;

constexpr int RING_OFF = 0, RING_BYTES = 131072;
constexpr int LDSCTL_OFF = RING_BYTES, MISC_OFF = LDSCTL_OFF + 320;
constexpr int LDS_BYTES = 147456;

typedef GAS unsigned gu32;
#define RLX_AGENT __ATOMIC_RELAXED, __HIP_MEMORY_SCOPE_AGENT
#define LDS_WAIT() asm volatile("s_waitcnt lgkmcnt(0)" ::: "memory")
#define VM_WAIT() asm volatile("s_waitcnt vmcnt(0)" ::: "memory")

__device__ __forceinline__ unsigned f2bf(float f) { unsigned u = __builtin_bit_cast(unsigned, f); return (u + 0x7fffu + ((u >> 16) & 1u)) >> 16; }
__device__ __forceinline__ unsigned pk2(float lo, float hi) { return f2bf(lo) | (f2bf(hi) << 16); }
__device__ __forceinline__ float bflo(unsigned w) { return __builtin_bit_cast(float, w << 16); }
__device__ __forceinline__ float bfhi(unsigned w) { return __builtin_bit_cast(float, w & 0xffff0000u); }
__device__ __forceinline__ float wave_sum(float v) {
#pragma unroll
    for (int o = 1; o < 64; o <<= 1) v += __shfl_xor(v, o);
    return v;
}
__device__ __forceinline__ float wave_max(float v) {
#pragma unroll
    for (int o = 1; o < 64; o <<= 1) v = fmaxf(v, __shfl_xor(v, o));
    return v;
}
__device__ __forceinline__ float rdlane(float v, int j) { return __builtin_bit_cast(float, __builtin_amdgcn_readlane(__builtin_bit_cast(int, v), j)); }
__device__ __forceinline__ float sigmoidf_(float x) { return 1.0f / (1.0f + __expf(-x)); }

__device__ __forceinline__ int lane_now() { int x; asm volatile("v_mbcnt_lo_u32_b32 %0, -1, 0\n\tv_mbcnt_hi_u32_b32 %0, -1, %0" : "=v"(x)); return x; }
#define TID_NOW(wave_) ((wave_) * 64 + lane_now())
__device__ const double ROPE_INV[64] = {1.0,0.8659643233600653,0.7498942093324559,0.6493816315762113,0.5623413251903491,0.4869675251658631,0.4216965034285822,0.3651741272548377,0.31622776601683794,0.27384196342643613,0.23713737056616552,0.2053525026457146,0.1778279410038923,0.1539926526059492,0.1333521432163324,0.11547819846894582,0.1,0.08659643233600653,0.07498942093324558,0.06493816315762113,0.05623413251903491,0.04869675251658631,0.042169650342858224,0.03651741272548377,0.03162277660168379,0.027384196342643614,0.023713737056616554,0.02053525026457146,0.01778279410038923,0.01539926526059492,0.01333521432163324,0.011547819846894581,0.01,0.008659643233600654,0.007498942093324558,0.006493816315762113,0.005623413251903491,0.004869675251658631,0.004216965034285823,0.003651741272548377,0.0031622776601683794,0.0027384196342643613,0.0023713737056616554,0.002053525026457146,0.0017782794100389228,0.001539926526059492,0.001333521432163324,0.0011547819846894581,0.001,0.0008659643233600654,0.0007498942093324559,0.0006493816315762113,0.0005623413251903491,0.0004869675251658631,0.00042169650342858224,0.0003651741272548377,0.00031622776601683794,0.0002738419634264361,0.00023713737056616554,0.0002053525026457146,0.00017782794100389227,0.0001539926526059492,0.0001333521432163324,0.00011547819846894582};
__device__ const unsigned char REL_BUCKET[128] = {0,1,2,3,4,5,6,7,8,9,10,11,12,13,14,15,16,16,16,17,17,18,18,18,19,19,19,20,20,20,20,21,21,21,21,22,22,22,22,22,23,23,23,23,23,23,24,24,24,24,24,24,25,25,25,25,25,25,25,26,26,26,26,26,26,26,26,27,27,27,27,27,27,27,27,27,27,28,28,28,28,28,28,28,28,28,28,29,29,29,29,29,29,29,29,29,29,29,29,30,30,30,30,30,30,30,30,30,30,30,30,30,30,31,31,31,31,31,31,31,31,31,31,31,31,31,31,31};

typedef __bf16 bf16x2_t __attribute__((ext_vector_type(2)));
__device__ __forceinline__ unsigned cvtpk(float lo, float hi) { const f32x2 v = {lo, hi}; const bf16x2_t b = __builtin_convertvector(v, bf16x2_t); return __builtin_bit_cast(unsigned, b); }
namespace pg8 {
#define PG8_LAS __attribute__((address_space(3)))
constexpr int BM = 256, BK = 64, HALF = 128, HTB = HALF * BK * 2, STAGE_BYTES = 8 * HTB, NXCD = 8, WGM = 8;
__host__ __device__ __forceinline__ int lds_byte(int r, int c) { const int st = (r >> 4) * 2 + (c >> 5), rr = r & 15, cc = c & 31, ob = rr * 64 + cc * 2; return st * 1024 + (ob ^ (((ob >> 9) & 1) << 5)); }
__host__ __device__ __forceinline__ void stage_rc(int b, int& R, int& C) { const int st = b / 1024, sb = b % 1024, swz = sb ^ (((sb >> 9) & 1) << 5); R = (st >> 1) * 16 + swz / 64; C = (st & 1) * 32 + (swz % 64) / 2; }
__host__ __device__ __forceinline__ int perm32(int rho) { const int n = rho >> 4, i = rho & 15; return 8 * (i >> 2) + 4 * n + (i & 3); }

struct Unit { int pm, pn, seg; };
struct Gemm { const bf16_t* A; const bf16_t* Bt; int lda, ldb, M, N, K; };

struct StaticOrder {
    int nM, nN, nwg, G, c;
    __device__ void init(int M_, int N_, int G_, int c_) { nM = M_ / BM; nN = N_ / BM; nwg = nM * nN; G = G_; c = c_; }
    __device__ __forceinline__ bool tile(int i, Unit& u) const {
        const long L = (long)i * G + c; if (L >= nwg) return false;
        int wgid = (int)L; { const int q = nwg / NXCD, r = nwg % NXCD, xcd = wgid % NXCD, off = wgid / NXCD; wgid = (xcd < r ? xcd * (q + 1) : r * (q + 1) + (xcd - r) * q) + off; }
        const int nig = WGM * nN, gid = wgid / nig, fm = gid * WGM, gsz = (nM - fm) < WGM ? (nM - fm) : WGM;
        u.pm = fm + ((wgid % nig) % gsz); u.pn = (wgid % nig) / gsz; return true;
    }
    __device__ __forceinline__ bool next(int i, Unit& u) const { u.seg = 0; return tile(i, u); }
    __device__ __forceinline__ const char* abase(const Gemm& g, const Unit& u) const { return (const char*)g.A + (size_t)u.pm * BM * g.lda * 2; }
    __device__ __forceinline__ const char* bbase(const Gemm& g, const Unit& u) const { return (const char*)g.Bt + (size_t)u.pn * BM * g.ldb * 2; }
    __device__ __forceinline__ int nt(const Gemm& g, const Unit&) const { return g.K / BK; }
};
struct SegOrder : StaticOrder {
    __device__ __forceinline__ bool next(int i, Unit& u) const { u.seg = i % 3; return tile(i / 3, u); }
    __device__ __forceinline__ const char* abase(const Gemm& g, const Unit& u) const { return (const char*)g.A + (size_t)u.pm * BM * g.lda * 2 + (size_t)u.seg * 2048; }
    __device__ __forceinline__ const char* bbase(const Gemm& g, const Unit& u) const { return (const char*)g.Bt + (size_t)u.pn * BM * g.ldb * 2 + (size_t)u.seg * 2048; }
    __device__ __forceinline__ int nt(const Gemm&, const Unit& u) const { return u.seg < 2 ? 16 : 8; }
};

__device__ __forceinline__ unsigned cvt_pk_bf16(float lo, float hi) { unsigned r; asm volatile("v_cvt_pk_bf16_f32 %0, %1, %2" : "=v"(r) : "v"(lo), "v"(hi)); return r; }

struct EpiIn {
    static constexpr bool PERM = true, AFTER_DRAIN = false;
    bf16_t* O; int ldc; const float* rstd; const float* cs; int mode;
    __device__ __forceinline__ void operator()(const f32x4 (&acc)[2][2][4][2], const Unit& u, int wr, int wc, int fr, int fq) const {
        const int row0 = u.pm * BM + wr * 64 + fr, col0 = u.pn * BM + wc * 32 + 8 * fq;
        const bool rot = (mode == 1) && (u.pn < 4);
        float sc = 1.0f;
        if (rot && u.pn >= 2) sc = 0.08838834764831845f;
        if (mode == 3 && u.pn < 4) sc = 0.18033688011112042f;
        if (mode == 4 && u.pn < 2) sc = 0.12751743082459868f;
        float rs[2][4];
#pragma unroll
        for (int ai = 0; ai < 2; ++ai)
#pragma unroll
            for (int m = 0; m < 4; ++m) rs[ai][m] = rstd[row0 + ai * HALF + m * 16];
        if (rot) {
#pragma unroll
            for (int ai = 0; ai < 2; ++ai) {
                f32x4 c01[4], c23[4];
#pragma unroll
                for (int m = 0; m < 4; ++m) { const f32x4* cp = (const f32x4*)(cs + ((size_t)((row0 + ai * HALF + m * 16) & (SEQ - 1)) * 64 + 16 * wc + 4 * fq) * 2); c01[m] = cp[0]; c23[m] = cp[1]; }
#pragma unroll
                for (int m = 0; m < 4; ++m) {
                    const float r = rs[ai][m] * sc;
                    bf16_t* rowp = O + ((size_t)(col0 >> 7) * M + (row0 + ai * HALF + m * 16)) * 128 + (col0 & 127);
#pragma unroll
                    for (int bj = 0; bj < 2; ++bj) {
                        const f32x4 v0 = acc[ai][bj][m][0] * r, v1 = acc[ai][bj][m][1] * r;
                        u32x4 w;
                        w.x = cvtpk(v0[0] * c01[m][0] - v0[1] * c01[m][1], v0[0] * c01[m][1] + v0[1] * c01[m][0]);
                        w.y = cvtpk(v0[2] * c01[m][2] - v0[3] * c01[m][3], v0[2] * c01[m][3] + v0[3] * c01[m][2]);
                        w.z = cvtpk(v1[0] * c23[m][0] - v1[1] * c23[m][1], v1[0] * c23[m][1] + v1[1] * c23[m][0]);
                        w.w = cvtpk(v1[2] * c23[m][2] - v1[3] * c23[m][3], v1[2] * c23[m][3] + v1[3] * c23[m][2]);
                        *(u32x4*)(rowp + (size_t)bj * M * 128) = w;
                    }
                }
            }
        } else {
#pragma unroll
            for (int ai = 0; ai < 2; ++ai)
#pragma unroll
                for (int m = 0; m < 4; ++m) {
                    const float r = rs[ai][m] * sc;
                    bf16_t* rowp = O + ((size_t)(col0 >> 7) * M + (row0 + ai * HALF + m * 16)) * 128 + (col0 & 127);
#pragma unroll
                    for (int bj = 0; bj < 2; ++bj) {
                        f32x4 v0 = acc[ai][bj][m][0] * r, v1 = acc[ai][bj][m][1] * r;
                        if (mode == 2) {
#pragma unroll
                            for (int j = 0; j < 4; ++j) { v0[j] = sigmoidf_(v0[j]); v1[j] = sigmoidf_(v1[j]); }
                        }
                        u32x4 w; w.x = cvtpk(v0[0], v0[1]); w.y = cvtpk(v0[2], v0[3]); w.z = cvtpk(v1[0], v1[1]); w.w = cvtpk(v1[2], v1[3]);
                        *(u32x4*)(rowp + (size_t)bj * M * 128) = w;
                    }
                }
        }
    }
};
struct EpiMerge {
    static constexpr bool PERM = true, AFTER_DRAIN = false;
    bf16_t* O; const bf16_t* Gt;
    __device__ __forceinline__ void operator()(const f32x4 (&acc)[2][2][4][2], const Unit& u, int wr, int wc, int fr, int fq) const {
        const int row0 = u.pm * BM + wr * 64 + fr, col0 = u.pn * BM + wc * 32 + 8 * fq;
#pragma unroll
        for (int ai = 0; ai < 2; ++ai) {
            u32x4 g[4][2], p[4][2];
#pragma unroll
            for (int m = 0; m < 4; ++m)
#pragma unroll
                for (int bj = 0; bj < 2; ++bj) {
                    const int row = row0 + ai * HALF + m * 16, col = col0 + bj * HALF;
                    g[m][bj] = *(const u32x4*)(Gt + ((size_t)(u.seg * 8 + (col >> 7)) * M + row) * 128 + (col & 127));
                    p[m][bj] = (u.seg > 0) ? *(const u32x4*)(O + (size_t)row * D + col) : (u32x4){0u, 0u, 0u, 0u};
                }
#pragma unroll
            for (int m = 0; m < 4; ++m)
#pragma unroll
                for (int bj = 0; bj < 2; ++bj) {
                    const int row = row0 + ai * HALF + m * 16, col = col0 + bj * HALF;
                    const f32x4 a0 = acc[ai][bj][m][0], a1 = acc[ai][bj][m][1];
                    const u32x4 gg = g[m][bj], pp = p[m][bj];
                    u32x4 w;
                    w.x = cvtpk(a0[0] * bflo(gg.x) + bflo(pp.x), a0[1] * bfhi(gg.x) + bfhi(pp.x));
                    w.y = cvtpk(a0[2] * bflo(gg.y) + bflo(pp.y), a0[3] * bfhi(gg.y) + bfhi(pp.y));
                    w.z = cvtpk(a1[0] * bflo(gg.z) + bflo(pp.z), a1[1] * bfhi(gg.z) + bfhi(pp.z));
                    w.w = cvtpk(a1[2] * bflo(gg.w) + bflo(pp.w), a1[3] * bfhi(gg.w) + bfhi(pp.w));
                    *(u32x4*)(O + (size_t)row * D + col) = w;
                }
        }
    }
};
struct EpiRes {
    static constexpr bool PERM = true, AFTER_DRAIN = false;
    const void* res; bf16_t* xb; float* rss; int res32;
    __device__ __forceinline__ void operator()(const f32x4 (&acc)[2][2][4][2], const Unit& u, int wr, int wc, int fr, int fq) const {
        const int row0 = u.pm * BM + wr * 64 + fr, col0 = u.pn * BM + wc * 32 + 8 * fq;
#pragma unroll
        for (int ai = 0; ai < 2; ++ai) {
            f32x4 r[4][2][2];
            if (res32) {
#pragma unroll
                for (int m = 0; m < 4; ++m)
#pragma unroll
                    for (int bj = 0; bj < 2; ++bj) { const f32x4* p = (const f32x4*)((const float*)res + (size_t)(row0 + ai * HALF + m * 16) * D + col0 + bj * HALF); r[m][bj][0] = p[0]; r[m][bj][1] = p[1]; }
            } else {
                u32x4 q[4][2];
#pragma unroll
                for (int m = 0; m < 4; ++m)
#pragma unroll
                    for (int bj = 0; bj < 2; ++bj) q[m][bj] = *(const u32x4*)((const bf16_t*)res + (size_t)(row0 + ai * HALF + m * 16) * D + col0 + bj * HALF);
#pragma unroll
                for (int m = 0; m < 4; ++m)
#pragma unroll
                    for (int bj = 0; bj < 2; ++bj) { const u32x4 w = q[m][bj]; r[m][bj][0] = (f32x4){bflo(w.x), bfhi(w.x), bflo(w.y), bfhi(w.y)}; r[m][bj][1] = (f32x4){bflo(w.z), bfhi(w.z), bflo(w.w), bfhi(w.w)}; }
            }
#pragma unroll
            for (int m = 0; m < 4; ++m) {
                const int row = row0 + ai * HALF + m * 16; float ss = 0.f;
#pragma unroll
                for (int bj = 0; bj < 2; ++bj) {
                    const f32x4 v0 = acc[ai][bj][m][0] + r[m][bj][0], v1 = acc[ai][bj][m][1] + r[m][bj][1];
                    ss += ((v0[0] * v0[0] + v0[1] * v0[1]) + (v0[2] * v0[2] + v0[3] * v0[3])) + ((v1[0] * v1[0] + v1[1] * v1[1]) + (v1[2] * v1[2] + v1[3] * v1[3]));
                    u32x4 w; w.x = cvtpk(v0[0], v0[1]); w.y = cvtpk(v0[2], v0[3]); w.z = cvtpk(v1[0], v1[1]); w.w = cvtpk(v1[2], v1[3]);
                    *(u32x4*)(xb + (size_t)row * D + col0 + bj * HALF) = w;
                }
                ss += __shfl_xor(ss, 16); ss += __shfl_xor(ss, 32);
                if (fq == 0) rss[(size_t)row * 16 + u.pn * 4 + wc] = ss;
            }
        }
    }
};
struct EpiSwiGLU {
    static constexpr bool PERM = true, AFTER_DRAIN = false;
    bf16_t* H; const float* rstd;
    __device__ __forceinline__ void operator()(const f32x4 (&acc)[2][2][4][2], const Unit& u, int wr, int wc, int fr, int fq) const {
        const int row0 = u.pm * BM + wr * 64 + fr, col0 = u.pn * HALF + wc * 32 + 8 * fq;
        float rsv[2][4];
#pragma unroll
        for (int ai = 0; ai < 2; ++ai)
#pragma unroll
            for (int m = 0; m < 4; ++m) rsv[ai][m] = rstd[row0 + ai * HALF + m * 16];
#pragma unroll
        for (int ai = 0; ai < 2; ++ai)
#pragma unroll
            for (int m = 0; m < 4; ++m) {
                const int row = row0 + ai * HALF + m * 16;
                const float rs = rsv[ai][m];
                f32x4 h0, h1;
#pragma unroll
                for (int j = 0; j < 4; ++j) {
                    const float g0 = acc[ai][0][m][0][j] * rs, g1 = acc[ai][0][m][1][j] * rs;
                    h0[j] = g0 * sigmoidf_(g0) * (acc[ai][1][m][0][j] * rs);
                    h1[j] = g1 * sigmoidf_(g1) * (acc[ai][1][m][1][j] * rs);
                }
                u32x4 w; w.x = cvtpk(h0[0], h0[1]); w.y = cvtpk(h0[2], h0[3]); w.z = cvtpk(h1[0], h1[1]); w.w = cvtpk(h1[2], h1[3]);
                *(u32x4*)(H + (size_t)row * FFN + col0) = w;
            }
    }
};

template <class Epi, class Sched, bool ALIGN_EPI>
__device__ __forceinline__ void gemm_phase(PG8_LAS unsigned char* lds, const Gemm g, const Sched& S, const Epi& E, const int wv) {
    int tid_ = TID_NOW(wv); asm volatile("" : "+v"(tid_));
    const int tid = tid_, wid = __builtin_amdgcn_readfirstlane(tid >> 6), lane = tid & 63, wr = wid >> 2, wc = wid & 3, fr = lane & 15, fq = lane >> 4;
    unsigned voffA[2], voffB[2];
#pragma unroll
    for (int i = 0; i < 2; ++i) { int R, C; stage_rc(tid * 16 + i * 8192, R, C); const int Rb = Epi::PERM ? ((R & ~31) + perm32(R & 31)) : R;
        voffA[i] = (unsigned)(R * g.lda + C) * 2u; voffB[i] = (unsigned)(Rb * g.ldb + C) * 2u; }
    const size_t kstep = (size_t)(BK * 2);
    const size_t hstepA = (size_t)HALF * g.lda * 2, hstepB = (size_t)HALF * g.ldb * 2;
    const unsigned ldsw = (unsigned)wid * 1024u;
    const int aoff = lds_byte(wr * 64 + fr, fq * 8), boff = lds_byte(wc * 32 + fr, fq * 8);
#define PG8_SA(b, h) (((b) * 2 + (h)) * HTB)
#define PG8_SB(b, h) ((4 + (b) * 2 + (h)) * HTB)
#define PG8_STAGE(bufoff, gbase, voff) do { _Pragma("unroll") for (int _i = 0; _i < 2; ++_i) \
        __builtin_amdgcn_global_load_lds((const unsigned*)((const char*)(gbase) + (voff)[_i]), (PG8_LAS unsigned*)(lds + (bufoff) + ldsw + _i * 8192), 16, 0, 0); } while (0)
#define PG8_LDA(dst, b, h) do { _Pragma("unroll") for (int m = 0; m < 4; ++m) _Pragma("unroll") for (int k = 0; k < 2; ++k) dst[m][k] = *(const PG8_LAS bf16x8*)(lds + PG8_SA(b, h) + aoff + m * 2048 + k * 1024); } while (0)
#define PG8_LDB(dst, b, h) do { _Pragma("unroll") for (int n = 0; n < 2; ++n) _Pragma("unroll") for (int k = 0; k < 2; ++k) dst[n][k] = *(const PG8_LAS bf16x8*)(lds + PG8_SB(b, h) + boff + n * 2048 + k * 1024); } while (0)
#define PG8_MMA(ai, bj, At, Bt) do { __builtin_amdgcn_s_setprio(1); _Pragma("unroll") for (int m = 0; m < 4; ++m) _Pragma("unroll") for (int n = 0; n < 2; ++n) _Pragma("unroll") for (int k = 0; k < 2; ++k) \
        acc[ai][bj][m][n] = __builtin_amdgcn_mfma_f32_16x16x32_bf16(Bt[n][k], At[m][k], acc[ai][bj][m][n], 0, 0, 0); __builtin_amdgcn_s_setprio(0); } while (0)
#define PG8_WAIT_V(n) asm volatile("s_waitcnt vmcnt(" #n ")" ::: "memory")
#define PG8_WAIT_L(n) asm volatile("s_waitcnt lgkmcnt(" #n ")" ::: "memory")
#define PG8_BAR __builtin_amdgcn_s_barrier()
#define PG8_SCHED __builtin_amdgcn_sched_barrier(0)
    Unit cur, nxt; int ui = 0;
    if (!S.next(0, cur)) return;
    f32x4 acc[2][2][4][2];
#pragma unroll
    for (int a = 0; a < 2; ++a)
#pragma unroll
        for (int b = 0; b < 2; ++b)
#pragma unroll
            for (int m = 0; m < 4; ++m)
#pragma unroll
                for (int n = 0; n < 2; ++n) acc[a][b][m][n] = (f32x4){0.f, 0.f, 0.f, 0.f};
    bf16x8 At[4][2], B0[2][2], B1[2][2];
    const char* cA = S.abase(g, cur); const char* cB = S.bbase(g, cur);
    PG8_STAGE(PG8_SB(0, 0), cB, voffB); PG8_STAGE(PG8_SB(0, 1), cB + hstepB, voffB); PG8_STAGE(PG8_SA(0, 0), cA, voffA); PG8_STAGE(PG8_SA(0, 1), cA + hstepA, voffA);
    if (wr == 1) PG8_BAR;
    PG8_WAIT_V(2); PG8_BAR;
    PG8_STAGE(PG8_SB(1, 0), cB + kstep, voffB); PG8_STAGE(PG8_SA(1, 0), cA + kstep, voffA); PG8_STAGE(PG8_SB(1, 1), cB + hstepB + kstep, voffB);
    PG8_WAIT_V(6); PG8_BAR;
    for (;;) {
        const bool has_next = S.next(ui + 1, nxt);
        const int nt = S.nt(g, cur);
        const char* nA = has_next ? S.abase(g, nxt) : cA; const char* nB = has_next ? S.bbase(g, nxt) : cB;
        for (int t = 0; t < nt; t += 2) {
            const bool last = (t == nt - 2);
            const char* a1 = cA + (size_t)(t + 1) * kstep;
            const char* a2 = last ? nA : cA + (size_t)(t + 2) * kstep; const char* b2 = last ? nB : cB + (size_t)(t + 2) * kstep;
            const char* a3 = a2 + kstep; const char* b3 = b2 + kstep;
            PG8_LDB(B0, 0, 0); PG8_LDB(B1, 0, 1); PG8_SCHED; PG8_LDA(At, 0, 0); PG8_STAGE(PG8_SA(1, 1), a1 + hstepA, voffA);
            PG8_WAIT_V(8); PG8_WAIT_L(0); PG8_BAR; PG8_MMA(0, 0, At, B0); PG8_MMA(0, 1, At, B1); PG8_BAR; PG8_SCHED;
            PG8_LDA(At, 0, 1); PG8_STAGE(PG8_SB(0, 0), b2, voffB); PG8_STAGE(PG8_SB(0, 1), b2 + hstepB, voffB); PG8_STAGE(PG8_SA(0, 0), a2, voffA);
            PG8_WAIT_V(8); PG8_WAIT_L(0); PG8_BAR; PG8_MMA(1, 0, At, B0); PG8_MMA(1, 1, At, B1); PG8_BAR; PG8_SCHED;
            PG8_LDB(B0, 1, 0); PG8_LDB(B1, 1, 1); PG8_SCHED; PG8_LDA(At, 1, 0); PG8_STAGE(PG8_SA(0, 1), a2 + hstepA, voffA);
            PG8_WAIT_V(8); PG8_WAIT_L(0); PG8_BAR; PG8_MMA(0, 0, At, B0); PG8_MMA(0, 1, At, B1); PG8_BAR; PG8_SCHED;
            PG8_LDA(At, 1, 1); PG8_STAGE(PG8_SB(1, 0), b3, voffB); PG8_STAGE(PG8_SB(1, 1), b3 + hstepB, voffB); PG8_STAGE(PG8_SA(1, 0), a3, voffA);
            PG8_WAIT_V(8); PG8_WAIT_L(0); PG8_BAR; PG8_MMA(1, 0, At, B0); PG8_MMA(1, 1, At, B1); PG8_BAR; PG8_SCHED;
        }
        if constexpr (ALIGN_EPI) { if (wr == 0) PG8_BAR; }
        E(acc, cur, wr, wc, fr, fq);
        if (!has_next) break;
#pragma unroll
        for (int a = 0; a < 2; ++a)
#pragma unroll
            for (int b = 0; b < 2; ++b)
#pragma unroll
                for (int m = 0; m < 4; ++m)
#pragma unroll
                    for (int n = 0; n < 2; ++n) acc[a][b][m][n] = (f32x4){0.f, 0.f, 0.f, 0.f};
        cur = nxt; cA = nA; cB = nB; ++ui;
        if constexpr (ALIGN_EPI) { if (wr == 1) PG8_BAR; }
    }
    PG8_WAIT_V(0);
    if constexpr (!ALIGN_EPI) { if (wr == 0) PG8_BAR; }
    PG8_BAR;
#undef PG8_SA
#undef PG8_SB
#undef PG8_STAGE
#undef PG8_LDA
#undef PG8_LDB
#undef PG8_MMA
#undef PG8_WAIT_V
#undef PG8_WAIT_L
#undef PG8_BAR
#undef PG8_SCHED
}
}

#define XB_TMO      128
#define XB_XCNT(j)  (256  + 64 * (j))
#define XB_XSUB(j)  (1280 + 64 * (j))
#define XB_XGEN(j)  (2304 + 64 * (j))
#define XB_TOP      3328
#define XB_TOPGEN   3392
#define XCD_BAR_WORDS 3456
#define XB_SPIN_CAP (1u << 18)

__device__ __forceinline__ unsigned xb_ld(unsigned* p)              { return __hip_atomic_load(p, __ATOMIC_RELAXED, __HIP_MEMORY_SCOPE_AGENT); }
__device__ __forceinline__ unsigned xb_add(unsigned* p, unsigned v) { return __hip_atomic_fetch_add(p, v, __ATOMIC_RELAXED, __HIP_MEMORY_SCOPE_AGENT); }
__device__ __forceinline__ unsigned xb_xcc_id() { return (unsigned)__builtin_amdgcn_s_getreg((3 << 11) | 20) & 0xFu; }
#define XB_SPIN(cond, bar) do { unsigned _sp = 0; while (cond) { __builtin_amdgcn_s_sleep(1); \
    if ((++_sp & 255u) == 0u) { if (xb_ld(&(bar)[XB_TMO])) break; if (_sp > XB_SPIN_CAP) { atomicAdd(&(bar)[XB_TMO], 1u); break; } } } } while (0)

struct XcdBarrier { unsigned* bar; unsigned x; volatile LAS unsigned* st; int wave; };

__device__ __forceinline__ XcdBarrier xcd_barrier_post(unsigned* bar, volatile LAS unsigned* st, int wave) {
    XcdBarrier b; b.bar = bar; b.x = xb_xcc_id(); b.st = st; b.wave = wave;
    if (TID_NOW(wave) == 0) (void)xb_add(&bar[XB_XCNT(b.x)], 1u);
    return b;
}
__device__ __forceinline__ void xcd_barrier_complete(unsigned* bar, unsigned x, unsigned& nloc, unsigned& nx) {
    const unsigned G = gridDim.x * gridDim.y * gridDim.z;
    unsigned sum, cnt, mine, sp = 0u;
    for (;;) {
        sum = 0u; cnt = 0u; mine = 0u;
#pragma unroll
        for (unsigned j = 0; j < 16; ++j) { const unsigned c = xb_ld(&bar[XB_XCNT(j)]); sum += c; cnt += (c > 0u) ? 1u : 0u; mine = (j == x) ? c : mine; }
        if (sum == G) break;
        __builtin_amdgcn_s_sleep(1);
        if ((++sp & 255u) == 0u) { if (xb_ld(&bar[XB_TMO])) break; if (sp > XB_SPIN_CAP) { atomicAdd(&bar[XB_TMO], 1u); break; } }
    }
    nloc = mine > 0u ? mine : 1u; nx = cnt > 0u ? cnt : 1u;
}
__device__ __forceinline__ void xcd_barrier(const XcdBarrier& b) {
    asm volatile("s_waitcnt vmcnt(0)" ::: "memory");
    __syncthreads();
    if (TID_NOW(b.wave) == 0) {
        unsigned* bar = b.bar;
        __builtin_amdgcn_s_waitcnt(0);
        unsigned nloc = b.st[0], nx = b.st[1];
        if (nloc == 0u) { xcd_barrier_complete(bar, b.x, nloc, nx); b.st[0] = nloc; b.st[1] = nx; }
        const unsigned old = xb_add(&bar[XB_XSUB(b.x)], 1u);
        const unsigned gen = old / nloc;
        if (old + 1u == (gen + 1u) * nloc) {
            __builtin_amdgcn_fence(__ATOMIC_RELEASE, "agent");
            asm volatile("s_waitcnt vmcnt(0)" ::: "memory");
            const unsigned og = xb_add(&bar[XB_TOP], 1u);
            const unsigned tg = og / nx;
            if (og + 1u == (tg + 1u) * nx) xb_add(&bar[XB_TOPGEN], 1u);
            else XB_SPIN(xb_ld(&bar[XB_TOPGEN]) == tg, bar);
            __builtin_amdgcn_fence(__ATOMIC_ACQUIRE, "agent");
            xb_add(&bar[XB_XGEN(b.x)], 1u);
            asm volatile("s_waitcnt vmcnt(0)" ::: "memory");
        } else {
            XB_SPIN(xb_ld(&bar[XB_XGEN(b.x)]) == gen, bar);
            __builtin_amdgcn_fence(__ATOMIC_ACQUIRE, "agent");
            asm volatile("s_waitcnt vmcnt(0)" ::: "memory");
        }
    }
    __syncthreads();
}

struct Frame {
    LAS unsigned char* lds;
    volatile LAS unsigned* MISC;
    gu32* ctl;
    int wave;
    int vcu, G;
};

__device__ __forceinline__ int dst_row(int map, int n) {
    if (map == 1) { if (n < 1024) { const int d = n & 127; return (n & ~127) + 2 * (d & 63) + (d >> 6); } return n; }
    if (map == 2) return (n >> 7) * 256 + (n & 127);
    if (map == 3) return (n >> 7) * 256 + 128 + (n & 127);
    return n;
}
__device__ __forceinline__ void tr_item(const float* W, int N, bf16* WT, int ldw, int koff, int map, const float* gain, LAS float* scr, int item, int lane) {
    const int nblk = N / 32, kb = item / nblk, nb = item % nblk, k0 = 64 * kb, n0 = 32 * nb;
    float wv[32];
#pragma unroll
    for (int i = 0; i < 32; ++i) wv[i] = W[(size_t)(k0 + 2 * i + (lane >> 5)) * N + n0 + (lane & 31)];
    if (gain) {
#pragma unroll
        for (int i = 0; i < 32; ++i) wv[i] *= gain[k0 + 2 * i + (lane >> 5)];
    }
#pragma unroll
    for (int i = 0; i < 32; ++i) scr[(2 * i + (lane >> 5)) * 33 + (lane & 31)] = wv[i];
    LDS_WAIT(); asm volatile("" ::: "memory");
    const int c = lane & 7;
#pragma unroll
    for (int j = 0; j < 4; ++j) { const int n = (lane >> 3) + 8 * j; const LAS float* s = scr + (8 * c) * 33 + n;
        u32x4 o; o.x = pk2(s[0 * 33], s[1 * 33]); o.y = pk2(s[2 * 33], s[3 * 33]); o.z = pk2(s[4 * 33], s[5 * 33]); o.w = pk2(s[6 * 33], s[7 * 33]);
        *(u32x4*)(WT + (size_t)dst_row(map, n0 + n) * ldw + koff + k0 + 8 * c) = o; }
    LDS_WAIT(); asm volatile("" ::: "memory");
}

struct Args {
    const float* x; const float* w_in; const float* w_br_ret; const float* w_br_diff; const float* w_br_dil; const float* w_out;
    const float* norm_mix; const float* norm_ffn; const float* gn_gain; const float* diff_lambda; const float* subln; const float* rel_bias;
    const float* w_gate; const float* w_up; const float* w_down; const float* norm_final;
    float* out; unsigned char* ws; int ph_lo, ph_hi;
};

__device__ __forceinline__ void rstd_reduce(Frame& F, const float* rss, float* rstd) {
    int tid = TID_NOW(F.wave); asm volatile("" : "+v"(tid));
    for (int row = F.vcu * NWAVES * 64 + tid; row < M; row += F.G * NWAVES * 64) {
        const f32x4* rp = (const f32x4*)(rss + (size_t)row * 16);
        const f32x4 a = rp[0], b = rp[1], c = rp[2], d = rp[3];
        const float ss = (((a[0] + a[1]) + (a[2] + a[3])) + ((b[0] + b[1]) + (b[2] + b[3]))) + (((c[0] + c[1]) + (c[2] + c[3])) + ((d[0] + d[1]) + (d[2] + d[3])));
        rstd[row] = 1.0f / sqrtf(ss * (1.0f / 1024.0f) + 1e-6f);
    }
}
__device__ __forceinline__ void phase_convert(Frame& F, const Args& a, int l) {
    int tid = TID_NOW(F.wave); asm volatile("" : "+v"(tid));
    const int lane = tid & 63;
    LAS float* scr = (LAS float*)(F.lds + RING_OFF + F.wave * 16384);
    const int gw = F.vcu * NWAVES + F.wave, NGW = F.G * NWAVES;
    unsigned char* ws = a.ws;
    constexpr int I_IN = 16 * (IN_W / 32), I_BR = 16 * 32, I_BL = 8 * 32, I_O = 16 * 32, I_G = 16 * (FFN / 32), I_D = (FFN / 64) * 32;
    constexpr int NITEMS = I_IN + 2 * I_BR + I_BL + I_O + 2 * I_G + I_D;
    for (int it = gw; it < NITEMS; it += NGW) {
        int r = it; const float* W; int N; bf16* WT; int ldw, koff = 0, map = 0; const float* gain = nullptr;
        if (r < I_IN) { W = a.w_in + (size_t)l * D * IN_W; N = IN_W; WT = (bf16*)(ws + WS_WIN); ldw = D; map = 1; gain = a.norm_mix + l * D; }
        else if ((r -= I_IN) < I_BR) { W = a.w_br_ret + (size_t)l * 1024 * D; N = D; WT = (bf16*)(ws + WS_WBR); ldw = YW; }
        else if ((r -= I_BR) < I_BR) { W = a.w_br_diff + (size_t)l * 1024 * D; N = D; WT = (bf16*)(ws + WS_WBR); ldw = YW; koff = 1024; }
        else if ((r -= I_BR) < I_BL) { W = a.w_br_dil + (size_t)l * 512 * D; N = D; WT = (bf16*)(ws + WS_WBR); ldw = YW; koff = 2048; }
        else if ((r -= I_BL) < I_O) { W = a.w_out + (size_t)l * D * D; N = D; WT = (bf16*)(ws + WS_WOUT); ldw = D; }
        else if ((r -= I_O) < I_G) { W = a.w_gate + (size_t)l * D * FFN; N = FFN; WT = (bf16*)(ws + WS_WGU); ldw = D; map = 2; gain = a.norm_ffn + l * D; }
        else if ((r -= I_G) < I_G) { W = a.w_up + (size_t)l * D * FFN; N = FFN; WT = (bf16*)(ws + WS_WGU); ldw = D; map = 3; gain = a.norm_ffn + l * D; }
        else { r -= I_G; W = a.w_down + (size_t)l * FFN * D; N = D; WT = (bf16*)(ws + WS_WDN); ldw = FFN; }
        tr_item(W, N, WT, ldw, koff, map, gain, scr, r, lane);
    }
    if (l > 0) rstd_reduce(F, (const float*)(ws + WS_RSS), (float*)(ws + WS_RSTD));
    if (l == 0) {
        bf16* XB = (bf16*)(ws + WS_XB); float* rss = (float*)(ws + WS_RSS);
        for (int m = gw; m < M; m += NGW) {
            const f32x4* xr = (const f32x4*)(a.x + (size_t)m * D) + lane;
            u32x2* o8 = (u32x2*)(XB + (size_t)m * D) + lane;
            float s = 0.f;
#pragma unroll
            for (int j = 0; j < 4; ++j) { const f32x4 v = xr[64 * j]; s += (v[0] * v[0] + v[1] * v[1]) + (v[2] * v[2] + v[3] * v[3]); u32x2 w; w.x = pk2(v[0], v[1]); w.y = pk2(v[2], v[3]); o8[64 * j] = w; }
            s = wave_sum(s);
            if (lane == 0) ((float*)(ws + WS_RSTD))[m] = 1.0f / sqrtf(s * (1.0f / 1024.0f) + 1e-6f);
        }
        float* cs = (float*)(ws + WS_CS);
        const int gt = F.vcu * NWAVES * 64 + tid, NT = F.G * NWAVES * 64;
        for (int idx = gt; idx < SEQ * 64; idx += NT) {
            const int pos = idx >> 6, i = idx & 63;
            const double t = (double)pos * ROPE_INV[i] * 0.15915494309189535;
            const double fr = t - floor(t);
            const float f = (float)fr;
            cs[2 * idx] = __builtin_amdgcn_cosf(f); cs[2 * idx + 1] = __builtin_amdgcn_sinf(f);
        }
        float* blut = (float*)(ws + WS_BLUT);
        for (int idx = gt; idx < 20 * 128; idx += NT) { const int h = idx >> 7, dist = idx & 127; blut[idx] = a.rel_bias[REL_BUCKET[dist] * 20 + h]; }
    }
}

__device__ __forceinline__ float dot8(const u32x4 a, const u32x4 b, float acc) {
    acc += bflo(a.x) * bflo(b.x); acc += bfhi(a.x) * bfhi(b.x); acc += bflo(a.y) * bflo(b.y); acc += bfhi(a.y) * bfhi(b.y);
    acc += bflo(a.z) * bflo(b.z); acc += bfhi(a.z) * bfhi(b.z); acc += bflo(a.w) * bflo(b.w); acc += bfhi(a.w) * bfhi(b.w);
    return acc;
}

__device__ __forceinline__ void naive_ret(Frame& F, const bf16* R, const float* gn_gain, bf16* Y) {
    LAS unsigned* qs = (LAS unsigned*)(F.lds + RING_OFF + F.wave * 1024);
    int lane_ = lane_now(); asm volatile("" : "+v"(lane_));
    const int gw = F.vcu * NWAVES + F.wave, NGW = F.G * NWAVES, lane = lane_;
    for (int it = gw; it < M * 4; it += NGW) {
        const int bh = it & 63, t = it >> 6, b = bh >> 2, h = bh & 3;
        const size_t row = (size_t)b * SEQ + t;
        LDS_WAIT();
        qs[lane] = *(const unsigned*)(R + row * N_RET + h * 128 + 2 * lane);
        LDS_WAIT(); asm volatile("" ::: "memory");
        const float l2g = log2f(1.0f - exp2f(-5.0f - (float)h));
        float y0 = 0.f, y1 = 0.f, y2 = 0.f, y3 = 0.f;
        for (int s0 = 0; s0 <= t; s0 += 64) {
            const int s = s0 + lane; const bool valid = s <= t; const int sc = valid ? s : t;
            const u32x4* kr = (const u32x4*)(R + ((size_t)b * SEQ + sc) * N_RET + 512 + h * 128);
            float dot = 0.f;
#pragma unroll
            for (int d8 = 0; d8 < 16; ++d8) { const u32x4 q8 = *(const LAS u32x4*)(qs + d8 * 4); dot = dot8(q8, kr[d8], dot); }
            const float w = valid ? dot * exp2f((float)(t - s) * l2g) : 0.f;
            const int ns = (t - s0 + 1) < 64 ? (t - s0 + 1) : 64;
            const bf16* vb = R + ((size_t)b * SEQ + s0) * N_RET + 1024 + h * 256 + 4 * lane;
            for (int j = 0; j < ns; ++j) {
                const float wj = rdlane(w, j);
                const u32x2 v = *(const u32x2*)(vb + (size_t)j * N_RET);
                y0 += wj * bflo(v.x); y1 += wj * bfhi(v.x); y2 += wj * bflo(v.y); y3 += wj * bfhi(v.y);
            }
        }
        const float mean = wave_sum((y0 + y1) + (y2 + y3)) * (1.0f / 256.0f);
        const float d0 = y0 - mean, d1 = y1 - mean, d2 = y2 - mean, d3 = y3 - mean;
        const float var = wave_sum((d0 * d0 + d1 * d1) + (d2 * d2 + d3 * d3)) * (1.0f / 256.0f);
        const float rstd = 1.0f / sqrtf(var + 1e-5f);
        const f32x4 gg = *(const f32x4*)(gn_gain + h * 256 + 4 * lane);
        const u32x2 gv = *(const u32x2*)(R + row * N_RET + 2048 + h * 256 + 4 * lane);
        const float g0 = bflo(gv.x), g1 = bfhi(gv.x), g2 = bflo(gv.y), g3 = bfhi(gv.y);
        const float o0 = d0 * rstd * gg[0] * (g0 * sigmoidf_(g0)), o1 = d1 * rstd * gg[1] * (g1 * sigmoidf_(g1));
        const float o2 = d2 * rstd * gg[2] * (g2 * sigmoidf_(g2)), o3 = d3 * rstd * gg[3] * (g3 * sigmoidf_(g3));
        u32x2 w; w.x = pk2(o0, o1); w.y = pk2(o2, o3);
        *(u32x2*)(Y + row * YW + h * 256 + 4 * lane) = w;
    }
}

__device__ __forceinline__ void naive_diff(Frame& F, const bf16* Sd, const float* lamp, float lam_init, const float* subln, const float* blut, bf16* Y) {
    LAS unsigned* qs = (LAS unsigned*)(F.lds + RING_OFF + F.wave * 1024);
    int lane_ = lane_now(); asm volatile("" : "+v"(lane_));
    const int gw = F.vcu * NWAVES + F.wave, NGW = F.G * NWAVES, lane = lane_;
    const float lam = __expf(wave_sum(lamp[lane] * lamp[64 + lane])) - __expf(wave_sum(lamp[128 + lane] * lamp[192 + lane])) + lam_init;
    for (int it = gw; it < M * 8; it += NGW) {
        const int bh = it & 127, t = it >> 7, b = bh >> 3, h = bh & 7;
        const size_t row = (size_t)b * SEQ + t;
        LDS_WAIT();
        qs[lane] = *(const unsigned*)(Sd + row * N_DIFF + h * 128 + 2 * lane);
        LDS_WAIT(); asm volatile("" ::: "memory");
        float om0[2], om1[2];
#pragma unroll
        for (int mm = 0; mm < 2; ++mm) {
            float mrun = -3.0e38f, l = 0.f, o0 = 0.f, o1 = 0.f;
            for (int s0 = 0; s0 <= t; s0 += 64) {
                const int s = s0 + lane; const bool valid = s <= t; const int sc = valid ? s : t;
                const u32x4* kr = (const u32x4*)(Sd + ((size_t)b * SEQ + sc) * N_DIFF + 1024 + h * 128 + mm * 64);
                float dot = 0.f;
#pragma unroll
                for (int d8 = 0; d8 < 8; ++d8) { const u32x4 q8 = *(const LAS u32x4*)(qs + mm * 32 + d8 * 4); dot = dot8(q8, kr[d8], dot); }
                const int dist = (t - sc) < 127 ? (t - sc) : 127;
                const float scv = valid ? dot * 0.125f + blut[h * 128 + dist] : -3.0e38f;
                const float mnew = fmaxf(mrun, wave_max(scv));
                const float alpha = __expf(mrun - mnew);
                const float p = valid ? __expf(scv - mnew) : 0.f;
                l = l * alpha + wave_sum(p); o0 *= alpha; o1 *= alpha; mrun = mnew;
                const int ns = (t - s0 + 1) < 64 ? (t - s0 + 1) : 64;
                const bf16* vb = Sd + ((size_t)b * SEQ + s0) * N_DIFF + 2048 + h * 128 + 2 * lane;
                for (int j = 0; j < ns; ++j) {
                    const float pj = rdlane(p, j);
                    const unsigned v = *(const unsigned*)(vb + (size_t)j * N_DIFF);
                    o0 += pj * bflo(v); o1 += pj * bfhi(v);
                }
            }
            om0[mm] = o0 / l; om1[mm] = o1 / l;
        }
        const float a0 = om0[0] - lam * om0[1], a1 = om1[0] - lam * om1[1];
        const float ms = wave_sum(a0 * a0 + a1 * a1) * (1.0f / 128.0f);
        const float rs = (1.0f / sqrtf(ms + 1e-5f)) * (1.0f - lam_init);
        *(unsigned*)(Y + row * YW + 1024 + h * 128 + 2 * lane) = pk2(a0 * rs * subln[2 * lane], a1 * rs * subln[2 * lane + 1]);
    }
}

__device__ __forceinline__ void naive_dil(Frame& F, const bf16* Sl, int g, const float* blut, float* Pn, float* Ps, bf16* Y) {
    LAS unsigned* qs = (LAS unsigned*)(F.lds + RING_OFF + F.wave * 1024);
    int lane_ = lane_now(); asm volatile("" : "+v"(lane_));
    const int gw = F.vcu * NWAVES + F.wave, NGW = F.G * NWAVES, lane = lane_;
    const int dl = (g == 0) ? 1 : (g == 1 ? 4 : 16);
    for (int it = gw; it < M * 4; it += NGW) {
        const int bh = it & 63, t = it >> 6, b = bh >> 2, h = bh & 3;
        const size_t row = (size_t)b * SEQ + t;
        LDS_WAIT();
        qs[lane] = *(const unsigned*)(Sl + row * N_DILG + h * 128 + 2 * lane);
        LDS_WAIT(); asm volatile("" ::: "memory");
        float sc[3];
#pragma unroll
        for (int tl = 0; tl < 3; ++tl) {
            const int mi = tl * 64 + lane; const int kp = t - mi * dl; const bool valid = (mi <= 128) && (kp >= 0);
            const u32x4* kr = (const u32x4*)(Sl + ((size_t)b * SEQ + (valid ? kp : t)) * N_DILG + 512 + h * 128);
            float dot = 0.f;
#pragma unroll
            for (int d8 = 0; d8 < 16; ++d8) { const u32x4 q8 = *(const LAS u32x4*)(qs + d8 * 4); dot = dot8(q8, kr[d8], dot); }
            const int dist = (mi * dl) < 127 ? (mi * dl) : 127;
            sc[tl] = valid ? dot * 0.08838834764831845f + blut[(8 + g * 4 + h) * 128 + dist] : -3.0e38f;
        }
        float mx = wave_max(fmaxf(fmaxf(sc[0], sc[1]), sc[2]));
        float p[3], den = 0.f;
#pragma unroll
        for (int tl = 0; tl < 3; ++tl) { p[tl] = (sc[tl] > -1.0e38f) ? __expf(sc[tl] - mx) : 0.f; den += p[tl]; }
        den = wave_sum(den);
        float n0 = 0.f, n1 = 0.f;
#pragma unroll
        for (int tl = 0; tl < 3; ++tl) {
            for (int j = 0; j < 64; ++j) {
                const int mi = tl * 64 + j; const int kp = t - mi * dl;
                if (mi > 128 || kp < 0) break;
                const float pj = rdlane(p[tl], j);
                const unsigned v = *(const unsigned*)(Sl + ((size_t)b * SEQ + kp) * N_DILG + 1024 + h * 128 + 2 * lane);
                n0 += pj * bflo(v); n1 += pj * bfhi(v);
            }
        }
        float* pn = Pn + (row * 4 + h) * 128 + 2 * lane; float* ps = Ps + (row * 4 + h) * 2;
        if (g > 0) {
            const f32x2 q = *(const f32x2*)pn; const float pm = ps[0], pd = ps[1];
            const float mnew = fmaxf(mx, pm), ea = __expf(mx - mnew), eb = __expf(pm - mnew);
            n0 = ea * n0 + eb * q[0]; n1 = ea * n1 + eb * q[1]; den = ea * den + eb * pd; mx = mnew;
        }
        if (g < 2) { *(f32x2*)pn = (f32x2){n0, n1}; if (lane == 0) { ps[0] = mx; ps[1] = den; } }
        else { const float inv = 1.0f / den; *(unsigned*)(Y + row * YW + 2048 + h * 128 + 2 * lane) = pk2(n0 * inv, n1 * inv); }
    }
}


typedef short v4i16 __attribute__((ext_vector_type(4)));
__device__ __forceinline__ float fexp2(float x) { return __builtin_amdgcn_exp2f(x); }
__device__ __forceinline__ float hmax4(const f32x4 a) { return fmaxf(fmaxf(a[0], a[1]), fmaxf(a[2], a[3])); }
__device__ __forceinline__ bf16x8 pack_p(const f32x4 a, const f32x4 b) { u32x4 w; w.x = cvtpk(a[0], a[1]); w.y = cvtpk(a[2], a[3]); w.z = cvtpk(b[0], b[1]); w.w = cvtpk(b[2], b[3]); return __builtin_bit_cast(bf16x8, w); }
constexpr int AT_PITCH = 288, AT_TILE = 64 * AT_PITCH, AT_BUF = 2 * AT_TILE, AT_LUT = 2 * AT_BUF, AT_XP = 132;
__device__ __forceinline__ bf16x8 tr16x2(const LAS unsigned char* p0, const LAS unsigned char* p1) {
    const v4i16 a = __builtin_amdgcn_ds_read_tr16_b64_v4i16((LAS v4i16*)p0), b = __builtin_amdgcn_ds_read_tr16_b64_v4i16((LAS v4i16*)p1);
    return __builtin_shufflevector(a, b, 0, 1, 2, 3, 4, 5, 6, 7);
}
#define PIN_Q4(a, b, c, d) asm volatile("" : "+v"(a), "+v"(b), "+v"(c), "+v"(d))
constexpr int DR_TILE = 16384, DR_BUF = 32768, DR_Q = 98304, DR_LUT = 132096, DR_SUBLN = DR_LUT + 4096;
#define VMWAIT(n) asm volatile("s_waitcnt vmcnt(" #n ")" ::: "memory")
__device__ __forceinline__ void vm_wait_n(int n) { if (n <= 0) VMWAIT(0); else if (n <= 4) VMWAIT(4); else VMWAIT(8); }
#define WG_BARRIER() do { asm volatile("" ::: "memory"); __builtin_amdgcn_s_barrier(); asm volatile("" ::: "memory"); } while (0)
__device__ __forceinline__ void dma16(const bf16* gsrc, LAS unsigned char* ldst) {
    unsigned keep; const unsigned dst = (unsigned)__builtin_amdgcn_readfirstlane((int)(unsigned)(uintptr_t)ldst);
    asm volatile("s_mov_b32 %0, m0\n\ts_mov_b32 m0, %2\n\ts_nop 0\n\tglobal_load_lds_dwordx4 %1, off\n\ts_mov_b32 m0, %0" : "=&s"(keep) : "v"(gsrc), "s"(dst) : "memory");
}

__device__ __forceinline__ float hmax16(const f32x4 (&x)[4]) {
    const float a = fmaxf(fmaxf(x[0][0], x[0][1]), x[0][2]), b = fmaxf(fmaxf(x[0][3], x[1][0]), x[1][1]), c = fmaxf(fmaxf(x[1][2], x[1][3]), x[2][0]);
    const float d = fmaxf(fmaxf(x[2][1], x[2][2]), x[2][3]), e = fmaxf(fmaxf(x[3][0], x[3][1]), x[3][2]);
    return fmaxf(fmaxf(fmaxf(a, b), c), fmaxf(fmaxf(d, e), x[3][3]));
}
__device__ __forceinline__ void diff_tile(const LAS unsigned char* Kt, const LAS unsigned char* Vt, int k0, int qw, int l15, int kg, bool first, const bf16x8 (&qf)[2][2],
                                          f32x4 (&O)[2][8], float (&beta)[2], float (&lsum)[2], const LAS float* lut, float c31, const int vl) {
    const int sw = (2 * l15) & 15;
    const int kl = l15 * 256 + 16 * (kg ^ sw);
    const bool nearT = (qw - k0 - 63) < 113;
    f32x4 Sx[2][4];
#pragma unroll
    for (int m = 0; m < 2; ++m) {
        const float i0 = nearT ? -beta[m] : c31 - beta[m];
#pragma unroll
        for (int kb = 0; kb < 4; ++kb) Sx[m][kb] = (f32x4){i0, i0, i0, i0};
    }
#pragma unroll
    for (int m = 0; m < 2; ++m)
#pragma unroll
        for (int ks = 0; ks < 2; ++ks) {
            bf16x8 kf[4];
#pragma unroll
            for (int kb = 0; kb < 4; ++kb) kf[kb] = *(const LAS bf16x8*)(Kt + kb * 4096 + (kl ^ (128 * m + 64 * ks)));
            __builtin_amdgcn_sched_barrier(0);
#pragma unroll
            for (int kb = 0; kb < 4; ++kb) Sx[m][kb] = __builtin_amdgcn_mfma_f32_16x16x32_bf16(kf[kb], qf[m][ks], Sx[m][kb], 0, 0, 0);
        }
#define DIFF_VLOAD(dst, j) do { _Pragma("unroll") for (int e4 = 0; e4 < 4; ++e4) dst[e4] = tr16x2(Vt + (32 * ((j) >> 1)) * 256 + (vl ^ (32 * (4 * ((j) & 1) + e4))), Vt + (32 * ((j) >> 1) + 16) * 256 + (vl ^ (32 * (4 * ((j) & 1) + e4)))); } while (0)
#define DIFF_VMMA(src, j) do { _Pragma("unroll") for (int e4 = 0; e4 < 4; ++e4) _Pragma("unroll") for (int m = 0; m < 2; ++m) \
        O[m][4 * ((j) & 1) + e4] = __builtin_amdgcn_mfma_f32_16x16x32_bf16(src[e4], pf[m][(j) >> 1], O[m][4 * ((j) & 1) + e4], 0, 0, 0); } while (0)
    bf16x8 va[4], vc[4];
    DIFF_VLOAD(va, 0);
    __builtin_amdgcn_sched_barrier(0);
    bf16x8 pf[2][2];
    if (nearT) {
        float bv[4][4];
        const int dq = qw + l15 - k0 - 4 * kg;
#pragma unroll
        for (int kb = 0; kb < 4; ++kb)
#pragma unroll
            for (int r = 0; r < 4; ++r) { int di = dq - 16 * kb - r; di = di < 0 ? 0 : (di > 127 ? 127 : di); bv[kb][r] = lut[di]; }
#pragma unroll
        for (int m = 0; m < 2; ++m)
#pragma unroll
            for (int kb = 0; kb < 4; ++kb)
#pragma unroll
                for (int r = 0; r < 4; ++r) Sx[m][kb][r] = (dq - 16 * kb - r < 0) ? -1.0e30f : Sx[m][kb][r] + bv[kb][r];
    }
#pragma unroll
    for (int m = 0; m < 2; ++m) {
        float mx = hmax16(Sx[m]);
        mx = fmaxf(mx, __shfl_xor(mx, 16)); mx = fmaxf(mx, __shfl_xor(mx, 32));
        if (first || __builtin_amdgcn_ballot_w64(mx > 8.0f) != 0ull) {
            const float dlt = (first || mx > 0.f) ? mx : 0.f, sc = fexp2(-dlt);
            beta[m] += dlt; lsum[m] *= sc;
#pragma unroll
            for (int kb = 0; kb < 4; ++kb) Sx[m][kb] = Sx[m][kb] - dlt;
#pragma unroll
            for (int eb = 0; eb < 8; ++eb) O[m][eb] = O[m][eb] * sc;
        }
#pragma unroll
        for (int kb = 0; kb < 4; ++kb) Sx[m][kb] = (f32x4){fexp2(Sx[m][kb][0]), fexp2(Sx[m][kb][1]), fexp2(Sx[m][kb][2]), fexp2(Sx[m][kb][3])};
        const f32x4 pv4 = (Sx[m][0] + Sx[m][1]) + (Sx[m][2] + Sx[m][3]);
        lsum[m] += (pv4[0] + pv4[1]) + (pv4[2] + pv4[3]);
        pf[m][0] = pack_p(Sx[m][0], Sx[m][1]); pf[m][1] = pack_p(Sx[m][2], Sx[m][3]);
    }
    DIFF_VLOAD(vc, 1);
    __builtin_amdgcn_sched_barrier(0);
    DIFF_VMMA(va, 0);
    DIFF_VLOAD(va, 2);
    __builtin_amdgcn_sched_barrier(0);
    DIFF_VMMA(vc, 1);
    DIFF_VLOAD(vc, 3);
    __builtin_amdgcn_sched_barrier(0);
    DIFF_VMMA(va, 2);
    DIFF_VMMA(vc, 3);
#undef DIFF_VLOAD
#undef DIFF_VMMA
}
__device__ __forceinline__ void diff_attn_phase(Frame& F, const bf16* Sd, const float* lamp, float lam_init, const float* subln, const float* blut, bf16* Yo) {
    int tid_ = TID_NOW(F.wave); asm volatile("" : "+v"(tid_));
    const int tid = tid_, lane = tid & 63, wave = F.wave, l15 = lane & 15, kg = lane >> 4, G = F.G;
    LAS unsigned char* lds = F.lds;
    const float lam = __expf(wave_sum(lamp[lane] * lamp[64 + lane])) - __expf(wave_sum(lamp[128 + lane] * lamp[192 + lane])) + lam_init;
    for (int i = tid; i < 1024; i += NWAVES * 64) ((LAS float*)(lds + DR_LUT))[i] = blut[i] * 1.4426950408889634f;
    if (tid < 128) ((LAS float*)(lds + DR_SUBLN))[tid] = subln[tid] * (1.0f - lam_init);
    VMWAIT(0);
    __syncthreads();
    const int nun = ((int)blockIdx.x < 2048) ? (2048 - (int)blockIdx.x + G - 1) / G : 0;
#define DIFF_UNIT(j, b_, h_, qb_) do { int bh_; if (G == 256) { const int x_ = F.vcu >> 5, i_ = F.vcu & 31, cp_ = ((i_ & 15) + 4 * ((j) >> 1)) & 15; \
            bh_ = 16 * x_ + 2 * (j) + (i_ >> 4); qb_ = ((j) & 1) ? 15 - cp_ : cp_; } \
        else { const int u_ = (int)blockIdx.x + (j) * G; const int hf_ = u_ & 1, jj_ = u_ >> 8; bh_ = (u_ & 255) >> 1; qb_ = hf_ ? (14 - 2 * jj_ + (jj_ & 1)) : (15 - 2 * jj_ - (jj_ & 1)); } \
        b_ = bh_ >> 3; h_ = bh_ & 7; } while (0)
#define DIFF_LO(i) ((4 * (i) + (ln_ >> 4)) * 128 + ((((ln_ & 15) ^ (2 * (ln_ >> 4))) * 8) ^ (64 * ((i) & 1))))
    const int kvrow0 = 16 * (wave & 3), kvblk = 8 + (wave >> 2) * 8;
    LAS unsigned char* const kvdst = lds + (wave >> 2) * DR_TILE + (wave & 3) * 4096;
    LAS unsigned char* const qdst = lds + DR_Q + wave * 4096;
    int iu = 0, it = 0, ib = 0, i_nt = 0, i_b = 0, i_h = 0;
    if (nun > 0) { int qb_; DIFF_UNIT(0, i_b, i_h, qb_); i_nt = 2 * qb_ + 2; }
#define DIFF_ISSUE() do { int ln_ = lane; asm volatile("" : "+v"(ln_)); const bf16* src_ = Sd + ((size_t)(kvblk + i_h) * M + (size_t)i_b * SEQ + 64 * it + kvrow0) * 128; \
        _Pragma("unroll") for (int i = 0; i < 4; ++i) dma16(src_ + DIFF_LO(i), kvdst + ib * DR_BUF + i * 1024); \
        ib = (ib == 2) ? 0 : ib + 1; if (++it == i_nt) { it = 0; ++iu; if (iu < nun) { int qb_; DIFF_UNIT(iu, i_b, i_h, qb_); i_nt = 2 * qb_ + 2; } } } while (0)
#define DIFF_ISSUE_Q(b_, h_, Q0_) do { int ln_ = lane; asm volatile("" : "+v"(ln_)); const bf16* src_ = Sd + ((size_t)(h_) * M + (size_t)(b_) * SEQ + (Q0_) + 16 * wave) * 128; \
        _Pragma("unroll") for (int i = 0; i < 4; ++i) dma16(src_ + DIFF_LO(i), qdst + i * 1024); } while (0)
    if (nun > 0) {
        DIFF_ISSUE(); DIFF_ISSUE();
        { int b_, h_, qb_; DIFF_UNIT(0, b_, h_, qb_); DIFF_ISSUE_Q(b_, h_, qb_ * 128); }
    }
    int cb = 0;
    for (int ju = 0; ju < nun; ++ju) {
        int b, h, qb; DIFF_UNIT(ju, b, h, qb);
        const int Q0 = qb * 128, nt = 2 * qb + 2, qw = Q0 + 16 * wave;
        const LAS float* lut = (const LAS float*)(lds + DR_LUT) + h * 128;
        const float c31 = lut[127];
        bf16x8 qf[2][2];
        f32x4 O[2][8]; float mrun[2], lsum[2];
#pragma unroll
        for (int m = 0; m < 2; ++m) { mrun[m] = 0.f; lsum[m] = 0.f;
#pragma unroll
            for (int eb = 0; eb < 8; ++eb) O[m][eb] = (f32x4){0.f, 0.f, 0.f, 0.f}; }
        for (int t = 0; t < nt; ++t) {
            int ln2 = lane; asm volatile("" : "+v"(ln2));
            const int l15 = ln2 & 15, kg = ln2 >> 4;
            const int ql = (16 * wave + l15) * 256 + 16 * (kg ^ ((2 * l15) & 15));
            const int vl = (4 * kg + (l15 >> 2)) * 256 + 8 * (l15 & 3) + 16 * ((2 * (4 * kg + (l15 >> 2))) & 15);
            const bool has_next = !(ju == nun - 1 && t == nt - 1);
            if (t == 0) VMWAIT(0);
            else vm_wait_n((has_next ? 4 : 0) + (((t == 2 || t == 3) && ju + 1 < nun) ? 4 : 0));
            WG_BARRIER();
            if (iu < nun) DIFF_ISSUE();
            if (t == 1 && ju + 1 < nun) { int b_, h_, qb_; DIFF_UNIT(ju + 1, b_, h_, qb_); DIFF_ISSUE_Q(b_, h_, qb_ * 128); }
            if (t == 0) {
#pragma unroll
                for (int m = 0; m < 2; ++m)
#pragma unroll
                    for (int ks = 0; ks < 2; ++ks) qf[m][ks] = *(const LAS bf16x8*)(lds + DR_Q + (ql ^ (128 * m + 64 * ks)));
            }
            if (64 * t <= qw + 15) diff_tile(lds + cb * DR_BUF, lds + cb * DR_BUF + DR_TILE, 64 * t, qw, l15, kg, t == 0, qf, O, mrun, lsum, lut, c31, vl);
            cb = (cb == 2) ? 0 : cb + 1;
        }
        float inv[2];
#pragma unroll
        for (int m = 0; m < 2; ++m) { float l = lsum[m]; l += __shfl_xor(l, 16); l += __shfl_xor(l, 32); inv[m] = 1.0f / l; }
        const float i0 = inv[0], i1 = inv[1] * lam;
        float ss = 0.f;
#pragma unroll
        for (int eb = 0; eb < 8; ++eb) { const f32x4 a = O[0][eb] * i0 - O[1][eb] * i1; O[0][eb] = a; ss += (a[0] * a[0] + a[1] * a[1]) + (a[2] * a[2] + a[3] * a[3]); }
        ss += __shfl_xor(ss, 16); ss += __shfl_xor(ss, 32);
        const float rs = 1.0f / sqrtf(ss * (1.0f / 128.0f) + 1e-5f);
        bf16* orow = Yo + ((size_t)b * SEQ + qw + l15) * YW + 1024 + h * 128 + 4 * kg;
        const LAS float* sg = (const LAS float*)(lds + DR_SUBLN) + 4 * kg;
#pragma unroll
        for (int eb = 0; eb < 8; ++eb) { const f32x4 gq = *(const LAS f32x4*)(sg + 16 * eb); const f32x4 a = O[0][eb] * rs * gq;
            u32x2 w; w.x = cvtpk(a[0], a[1]); w.y = cvtpk(a[2], a[3]); *(u32x2*)(orow + 16 * eb) = w; }
    }
#undef DIFF_UNIT
#undef DIFF_ISSUE
#undef DIFF_ISSUE_Q
#undef DIFF_LO
    VMWAIT(0);
    __syncthreads();
}

__device__ __forceinline__ void dil_tile(const LAS unsigned char* Kt, const LAS unsigned char* Vt, int m0, int l15, int kg, bool first, const bf16x8 (&qf)[4],
                                         f32x4 (&O)[8], float& beta, float& lsum, const LAS float* lutm, const int (&voff)[8]) {
    const int sw = (2 * l15) & 15;
    const int kl = l15 * 256 + 16 * (kg ^ sw);
    f32x4 Sx[4];
    const float i0 = -beta;
#pragma unroll
    for (int kb = 0; kb < 4; ++kb) Sx[kb] = (f32x4){i0, i0, i0, i0};
#pragma unroll
    for (int h2 = 0; h2 < 2; ++h2) {
        bf16x8 kf[2][4];
#pragma unroll
        for (int ks = 0; ks < 2; ++ks)
#pragma unroll
            for (int kb = 0; kb < 4; ++kb) kf[ks][kb] = *(const LAS bf16x8*)(Kt + kb * 4096 + (kl ^ (64 * (2 * h2 + ks))));
        __builtin_amdgcn_sched_barrier(0);
#pragma unroll
        for (int ks = 0; ks < 2; ++ks)
#pragma unroll
            for (int kb = 0; kb < 4; ++kb) Sx[kb] = __builtin_amdgcn_mfma_f32_16x16x32_bf16(kf[ks][kb], qf[2 * h2 + ks], Sx[kb], 0, 0, 0);
    }
#define DIL_VLOAD(dst, j) do { _Pragma("unroll") for (int e4 = 0; e4 < 4; ++e4) dst[e4] = tr16x2(Vt + (32 * ((j) >> 1)) * 256 + voff[4 * ((j) & 1) + e4], Vt + (32 * ((j) >> 1) + 16) * 256 + voff[4 * ((j) & 1) + e4]); } while (0)
#define DIL_VMMA(src, j) do { _Pragma("unroll") for (int e4 = 0; e4 < 4; ++e4) O[4 * ((j) & 1) + e4] = __builtin_amdgcn_mfma_f32_16x16x32_bf16(src[e4], pf[(j) >> 1], O[4 * ((j) & 1) + e4], 0, 0, 0); } while (0)
    bf16x8 va[4], vc[4];
    DIL_VLOAD(va, 0);
    __builtin_amdgcn_sched_barrier(0);
    {
        const LAS float* lp = lutm + (m0 + 64);
#pragma unroll
        for (int kb = 0; kb < 4; ++kb) { const f32x4 bv = (f32x4){lp[-16 * kb], lp[-16 * kb - 1], lp[-16 * kb - 2], lp[-16 * kb - 3]}; Sx[kb] = Sx[kb] + bv; }
    }
    float mx = hmax16(Sx);
    mx = fmaxf(mx, __shfl_xor(mx, 16)); mx = fmaxf(mx, __shfl_xor(mx, 32));
    if (first || __builtin_amdgcn_ballot_w64(mx > 8.0f) != 0ull) {
        const float dlt = (first || mx > 0.f) ? mx : 0.f, sc = fexp2(-dlt);
        beta += dlt; lsum *= sc;
#pragma unroll
        for (int kb = 0; kb < 4; ++kb) Sx[kb] = Sx[kb] - dlt;
#pragma unroll
        for (int eb = 0; eb < 8; ++eb) O[eb] = O[eb] * sc;
    }
#pragma unroll
    for (int kb = 0; kb < 4; ++kb) Sx[kb] = (f32x4){fexp2(Sx[kb][0]), fexp2(Sx[kb][1]), fexp2(Sx[kb][2]), fexp2(Sx[kb][3])};
    const f32x4 pv4 = (Sx[0] + Sx[1]) + (Sx[2] + Sx[3]);
    lsum += (pv4[0] + pv4[1]) + (pv4[2] + pv4[3]);
    bf16x8 pf[2];
    pf[0] = pack_p(Sx[0], Sx[1]); pf[1] = pack_p(Sx[2], Sx[3]);
    DIL_VLOAD(vc, 1);
    __builtin_amdgcn_sched_barrier(0);
    DIL_VMMA(va, 0);
    DIL_VLOAD(va, 2);
    __builtin_amdgcn_sched_barrier(0);
    DIL_VMMA(vc, 1);
    DIL_VLOAD(vc, 3);
    __builtin_amdgcn_sched_barrier(0);
    DIL_VMMA(va, 2);
    DIL_VMMA(vc, 3);
#undef DIL_VLOAD
#undef DIL_VMMA
}
__device__ __forceinline__ void dil_attn_phase(Frame& F, const bf16* Sl, int g, const float* blut, float* Lse, bf16* Yo) {
    int tid_ = TID_NOW(F.wave); asm volatile("" : "+v"(tid_));
    const int tid = tid_, lane = tid & 63, wave = F.wave, l15 = lane & 15, kg = lane >> 4, G = F.G;
    const int dl = (g == 0) ? 1 : (g == 1 ? 4 : 16);
    LAS unsigned char* lds = F.lds;
    for (int i = tid; i < 1024; i += NWAVES * 64) {
        const int hh = i >> 8, m = (i & 255) - 64; int di = m * dl; di = di < 0 ? 0 : (di > 127 ? 127 : di);
        ((LAS float*)(lds + DR_LUT))[i] = (m >= 0 && m <= 128) ? blut[(8 + g * 4 + hh) * 128 + di] * 1.4426950408889634f : -1.0e30f;
    }
    VMWAIT(0);
    __syncthreads();
    const int nun = ((int)blockIdx.x < 1024) ? (1024 - (int)blockIdx.x + G - 1) / G : 0;
#define DIL_UNIT(j, b_, h_, r_, nbi_) do { const int u_ = (int)blockIdx.x + (j) * G; const int bh_ = u_ & 63, idx_ = u_ >> 6; b_ = bh_ >> 2; h_ = bh_ & 3; r_ = idx_ % dl; nbi_ = idx_ / dl; } while (0)
    int lo[4];
#pragma unroll
    for (int i = 0; i < 4; ++i) { const int ri = 4 * i + (lane >> 4); lo[i] = ri * dl * 128 + ((lane & 15) ^ ((2 * ri) & 15)) * 8; }
    const int kvrow0 = 16 * (wave & 3), kvblk = 4 + (wave >> 2) * 4;
    LAS unsigned char* const kvdst = lds + (wave >> 2) * DR_TILE + (wave & 3) * 4096;
    LAS unsigned char* const qdst = lds + DR_Q + wave * 4096;
    int iu = 0, it = 0, ib = 0, i_nt = 0, i_t0 = 0, i_b = 0, i_h = 0, i_r = 0, i_nbi = 0;
    if (nun > 0) { DIL_UNIT(0, i_b, i_h, i_r, i_nbi); i_t0 = (i_nbi == 0) ? 2 : 0; i_nt = 4 - i_t0; }
#define DIL_ISSUE() do { const bf16* src_ = Sl + ((size_t)(kvblk + i_h) * M + (size_t)i_b * SEQ + (size_t)(((i_nbi - 1) * 128 + 64 * (i_t0 + it) + kvrow0) * dl + i_r)) * 128; \
        _Pragma("unroll") for (int i = 0; i < 4; ++i) dma16(src_ + lo[i], kvdst + ib * DR_BUF + i * 1024); \
        ib = (ib == 2) ? 0 : ib + 1; if (++it == i_nt) { it = 0; ++iu; if (iu < nun) { DIL_UNIT(iu, i_b, i_h, i_r, i_nbi); i_t0 = (i_nbi == 0) ? 2 : 0; i_nt = 4 - i_t0; } } } while (0)
#define DIL_ISSUE_Q(b_, h_, r_, nbi_) do { const bf16* src_ = Sl + ((size_t)(h_) * M + (size_t)(b_) * SEQ + (size_t)(((nbi_) * 128 + 16 * wave) * dl + (r_))) * 128; \
        _Pragma("unroll") for (int i = 0; i < 4; ++i) dma16(src_ + lo[i], qdst + i * 1024); } while (0)
    if (nun > 0) {
        DIL_ISSUE(); DIL_ISSUE();
        { int b_, h_, r_, n_; DIL_UNIT(0, b_, h_, r_, n_); DIL_ISSUE_Q(b_, h_, r_, n_); }
    }
    int cb = 0;
    const int sw = (2 * l15) & 15;
    const int ql = (16 * wave + l15) * 256 + 16 * (kg ^ sw);
    int voff[8];
    { const int vq = 4 * kg + (l15 >> 2); const int vl = vq * 256 + 8 * (l15 & 3) + 16 * ((2 * vq) & 15);
#pragma unroll
      for (int eb = 0; eb < 8; ++eb) voff[eb] = vl ^ (32 * eb); }
    const int tlo = wave >> 2, thi = tlo + 2, qi = 16 * wave + l15;
    for (int ju = 0; ju < nun; ++ju) {
        int b, h, r, nbi; DIL_UNIT(ju, b, h, r, nbi);
        const int t0 = (nbi == 0) ? 2 : 0, nt = 4 - t0, tfirst = tlo > t0 ? tlo : t0;
        const LAS float* lutm = (const LAS float*)(lds + DR_LUT) + h * 256;
        const int qpos = (nbi * 128 + qi) * dl + r;
        const size_t row = (size_t)b * SEQ + qpos;
        bf16* orow = Yo + row * YW + 2048 + h * 128 + 4 * kg;
        bf16x8 qf[4];
        f32x4 O[8]; float beta = 0.f, lsum = 0.f;
#pragma unroll
        for (int eb = 0; eb < 8; ++eb) O[eb] = (f32x4){0.f, 0.f, 0.f, 0.f};
        u32x2 pv[8]; float lp = 0.f;
        for (int t = 0; t < nt; ++t) {
            const int tt = t0 + t;
            const bool has_next = !(ju == nun - 1 && t == nt - 1);
            if (t == 0) VMWAIT(0);
            else vm_wait_n((has_next ? 4 : 0) + (((t == 2 || t == 3) && ju + 1 < nun) ? 4 : 0));
            WG_BARRIER();
            if (iu < nun) DIL_ISSUE();
            if (t == 1 && ju + 1 < nun) { int b_, h_, r_, n_; DIL_UNIT(ju + 1, b_, h_, r_, n_); DIL_ISSUE_Q(b_, h_, r_, n_); }
            if (t == 0) {
#pragma unroll
                for (int ks = 0; ks < 4; ++ks) qf[ks] = *(const LAS bf16x8*)(lds + DR_Q + (ql ^ (64 * ks)));
            }
            if (t == nt - 1 && g > 0) {
#pragma unroll
                for (int eb = 0; eb < 8; ++eb) pv[eb] = *(const u32x2*)(orow + 16 * eb);
                lp = Lse[row * 4 + h];
            }
            if (tt >= tlo && tt <= thi) dil_tile(lds + cb * DR_BUF, lds + cb * DR_BUF + DR_TILE, qi + 128 - 64 * tt - 4 * kg, l15, kg, tt == tfirst, qf, O, beta, lsum, lutm, voff);
            cb = (cb == 2) ? 0 : cb + 1;
        }
        float l = lsum; l += __shfl_xor(l, 16); l += __shfl_xor(l, 32);
        float inv = 1.0f / l, lse = beta + log2f(l);
        float wa = inv, wb = 0.f;
        if (g > 0) {
            const float mm = fmaxf(lse, lp), ea = fexp2(lse - mm), eb_ = fexp2(lp - mm), tot = ea + eb_;
            wa = inv * ea / tot; wb = eb_ / tot; lse = mm + log2f(tot);
        }
#pragma unroll
        for (int eb = 0; eb < 8; ++eb) {
            f32x4 a = O[eb] * wa;
            if (g > 0) { a[0] += wb * bflo(pv[eb].x); a[1] += wb * bfhi(pv[eb].x); a[2] += wb * bflo(pv[eb].y); a[3] += wb * bfhi(pv[eb].y); }
            u32x2 w; w.x = cvtpk(a[0], a[1]); w.y = cvtpk(a[2], a[3]); *(u32x2*)(orow + 16 * eb) = w;
        }
        if (g < 2 && kg == 0) Lse[row * 4 + h] = lse;
    }
#undef DIL_UNIT
#undef DIL_ISSUE
#undef DIL_ISSUE_Q
    VMWAIT(0);
    __syncthreads();
}

constexpr int RS_VP = 160, RS_KT = 64 * AT_PITCH, RS_BUF = RS_KT + 64 * RS_VP;
constexpr size_t WS_ST = WS_S + 192 * MiB;
__device__ __forceinline__ void ret_state_phase(Frame& F, const bf16* R, bf16* ST) {
    constexpr int SB = 24576, SKT = 16384;
    int tid_ = TID_NOW(F.wave); asm volatile("" : "+v"(tid_));
    const int tid = tid_, lane = tid & 63, wave = F.wave, l15 = lane & 15, kg = lane >> 4;
    LAS unsigned char* lds = F.lds;
    __syncthreads();
    for (int u = F.vcu; u < 256; u += F.G) {
        const int bh = u >> 2, es = u & 3, b = bh >> 2, h = bh & 3;
        const float l2g = log2f(1.0f - exp2f(-5.0f - (float)h));
        const float g256 = fexp2(256.0f * l2g);
        float cw[2][8];
#pragma unroll
        for (int c = 0; c < 2; ++c)
#pragma unroll
            for (int j = 0; j < 8; ++j) cw[c][j] = fexp2((float)(63 - (32 * c + 16 * (j >> 2) + 4 * kg + (j & 3))) * l2g);
        const bf16* kblk = R + ((size_t)(4 + h) * M + (size_t)b * SEQ) * 128;
        const bf16* vblk = R + ((size_t)(8 + 2 * h + (es >> 1)) * M + (size_t)b * SEQ) * 128 + (es & 1) * 64;
        const bf16* ksrc0 = kblk + (size_t)(8 * wave + (lane >> 4)) * 128 + (((lane & 15) ^ (2 * (lane >> 4))) * 8);
        const bf16* ksrc1 = kblk + (size_t)(8 * wave + 4 + (lane >> 4)) * 128 + ((((lane & 15) ^ (2 * (lane >> 4))) * 8) ^ 64);
        const bf16* vsrc = vblk + (size_t)(8 * wave + (lane >> 3)) * 128 + (((lane & 7) ^ ((lane >> 3) & 6)) * 8);
        LAS unsigned char* const kd = lds + wave * 2048;
        LAS unsigned char* const vd = lds + SKT + wave * 1024;
#define RS_ISSUE(t_) do { const size_t ro_ = (size_t)(64 * (t_)) * 128; LAS unsigned char* bo_ = (LAS unsigned char*)0 + ((t_) & 3) * SB; \
        dma16(ksrc0 + ro_, kd + ((t_) & 3) * SB); dma16(ksrc1 + ro_, kd + ((t_) & 3) * SB + 1024); dma16(vsrc + ro_, vd + ((t_) & 3) * SB); (void)bo_; } while (0)
        RS_ISSUE(0); RS_ISSUE(1); RS_ISSUE(2);
        f32x4 acc[4];
#pragma unroll
        for (int eb = 0; eb < 4; ++eb) acc[eb] = (f32x4){0.f, 0.f, 0.f, 0.f};
        const int rl = 4 * kg + (l15 >> 2), pp = l15 & 3;
        const int kls = (rl * 256 + 8 * pp + 16 * ((2 * rl) & 15)) ^ (32 * wave);
        const int vls = rl * 128 + 8 * pp + 16 * (rl & 6);
        for (int t = 0; t < 28; ++t) {
            if (t < 26) VMWAIT(6); else if (t == 26) VMWAIT(3); else VMWAIT(0);
            WG_BARRIER();
            if (t + 3 < 28) RS_ISSUE(t + 3);
            const LAS unsigned char* Kt = lds + (t & 3) * SB;
            const LAS unsigned char* Vt = Kt + SKT;
            const float tf = fexp2((float)(192 - 64 * (t & 3)) * l2g);
            bf16x8 kf[2], vf[2][4];
#pragma unroll
            for (int c = 0; c < 2; ++c) {
                kf[c] = tr16x2(Kt + (32 * c) * 256 + kls, Kt + (32 * c + 16) * 256 + kls);
#pragma unroll
                for (int eb = 0; eb < 4; ++eb) vf[c][eb] = tr16x2(Vt + (32 * c) * 128 + (vls ^ (32 * eb)), Vt + (32 * c + 16) * 128 + (vls ^ (32 * eb)));
            }
#pragma unroll
            for (int c = 0; c < 2; ++c) {
                const u32x4 w = __builtin_bit_cast(u32x4, kf[c]);
                u32x4 o;
                o.x = cvtpk(bflo(w.x) * (cw[c][0] * tf), bfhi(w.x) * (cw[c][1] * tf)); o.y = cvtpk(bflo(w.y) * (cw[c][2] * tf), bfhi(w.y) * (cw[c][3] * tf));
                o.z = cvtpk(bflo(w.z) * (cw[c][4] * tf), bfhi(w.z) * (cw[c][5] * tf)); o.w = cvtpk(bflo(w.w) * (cw[c][6] * tf), bfhi(w.w) * (cw[c][7] * tf));
                kf[c] = __builtin_bit_cast(bf16x8, o);
            }
#pragma unroll
            for (int c = 0; c < 2; ++c)
#pragma unroll
                for (int eb = 0; eb < 4; ++eb) acc[eb] = __builtin_amdgcn_mfma_f32_16x16x32_bf16(vf[c][eb], kf[c], acc[eb], 0, 0, 0);
            if ((t & 3) == 3) {
                bf16* st = ST + ((size_t)(bh * 7 + (t >> 2)) * 128 + 16 * wave + l15) * 256 + es * 64 + 4 * kg;
#pragma unroll
                for (int eb = 0; eb < 4; ++eb) { u32x2 w; w.x = cvtpk(acc[eb][0], acc[eb][1]); w.y = cvtpk(acc[eb][2], acc[eb][3]); *(u32x2*)(st + 16 * eb) = w; acc[eb] = acc[eb] * g256; }
            }
        }
        VMWAIT(0);
        WG_BARRIER();
#undef RS_ISSUE
    }
    __syncthreads();
}
constexpr int RC_KT = 16384, RC_BUF = 49152, RC_GAIN = DR_LUT;
__device__ __forceinline__ void ret_phase(Frame& F, const bf16* R, const bf16* ST, const float* gn_gain, bf16* Yo) {
    int tid_ = TID_NOW(F.wave); asm volatile("" : "+v"(tid_));
    const int tid = tid_, lane = tid & 63, wave = F.wave, l15 = lane & 15, kg = lane >> 4, G = F.G;
    LAS unsigned char* lds = F.lds;
    for (int i = tid; i < 1024; i += NWAVES * 64) ((LAS float*)(lds + RC_GAIN))[i] = gn_gain[i];
    VMWAIT(0);
    __syncthreads();
    const int nun = ((int)blockIdx.x < 1024) ? (1024 - (int)blockIdx.x + G - 1) / G : 0;
#define RC_UNIT(j, b_, h_, qb_) do { const int u_ = (int)blockIdx.x + (j) * G; const int bh_ = (u_ & 255) >> 2, qt_ = u_ & 3, jj_ = u_ >> 8; qb_ = 4 * jj_ + ((qt_ + jj_) & 3); b_ = bh_ >> 2; h_ = bh_ & 3; } while (0)
#define RC_LOK(i) ((4 * (i) + (ln_ >> 4)) * 128 + ((((ln_ & 15) ^ (2 * (ln_ >> 4))) * 8) ^ (64 * ((i) & 1))))
#define RC_LOV(i, pitch) ((2 * (i) + (ln_ >> 5)) * (pitch) + ((((ln_ & 31) ^ (2 * (ln_ >> 5))) * 8) ^ (32 * (i))))
    LAS unsigned char* const kdst = lds + wave * 2048;
    LAS unsigned char* const vdst = lds + RC_KT + wave * 4096;
    LAS unsigned char* const qdst = lds + DR_Q + wave * 4096;
    int iu = 0, it = 0, ib = 0, i_n = 0, i_ns = 0, i_t0 = 0, i_b = 0, i_h = 0, i_sc = 0;
#define RC_SETUP(j) do { int qb_; RC_UNIT(j, i_b, i_h, qb_); i_sc = qb_ >> 1; i_ns = (i_sc > 0) ? 2 : 0; i_t0 = 4 * i_sc; i_n = i_ns + 2 * qb_ + 2 - i_t0; } while (0)
    if (nun > 0) RC_SETUP(0);
#define RC_ISSUE() do { int ln_ = lane; asm volatile("" : "+v"(ln_)); LAS unsigned char* kd_ = kdst + ib * RC_BUF; LAS unsigned char* vd_ = vdst + ib * RC_BUF; \
        if (it < i_ns) { const bf16* src_ = ST + ((size_t)((i_b * 4 + i_h) * 7 + i_sc - 1) * 128 + 64 * it + 8 * wave) * 256; \
            _Pragma("unroll") for (int i = 0; i < 4; ++i) dma16(src_ + RC_LOV(i, 256), vd_ + i * 1024); } \
        else { const size_t ro_ = ((size_t)i_b * SEQ + 64 * (i_t0 + it - i_ns) + 8 * wave) * 128; \
            _Pragma("unroll") for (int i = 0; i < 2; ++i) dma16(R + (size_t)(4 + i_h) * M * 128 + ro_ + RC_LOK(i), kd_ + i * 1024); \
              \
            _Pragma("unroll") for (int i = 0; i < 4; ++i) { const int ch_ = (ln_ & 31) ^ ((2 * (ln_ >> 5)) ^ (4 * i)); \
                dma16(R + (size_t)(8 + 2 * i_h + (ch_ >> 4)) * M * 128 + ro_ + (size_t)(2 * i + (ln_ >> 5)) * 128 + (ch_ & 15) * 8, vd_ + i * 1024); } } \
        ib ^= 1; if (++it == i_n) { it = 0; ++iu; if (iu < nun) RC_SETUP(iu); } } while (0)
#define RC_ISSUE_Q(b_, h_, Q0_) do { int ln_ = lane; asm volatile("" : "+v"(ln_)); const bf16* src_ = R + ((size_t)(h_) * M + (size_t)(b_) * SEQ + (Q0_) + 16 * wave) * 128; \
        _Pragma("unroll") for (int i = 0; i < 4; ++i) dma16(src_ + RC_LOK(i), qdst + i * 1024); } while (0)
    if (nun > 0) { RC_ISSUE(); { int b_, h_, qb_; RC_UNIT(0, b_, h_, qb_); RC_ISSUE_Q(b_, h_, qb_ * 128); } }
    int cb = 0;
#define RC_VLOAD(dst, Vt_, c_, q_) do { _Pragma("unroll") for (int e4 = 0; e4 < 4; ++e4) dst[e4] = tr16x2((Vt_) + (32 * (c_)) * 512 + (vl ^ (32 * (4 * (q_) + e4))), (Vt_) + (32 * (c_) + 16) * 512 + (vl ^ (32 * (4 * (q_) + e4)))); } while (0)
#define RC_VMMA(src, pb_, q_) do { _Pragma("unroll") for (int e4 = 0; e4 < 4; ++e4) O[4 * (q_) + e4] = __builtin_amdgcn_mfma_f32_16x16x32_bf16(src[e4], (pb_), O[4 * (q_) + e4], 0, 0, 0); } while (0)
#define RC_PV(Vt_, p0_, p1_) do { bf16x8 va[4], vc[4]; \
        RC_VLOAD(va, Vt_, 0, 0); RC_VLOAD(vc, Vt_, 0, 1); __builtin_amdgcn_sched_barrier(0); \
        RC_VMMA(va, p0_, 0); RC_VLOAD(va, Vt_, 0, 2); __builtin_amdgcn_sched_barrier(0); \
        RC_VMMA(vc, p0_, 1); RC_VLOAD(vc, Vt_, 0, 3); __builtin_amdgcn_sched_barrier(0); \
        RC_VMMA(va, p0_, 2); RC_VLOAD(va, Vt_, 1, 0); __builtin_amdgcn_sched_barrier(0); \
        RC_VMMA(vc, p0_, 3); RC_VLOAD(vc, Vt_, 1, 1); __builtin_amdgcn_sched_barrier(0); \
        RC_VMMA(va, p1_, 0); RC_VLOAD(va, Vt_, 1, 2); __builtin_amdgcn_sched_barrier(0); \
        RC_VMMA(vc, p1_, 1); RC_VLOAD(vc, Vt_, 1, 3); __builtin_amdgcn_sched_barrier(0); \
        RC_VMMA(va, p1_, 2); RC_VMMA(vc, p1_, 3); } while (0)
    for (int ju = 0; ju < nun; ++ju) {
        int b, h, qb; RC_UNIT(ju, b, h, qb);
        const int Q0 = qb * 128, scx = qb >> 1, ns = (scx > 0) ? 2 : 0, t0 = 4 * scx, n = ns + 2 * qb + 2 - t0;
        const int qw = Q0 + 16 * wave, tq = qw + l15;
        const float l2g = log2f(1.0f - exp2f(-5.0f - (float)h));
        const float lbase = fexp2((float)(63 - 4 * kg) * l2g);
        const float fr1 = __builtin_bit_cast(float, __builtin_amdgcn_readfirstlane(__builtin_bit_cast(int, fexp2(-l2g))));
        const float fr2 = __builtin_bit_cast(float, __builtin_amdgcn_readfirstlane(__builtin_bit_cast(int, fexp2(-2.0f * l2g))));
        const float fr3 = __builtin_bit_cast(float, __builtin_amdgcn_readfirstlane(__builtin_bit_cast(int, fexp2(-3.0f * l2g))));
        float fk[4];
#pragma unroll
        for (int kb = 0; kb < 4; ++kb) fk[kb] = __builtin_bit_cast(float, __builtin_amdgcn_readfirstlane(__builtin_bit_cast(int, fexp2(-16.0f * (float)kb * l2g))));
        const size_t row = (size_t)b * SEQ + tq;
        const bf16* grow = R + ((size_t)(16 + 2 * h) * M + row) * 128 + 4 * kg;
        bf16x8 qf[4];
        f32x4 O[16];
#pragma unroll
        for (int eb = 0; eb < 16; ++eb) O[eb] = (f32x4){0.f, 0.f, 0.f, 0.f};
        for (int it2 = 0; it2 < n; ++it2) {
            int ln2 = lane; asm volatile("" : "+v"(ln2));
            const int l15 = ln2 & 15, kg = ln2 >> 4, sw = (2 * l15) & 15;
            const int ql = (16 * wave + l15) * 256 + 16 * (kg ^ sw), kl = l15 * 256 + 16 * (kg ^ sw);
            const int vl = (4 * kg + (l15 >> 2)) * 512 + 8 * (l15 & 3) + 16 * ((2 * (4 * kg + (l15 >> 2))) & 15);
            VMWAIT(0);
            WG_BARRIER();
            if (iu < nun) RC_ISSUE();

            if (it2 == 0) {
#pragma unroll
                for (int ks = 0; ks < 4; ++ks) qf[ks] = *(const LAS bf16x8*)(lds + DR_Q + (ql ^ (64 * ks)));
            }
            const LAS unsigned char* Kt = lds + cb * RC_BUF;
            const LAS unsigned char* Vt = Kt + RC_KT;
            if (it2 < ns) {
                const float fq = fexp2((float)(tq - 256 * scx + 1) * l2g);
                bf16x8 pq[2];
#pragma unroll
                for (int c = 0; c < 2; ++c) {
                    const int ch = 8 * it2 + 4 * c + (kg >> 1);
                    const LAS unsigned char* qb_ = lds + DR_Q + (16 * wave + l15) * 256 + 8 * (kg & 1);
                    const u32x2 x0 = *(const LAS u32x2*)(qb_ + 16 * (ch ^ sw)), x1 = *(const LAS u32x2*)(qb_ + 16 * ((ch + 2) ^ sw));
                    u32x4 w; w.x = cvtpk(bflo(x0.x) * fq, bfhi(x0.x) * fq); w.y = cvtpk(bflo(x0.y) * fq, bfhi(x0.y) * fq);
                    w.z = cvtpk(bflo(x1.x) * fq, bfhi(x1.x) * fq); w.w = cvtpk(bflo(x1.y) * fq, bfhi(x1.y) * fq);
                    pq[c] = __builtin_bit_cast(bf16x8, w);
                }
                RC_PV(Vt, pq[0], pq[1]);
            } else {
                const int k0 = 64 * (t0 + it2 - ns);
                if (k0 <= qw + 15) {
                    f32x4 Sx[4];
#pragma unroll
                    for (int kb = 0; kb < 4; ++kb) Sx[kb] = (f32x4){0.f, 0.f, 0.f, 0.f};
#pragma unroll
                    for (int ks = 0; ks < 4; ++ks) {
                        bf16x8 kf[4];
#pragma unroll
                        for (int kb = 0; kb < 4; ++kb) kf[kb] = *(const LAS bf16x8*)(Kt + kb * 4096 + (kl ^ (64 * ks)));
                        __builtin_amdgcn_sched_barrier(0);
#pragma unroll
                        for (int kb = 0; kb < 4; ++kb) Sx[kb] = __builtin_amdgcn_mfma_f32_16x16x32_bf16(kf[kb], qf[ks], Sx[kb], 0, 0, 0);
                    }
                    const float at = fexp2((float)(tq - k0 - 63) * l2g) * lbase;
#pragma unroll
                    for (int kb = 0; kb < 4; ++kb) { const float a = at * fk[kb]; Sx[kb][0] *= a; Sx[kb][1] *= a * fr1; Sx[kb][2] *= a * fr2; Sx[kb][3] *= a * fr3; }
                    if (k0 + 63 > qw) {
                        const int d0 = tq - k0 - 4 * kg;
#pragma unroll
                        for (int kb = 0; kb < 4; ++kb)
#pragma unroll
                            for (int rr = 0; rr < 4; ++rr) Sx[kb][rr] = (d0 - 16 * kb - rr >= 0) ? Sx[kb][rr] : 0.f;
                    }
                    const bf16x8 p0 = pack_p(Sx[0], Sx[1]), p1 = pack_p(Sx[2], Sx[3]);
                    RC_PV(Vt, p0, p1);
                }
            }
            if (it2 == n - 1 && ju + 1 < nun) { int b_, h_, qb_; RC_UNIT(ju + 1, b_, h_, qb_); RC_ISSUE_Q(b_, h_, qb_ * 128); }
            cb ^= 1;
        }
        float sm = 0.f;
#pragma unroll
        for (int eb = 0; eb < 16; ++eb) sm += (O[eb][0] + O[eb][1]) + (O[eb][2] + O[eb][3]);
        sm += __shfl_xor(sm, 16); sm += __shfl_xor(sm, 32);
        const float mean = sm * (1.0f / 256.0f);
        float sq = 0.f;
#pragma unroll
        for (int eb = 0; eb < 16; ++eb) { O[eb] = O[eb] - mean; sq += (O[eb][0] * O[eb][0] + O[eb][1] * O[eb][1]) + (O[eb][2] * O[eb][2] + O[eb][3] * O[eb][3]); }
        sq += __shfl_xor(sq, 16); sq += __shfl_xor(sq, 32);
        const float rstd = 1.0f / sqrtf(sq * (1.0f / 256.0f) + 1e-5f);
        bf16* orow = Yo + row * YW + h * 256 + 4 * kg;
        const LAS float* gg = (const LAS float*)(lds + RC_GAIN) + h * 256 + 4 * kg;
#pragma unroll
        for (int half = 0; half < 2; ++half) {
            u32x2 gv[8];
#pragma unroll
            for (int e8 = 0; e8 < 8; ++e8) gv[e8] = *(const u32x2*)(grow + (size_t)half * M * 128 + 16 * e8);
#pragma unroll
            for (int e8 = 0; e8 < 8; ++e8) {
                const int eb = 8 * half + e8;
                const f32x4 gq = *(const LAS f32x4*)(gg + 16 * eb);
                const float g0 = bflo(gv[e8].x), g1 = bfhi(gv[e8].x), g2 = bflo(gv[e8].y), g3 = bfhi(gv[e8].y);
                const float o0 = O[eb][0] * rstd * gq[0] * (g0 * sigmoidf_(g0)), o1 = O[eb][1] * rstd * gq[1] * (g1 * sigmoidf_(g1));
                const float o2 = O[eb][2] * rstd * gq[2] * (g2 * sigmoidf_(g2)), o3 = O[eb][3] * rstd * gq[3] * (g3 * sigmoidf_(g3));
                u32x2 w; w.x = cvtpk(o0, o1); w.y = cvtpk(o2, o3);
                *(u32x2*)(orow + 16 * eb) = w;
            }
        }
    }
#undef RC_UNIT
#undef RC_SETUP
#undef RC_ISSUE
#undef RC_ISSUE_Q
#undef RC_LOK
#undef RC_LOV
#undef RC_VLOAD
#undef RC_VMMA
#undef RC_PV
    VMWAIT(0);
    __syncthreads();
}

__device__ __forceinline__ void phase_final(Frame& F, const bf16* xb, float* out, const float* gain) {
    int lane = lane_now(); asm volatile("" : "+v"(lane));
    const int gw = F.vcu * NWAVES + F.wave, NGW = F.G * NWAVES;
    for (int m = gw; m < M; m += NGW) {
        const u32x4* xr = (const u32x4*)(xb + (size_t)m * D) + lane;
        f32x4 v[2][2]; float s = 0.f;
#pragma unroll
        for (int j = 0; j < 2; ++j) { const u32x4 w = xr[64 * j]; v[j][0] = (f32x4){bflo(w.x), bfhi(w.x), bflo(w.y), bfhi(w.y)}; v[j][1] = (f32x4){bflo(w.z), bfhi(w.z), bflo(w.w), bfhi(w.w)};
            s += ((v[j][0][0] * v[j][0][0] + v[j][0][1] * v[j][0][1]) + (v[j][0][2] * v[j][0][2] + v[j][0][3] * v[j][0][3])) + ((v[j][1][0] * v[j][1][0] + v[j][1][1] * v[j][1][1]) + (v[j][1][2] * v[j][1][2] + v[j][1][3] * v[j][1][3])); }
        const float rs = 1.0f / sqrtf(wave_sum(s) * (1.0f / D) + 1e-6f);
#pragma unroll
        for (int j = 0; j < 2; ++j) { const f32x4* gq = (const f32x4*)(gain + 8 * lane + 512 * j); f32x4* o = (f32x4*)(out + (size_t)m * D + 8 * lane + 512 * j);
            o[0] = v[j][0] * rs * gq[0]; o[1] = v[j][1] * rs * gq[1]; }
    }
}

constexpr int PH_PER_LAYER = 18;
constexpr int N_PHASES = DEPTH * PH_PER_LAYER + 1;

__global__ void __launch_bounds__(NWAVES * 64, 2) mk_fwd(Args args) {
    extern __shared__ __attribute__((aligned(16))) unsigned char lds[];
    Frame F;
    F.lds = (LAS unsigned char*)lds;
    F.MISC = (volatile LAS unsigned*)(F.lds + MISC_OFF);
    F.wave = __builtin_amdgcn_readfirstlane((int)threadIdx.x >> 6);
    F.G = gridDim.x; { const int bx = blockIdx.x; F.vcu = (F.G % 8 == 0) ? (bx % 8) * (F.G / 8) + bx / 8 : bx; }
    unsigned char* ws = args.ws;
    F.ctl = (gu32*)(ws + WS_CTL);
    for (int u = threadIdx.x; u < (LDS_BYTES - LDSCTL_OFF) / 4; u += NWAVES * 64) ((LAS unsigned*)(F.lds + LDSCTL_OFF))[u] = 0u;
    __syncthreads();
#if MK_PER_PHASE
#define GRID_BAR() do { } while (0)
#else
    XcdBarrier bar = xcd_barrier_post((unsigned*)(F.ctl + CW_BAR), F.MISC + 8, F.wave);
#define GRID_BAR() xcd_barrier(bar)
#endif
    const int lo = args.ph_lo, hi = args.ph_hi;
    int ph = 0;
#define PHASE_BEGIN if (ph >= lo && ph < hi) {
#define PHASE_END   if (ph + 1 < hi) GRID_BAR(); } ++ph;

#define WIN ((bf16*)(ws + WS_WIN))
#define WBR ((bf16*)(ws + WS_WBR))
#define WOUT ((bf16*)(ws + WS_WOUT))
#define WGU ((bf16*)(ws + WS_WGU))
#define WDN ((bf16*)(ws + WS_WDN))
#define XB ((bf16*)(ws + WS_XB))
#define Y ((bf16*)(ws + WS_Y))
#define S ((bf16*)(ws + WS_S))
#define XB2 ((bf16*)(ws + WS_XB2))
#define HID ((bf16*)(ws + WS_HID))
#define RSS ((float*)(ws + WS_RSS))
#define RSTD ((float*)(ws + WS_RSTD))
#define CS ((const float*)(ws + WS_CS))
#define BLUT ((const float*)(ws + WS_BLUT))
#define DILP ((float*)(ws + WS_DILP))
#define DILS ((float*)(ws + WS_DILS))

    for (int l = 0; l < DEPTH; ++l) {
        PHASE_BEGIN if (EN_CONV) phase_convert(F, args, l); PHASE_END

        for (int sub = 0; sub < 6; ++sub) {
            const int coff = (sub == 0) ? C_RET : (sub == 1) ? C_DIFF : (sub <= 4) ? (C_DIL + (sub - 2) * N_DILG) : C_GATE;
            const int nsub = (sub >= 2 && sub <= 4) ? N_DILG : 3072;
            PHASE_BEGIN {
                pg8::Gemm g{XB, WIN + (size_t)coff * D, D, D, M, nsub, D}; pg8::StaticOrder So; So.init(M, nsub, F.G, (int)blockIdx.x);
                pg8::EpiIn E{S, nsub, RSTD, CS, (sub == 0) ? 1 : (sub == 5 ? 2 : ((sub == 1 && DIFF_MFMA) ? 3 : ((sub >= 2 && sub <= 4 && DIL_MFMA) ? 4 : 0)))};
                if (EN_IN) for (int rep = 0; rep < REP_IN; ++rep) pg8::gemm_phase<pg8::EpiIn, pg8::StaticOrder, true>(F.lds + RING_OFF, g, So, E, F.wave);
            } PHASE_END
            if (sub == 0) {
#if RET_MFMA
                PHASE_BEGIN if (EN_RET) ret_state_phase(F, S, (bf16*)(ws + WS_ST)); PHASE_END
                PHASE_BEGIN if (EN_RET) for (int rep = 0; rep < REP_RET; ++rep) ret_phase(F, S, (const bf16*)(ws + WS_ST), args.gn_gain + l * 1024, Y); PHASE_END
#else
                PHASE_BEGIN if (EN_RET) naive_ret(F, S, args.gn_gain + l * 1024, Y); PHASE_END
                PHASE_BEGIN PHASE_END
#endif
            } else if (sub == 1) {
                const float lam_init = __builtin_bit_cast(float, __builtin_amdgcn_readfirstlane(__builtin_bit_cast(int, (l == 0) ? 0.2f : 0.35550906759096934f)));
#if DIFF_MFMA
                PHASE_BEGIN if (EN_DIFF) for (int rep = 0; rep < REP_DIFF; ++rep) diff_attn_phase(F, S, args.diff_lambda + l * 256, lam_init, args.subln + l * 128, BLUT, Y); PHASE_END
#else
                PHASE_BEGIN if (EN_DIFF) naive_diff(F, S, args.diff_lambda + l * 256, lam_init, args.subln + l * 128, BLUT, Y); PHASE_END
#endif
            } else if (sub <= 4) {
#if DIL_MFMA
                PHASE_BEGIN if (EN_DIL) dil_attn_phase(F, S, sub - 2, BLUT, DILS, Y); PHASE_END
#else
                PHASE_BEGIN if (EN_DIL) naive_dil(F, S, sub - 2, BLUT, DILP, DILS, Y); PHASE_END
#endif
            }
        }
        PHASE_BEGIN {
            pg8::Gemm g{Y, WBR, YW, YW, M, D, D}; pg8::SegOrder So; So.init(M, D, F.G, (int)blockIdx.x);
            pg8::EpiMerge E{(bf16*)args.out, S};
            if (EN_MERGE) for (int rep = 0; rep < REP_MERGE; ++rep) pg8::gemm_phase<pg8::EpiMerge, pg8::SegOrder, true>(F.lds + RING_OFF, g, So, E, F.wave);
        } PHASE_END
        PHASE_BEGIN {
            pg8::Gemm g{(const bf16*)args.out, WOUT, D, D, M, D, D}; pg8::StaticOrder So; So.init(M, D, F.G, (int)blockIdx.x);
            pg8::EpiRes E{(l == 0) ? (const void*)args.x : (const void*)XB, XB2, RSS, (l == 0) ? 1 : 0};
            if (EN_OUT) pg8::gemm_phase<pg8::EpiRes, pg8::StaticOrder, true>(F.lds + RING_OFF, g, So, E, F.wave);
        } PHASE_END
        PHASE_BEGIN rstd_reduce(F, RSS, RSTD); PHASE_END
        PHASE_BEGIN {
            pg8::Gemm g{XB2, WGU, D, D, M, 2 * FFN, D}; pg8::StaticOrder So; So.init(M, 2 * FFN, F.G, (int)blockIdx.x);
            pg8::EpiSwiGLU E{HID, RSTD};
            if (EN_UP) for (int rep = 0; rep < REP_UP; ++rep) pg8::gemm_phase<pg8::EpiSwiGLU, pg8::StaticOrder, true>(F.lds + RING_OFF, g, So, E, F.wave);
        } PHASE_END
        PHASE_BEGIN {
            pg8::Gemm g{HID, WDN, FFN, FFN, M, D, FFN}; pg8::StaticOrder So; So.init(M, D, F.G, (int)blockIdx.x);
            pg8::EpiRes E{(const void*)XB2, XB, RSS, 0};
            if (EN_DOWN) pg8::gemm_phase<pg8::EpiRes, pg8::StaticOrder, true>(F.lds + RING_OFF, g, So, E, F.wave);
        } PHASE_END
    }
    PHASE_BEGIN if (EN_FIN) phase_final(F, XB, args.out, args.norm_final); PHASE_END
#undef PHASE_BEGIN
#undef PHASE_END
}

extern "C" void kernel_launch(void* const* d_in, const int* in_sizes, int n_in, void* d_out, int out_size, void* d_ws, size_t ws_size, hipStream_t stream) {
    static int grid = 0;
    if (grid == 0) {
        if (n_in != 16 || in_sizes[0] != M * D || out_size != M * D || ws_size < WS_END) { fprintf(stderr, "kernel_launch: unexpected shapes (n_in %d, ws %zu)\n", n_in, ws_size); grid = -1; return; }
        int dev = 0, cus = 0, per_cu = 0;
        if (hipGetDevice(&dev) != hipSuccess || hipDeviceGetAttribute(&cus, hipDeviceAttributeMultiprocessorCount, dev) != hipSuccess) { grid = -1; return; }
        if (hipFuncSetAttribute((const void*)mk_fwd, hipFuncAttributeMaxDynamicSharedMemorySize, LDS_BYTES) != hipSuccess) { grid = -1; return; }
        if (hipOccupancyMaxActiveBlocksPerMultiprocessor(&per_cu, (const void*)mk_fwd, NWAVES * 64, LDS_BYTES) != hipSuccess || per_cu < 1) { fprintf(stderr, "kernel_launch: occupancy query says %d\n", per_cu); }
        (void)hipGetLastError();
        grid = cus;
    }
    if (grid < 0) return;
    if (hipMemsetAsync((char*)d_ws + WS_CTL, 0, CTL_ZERO_BYTES, stream) != hipSuccess) return;
    Args a{};
    a.x = (const float*)d_in[0]; a.w_in = (const float*)d_in[1]; a.w_br_ret = (const float*)d_in[2]; a.w_br_diff = (const float*)d_in[3]; a.w_br_dil = (const float*)d_in[4];
    a.w_out = (const float*)d_in[5]; a.norm_mix = (const float*)d_in[6]; a.norm_ffn = (const float*)d_in[7]; a.gn_gain = (const float*)d_in[8]; a.diff_lambda = (const float*)d_in[9];
    a.subln = (const float*)d_in[10]; a.rel_bias = (const float*)d_in[11]; a.w_gate = (const float*)d_in[12]; a.w_up = (const float*)d_in[13]; a.w_down = (const float*)d_in[14];
    a.norm_final = (const float*)d_in[15];
    a.out = (float*)d_out; a.ws = (unsigned char*)d_ws;
#if MK_PER_PHASE
    for (int p = 0; p < N_PHASES; ++p) {
        a.ph_lo = p; a.ph_hi = p + 1;
        hipLaunchKernelGGL(mk_fwd, dim3(grid), dim3(NWAVES * 64), LDS_BYTES, stream, a);
    }
#else
    a.ph_lo = 0; a.ph_hi = N_PHASES;
    hipLaunchKernelGGL(mk_fwd, dim3(grid), dim3(NWAVES * 64), LDS_BYTES, stream, a);
#endif
}
```

```cpp
#include <hip/hip_runtime.h>
#include <cstdio>
#include <cstdint>

#ifndef MK_PER_PHASE
#define MK_PER_PHASE 0
#endif


#ifndef DIFF_MFMA
#define DIFF_MFMA 1
#endif
#ifndef DIL_MFMA
#define DIL_MFMA 1
#endif
#ifndef RET_MFMA
#define RET_MFMA 1
#endif
#ifndef REP_IN
#define REP_IN 1
#endif
#ifndef REP_RET
#define REP_RET 1
#endif
#ifndef REP_DIFF
#define REP_DIFF 1
#endif
#ifndef REP_MERGE
#define REP_MERGE 1
#endif
#ifndef REP_UP
#define REP_UP 1
#endif
#ifndef PROBE_DIFF
#define PROBE_DIFF 0
#endif
#ifndef EN_ALL
#define EN_ALL 1
#endif
#ifndef EN_CONV
#define EN_CONV EN_ALL
#endif
#ifndef EN_IN
#define EN_IN EN_ALL
#endif
#ifndef EN_RET
#define EN_RET EN_ALL
#endif
#ifndef EN_DIFF
#define EN_DIFF EN_ALL
#endif
#ifndef EN_DIL
#define EN_DIL EN_ALL
#endif
#ifndef EN_MERGE
#define EN_MERGE EN_ALL
#endif
#ifndef EN_OUT
#define EN_OUT EN_ALL
#endif
#ifndef EN_UP
#define EN_UP EN_ALL
#endif
#ifndef EN_DOWN
#define EN_DOWN EN_ALL
#endif
#ifndef EN_FIN
#define EN_FIN EN_ALL
#endif
#define GAS __attribute__((address_space(1)))
#define LAS __attribute__((address_space(3)))
typedef unsigned short bf16;
typedef unsigned short bf16_t;
typedef short bf16x8 __attribute__((ext_vector_type(8)));
typedef float f32x4 __attribute__((ext_vector_type(4)));
typedef float f32x2 __attribute__((ext_vector_type(2)));
typedef unsigned u32x4 __attribute__((ext_vector_type(4)));
typedef unsigned u32x2 __attribute__((ext_vector_type(2)));

constexpr int BATCH = 16, SEQ = 2048, D = 1024, M = BATCH * SEQ, DEPTH = 2;
constexpr int IN_W = 13824, FFN = 2816;
constexpr int C_RET = 0, C_DIFF = 3072, C_DIL = 6144, C_GATE = 10752;
constexpr int N_RET = 3072, N_DIFF = 3072, N_DILG = 1536, N_GATE = 3072;
constexpr int YW = 2560;
constexpr int NWAVES = 8;

constexpr size_t MiB = 1u << 20;
constexpr size_t WS_CTL = 0, CTL_ZERO_BYTES = 1 * MiB;
constexpr size_t WS_CS = 1 * MiB;
constexpr size_t WS_BLUT = 2 * MiB;
constexpr size_t WS_RSS = 3 * MiB;
constexpr size_t WS_RSTD = 5 * MiB;
constexpr size_t WS_WIN = 8 * MiB;
constexpr size_t WS_WBR = 35 * MiB;
constexpr size_t WS_WOUT = 40 * MiB;
constexpr size_t WS_WGU = 42 * MiB;
constexpr size_t WS_WDN = 53 * MiB;
constexpr size_t WS_XB = 60 * MiB;
constexpr size_t WS_Y = 124 * MiB;
constexpr size_t WS_S = 284 * MiB;
constexpr size_t WS_XB2 = 300 * MiB;
constexpr size_t WS_HID = 124 * MiB;
constexpr size_t WS_DILP = WS_S + 96 * MiB;
constexpr size_t WS_DILS = WS_DILP + 64 * MiB;
constexpr size_t WS_END = 512 * MiB;

constexpr int CW_TMO = 0;
constexpr int CW_BAR = 4096;

constexpr int RING_OFF = 0, RING_BYTES = 131072;
constexpr int LDSCTL_OFF = RING_BYTES, MISC_OFF = LDSCTL_OFF + 320;
constexpr int LDS_BYTES = 147456;

typedef GAS unsigned gu32;
#define RLX_AGENT __ATOMIC_RELAXED, __HIP_MEMORY_SCOPE_AGENT
#define LDS_WAIT() asm volatile("s_waitcnt lgkmcnt(0)" ::: "memory")
#define VM_WAIT() asm volatile("s_waitcnt vmcnt(0)" ::: "memory")

__device__ __forceinline__ unsigned f2bf(float f) { unsigned u = __builtin_bit_cast(unsigned, f); return (u + 0x7fffu + ((u >> 16) & 1u)) >> 16; }
__device__ __forceinline__ unsigned pk2(float lo, float hi) { return f2bf(lo) | (f2bf(hi) << 16); }
__device__ __forceinline__ float bflo(unsigned w) { return __builtin_bit_cast(float, w << 16); }
__device__ __forceinline__ float bfhi(unsigned w) { return __builtin_bit_cast(float, w & 0xffff0000u); }
__device__ __forceinline__ float wave_sum(float v) {
#pragma unroll
    for (int o = 1; o < 64; o <<= 1) v += __shfl_xor(v, o);
    return v;
}
__device__ __forceinline__ float wave_max(float v) {
#pragma unroll
    for (int o = 1; o < 64; o <<= 1) v = fmaxf(v, __shfl_xor(v, o));
    return v;
}
__device__ __forceinline__ float rdlane(float v, int j) { return __builtin_bit_cast(float, __builtin_amdgcn_readlane(__builtin_bit_cast(int, v), j)); }
__device__ __forceinline__ float sigmoidf_(float x) { return __builtin_amdgcn_rcpf(1.0f + __builtin_amdgcn_exp2f(-1.4426950408889634f * x)); }

__device__ __forceinline__ int lane_now() { int x; asm volatile("v_mbcnt_lo_u32_b32 %0, -1, 0\n\tv_mbcnt_hi_u32_b32 %0, -1, %0" : "=v"(x)); return x; }
#define TID_NOW(wave_) ((wave_) * 64 + lane_now())
__device__ const double ROPE_INV[64] = {1.0,0.8659643233600653,0.7498942093324559,0.6493816315762113,0.5623413251903491,0.4869675251658631,0.4216965034285822,0.3651741272548377,0.31622776601683794,0.27384196342643613,0.23713737056616552,0.2053525026457146,0.1778279410038923,0.1539926526059492,0.1333521432163324,0.11547819846894582,0.1,0.08659643233600653,0.07498942093324558,0.06493816315762113,0.05623413251903491,0.04869675251658631,0.042169650342858224,0.03651741272548377,0.03162277660168379,0.027384196342643614,0.023713737056616554,0.02053525026457146,0.01778279410038923,0.01539926526059492,0.01333521432163324,0.011547819846894581,0.01,0.008659643233600654,0.007498942093324558,0.006493816315762113,0.005623413251903491,0.004869675251658631,0.004216965034285823,0.003651741272548377,0.0031622776601683794,0.0027384196342643613,0.0023713737056616554,0.002053525026457146,0.0017782794100389228,0.001539926526059492,0.001333521432163324,0.0011547819846894581,0.001,0.0008659643233600654,0.0007498942093324559,0.0006493816315762113,0.0005623413251903491,0.0004869675251658631,0.00042169650342858224,0.0003651741272548377,0.00031622776601683794,0.0002738419634264361,0.00023713737056616554,0.0002053525026457146,0.00017782794100389227,0.0001539926526059492,0.0001333521432163324,0.00011547819846894582};
__device__ const unsigned char REL_BUCKET[128] = {0,1,2,3,4,5,6,7,8,9,10,11,12,13,14,15,16,16,16,17,17,18,18,18,19,19,19,20,20,20,20,21,21,21,21,22,22,22,22,22,23,23,23,23,23,23,24,24,24,24,24,24,25,25,25,25,25,25,25,26,26,26,26,26,26,26,26,27,27,27,27,27,27,27,27,27,27,28,28,28,28,28,28,28,28,28,28,29,29,29,29,29,29,29,29,29,29,29,29,30,30,30,30,30,30,30,30,30,30,30,30,30,30,31,31,31,31,31,31,31,31,31,31,31,31,31,31,31};

typedef __bf16 bf16x2_t __attribute__((ext_vector_type(2)));
__device__ __forceinline__ unsigned cvtpk(float lo, float hi) { const f32x2 v = {lo, hi}; const bf16x2_t b = __builtin_convertvector(v, bf16x2_t); return __builtin_bit_cast(unsigned, b); }
namespace pg8 {
#define PG8_LAS __attribute__((address_space(3)))
constexpr int BM = 256, BK = 64, HALF = 128, HTB = HALF * BK * 2, STAGE_BYTES = 8 * HTB, NXCD = 8, WGM = 8;
__host__ __device__ __forceinline__ int lds_byte(int r, int c) { const int st = (r >> 4) * 2 + (c >> 5), rr = r & 15, cc = c & 31, ob = rr * 64 + cc * 2; return st * 1024 + (ob ^ (((ob >> 9) & 1) << 5)); }
__host__ __device__ __forceinline__ void stage_rc(int b, int& R, int& C) { const int st = b / 1024, sb = b % 1024, swz = sb ^ (((sb >> 9) & 1) << 5); R = (st >> 1) * 16 + swz / 64; C = (st & 1) * 32 + (swz % 64) / 2; }
__host__ __device__ __forceinline__ int perm32(int rho) { const int n = rho >> 4, i = rho & 15; return 8 * (i >> 2) + 4 * n + (i & 3); }

struct Unit { int pm, pn, seg; };
struct Gemm { const bf16_t* A; const bf16_t* Bt; int lda, ldb, M, N, K; };

struct StaticOrder {
    int nM, nN, nwg, G, c;
    __device__ void init(int M_, int N_, int G_, int c_) { nM = M_ / BM; nN = N_ / BM; nwg = nM * nN; G = G_; c = c_; }
    __device__ __forceinline__ bool tile(int i, Unit& u) const {
        const long L = (long)i * G + c; if (L >= nwg) return false;
        int wgid = (int)L; { const int q = nwg / NXCD, r = nwg % NXCD, xcd = wgid % NXCD, off = wgid / NXCD; wgid = (xcd < r ? xcd * (q + 1) : r * (q + 1) + (xcd - r) * q) + off; }
        const int nig = WGM * nN, gid = wgid / nig, fm = gid * WGM, gsz = (nM - fm) < WGM ? (nM - fm) : WGM;
        u.pm = fm + ((wgid % nig) % gsz); u.pn = (wgid % nig) / gsz; return true;
    }
    __device__ __forceinline__ bool next(int i, Unit& u) const { u.seg = 0; return tile(i, u); }
    __device__ __forceinline__ const char* abase(const Gemm& g, const Unit& u) const { return (const char*)g.A + (size_t)u.pm * BM * g.lda * 2; }
    __device__ __forceinline__ const char* bbase(const Gemm& g, const Unit& u) const { return (const char*)g.Bt + (size_t)u.pn * BM * g.ldb * 2; }
    __device__ __forceinline__ int nt(const Gemm& g, const Unit&) const { return g.K / BK; }
};
struct SegOrder : StaticOrder {
    __device__ __forceinline__ bool next(int i, Unit& u) const { u.seg = i % 3; return tile(i / 3, u); }
    __device__ __forceinline__ const char* abase(const Gemm& g, const Unit& u) const { return (const char*)g.A + (size_t)u.pm * BM * g.lda * 2 + (size_t)u.seg * 2048; }
    __device__ __forceinline__ const char* bbase(const Gemm& g, const Unit& u) const { return (const char*)g.Bt + (size_t)u.pn * BM * g.ldb * 2 + (size_t)u.seg * 2048; }
    __device__ __forceinline__ int nt(const Gemm&, const Unit& u) const { return u.seg < 2 ? 16 : 8; }
};

__device__ __forceinline__ unsigned cvt_pk_bf16(float lo, float hi) { unsigned r; asm volatile("v_cvt_pk_bf16_f32 %0, %1, %2" : "=v"(r) : "v"(lo), "v"(hi)); return r; }

struct EpiIn {
    static constexpr bool PERM = true, AFTER_DRAIN = false;
    bf16_t* O; int ldc; const float* rstd; const float* cs; int mode;
    __device__ __forceinline__ void operator()(const f32x4 (&acc)[2][2][4][2], const Unit& u, int wr, int wc, int fr, int fq) const {
        const int row0 = u.pm * BM + wr * 64 + fr, col0 = u.pn * BM + wc * 32 + 8 * fq;
        const bool rot = (mode == 1) && (u.pn < 4);
        float sc = 1.0f;
        if (rot && u.pn >= 2) sc = 0.08838834764831845f;
        if (mode == 3 && u.pn < 4) sc = 0.18033688011112042f;
        if (mode == 4 && u.pn < 2) sc = 0.12751743082459868f;
        float rs[2][4];
#pragma unroll
        for (int ai = 0; ai < 2; ++ai)
#pragma unroll
            for (int m = 0; m < 4; ++m) rs[ai][m] = rstd[row0 + ai * HALF + m * 16];
        if (rot) {
#pragma unroll
            for (int ai = 0; ai < 2; ++ai) {
                f32x4 c01[4], c23[4];
#pragma unroll
                for (int m = 0; m < 4; ++m) { const f32x4* cp = (const f32x4*)(cs + ((size_t)((row0 + ai * HALF + m * 16) & (SEQ - 1)) * 64 + 16 * wc + 4 * fq) * 2); c01[m] = cp[0]; c23[m] = cp[1]; }
#pragma unroll
                for (int m = 0; m < 4; ++m) {
                    const float r = rs[ai][m] * sc;
                    bf16_t* rowp = O + ((size_t)(col0 >> 7) * M + (row0 + ai * HALF + m * 16)) * 128 + (col0 & 127);
#pragma unroll
                    for (int bj = 0; bj < 2; ++bj) {
                        const f32x4 v0 = acc[ai][bj][m][0] * r, v1 = acc[ai][bj][m][1] * r;
                        u32x4 w;
                        w.x = cvtpk(v0[0] * c01[m][0] - v0[1] * c01[m][1], v0[0] * c01[m][1] + v0[1] * c01[m][0]);
                        w.y = cvtpk(v0[2] * c01[m][2] - v0[3] * c01[m][3], v0[2] * c01[m][3] + v0[3] * c01[m][2]);
                        w.z = cvtpk(v1[0] * c23[m][0] - v1[1] * c23[m][1], v1[0] * c23[m][1] + v1[1] * c23[m][0]);
                        w.w = cvtpk(v1[2] * c23[m][2] - v1[3] * c23[m][3], v1[2] * c23[m][3] + v1[3] * c23[m][2]);
                        *(u32x4*)(rowp + (size_t)bj * M * 128) = w;
                    }
                }
            }
        } else {
#pragma unroll
            for (int ai = 0; ai < 2; ++ai)
#pragma unroll
                for (int m = 0; m < 4; ++m) {
                    const float r = rs[ai][m] * sc;
                    bf16_t* rowp = O + ((size_t)(col0 >> 7) * M + (row0 + ai * HALF + m * 16)) * 128 + (col0 & 127);
#pragma unroll
                    for (int bj = 0; bj < 2; ++bj) {
                        f32x4 v0 = acc[ai][bj][m][0] * r, v1 = acc[ai][bj][m][1] * r;
                        if (mode == 2) {
#pragma unroll
                            for (int j = 0; j < 4; ++j) { v0[j] = sigmoidf_(v0[j]); v1[j] = sigmoidf_(v1[j]); }
                        }
                        u32x4 w; w.x = cvtpk(v0[0], v0[1]); w.y = cvtpk(v0[2], v0[3]); w.z = cvtpk(v1[0], v1[1]); w.w = cvtpk(v1[2], v1[3]);
                        *(u32x4*)(rowp + (size_t)bj * M * 128) = w;
                    }
                }
        }
    }
};
struct EpiMerge {
    static constexpr bool PERM = true, AFTER_DRAIN = false;
    bf16_t* O; const bf16_t* Gt;
    __device__ __forceinline__ void operator()(const f32x4 (&acc)[2][2][4][2], const Unit& u, int wr, int wc, int fr, int fq) const {
        const int row0 = u.pm * BM + wr * 64 + fr, col0 = u.pn * BM + wc * 32 + 8 * fq;
#pragma unroll
        for (int ai = 0; ai < 2; ++ai) {
            u32x4 g[4][2], p[4][2];
#pragma unroll
            for (int m = 0; m < 4; ++m)
#pragma unroll
                for (int bj = 0; bj < 2; ++bj) {
                    const int row = row0 + ai * HALF + m * 16, col = col0 + bj * HALF;
                    g[m][bj] = *(const u32x4*)(Gt + ((size_t)(u.seg * 8 + (col >> 7)) * M + row) * 128 + (col & 127));
                    p[m][bj] = (u.seg > 0) ? *(const u32x4*)(O + (size_t)row * D + col) : (u32x4){0u, 0u, 0u, 0u};
                }
#pragma unroll
            for (int m = 0; m < 4; ++m)
#pragma unroll
                for (int bj = 0; bj < 2; ++bj) {
                    const int row = row0 + ai * HALF + m * 16, col = col0 + bj * HALF;
                    const f32x4 a0 = acc[ai][bj][m][0], a1 = acc[ai][bj][m][1];
                    const u32x4 gg = g[m][bj], pp = p[m][bj];
                    u32x4 w;
                    w.x = cvtpk(a0[0] * bflo(gg.x) + bflo(pp.x), a0[1] * bfhi(gg.x) + bfhi(pp.x));
                    w.y = cvtpk(a0[2] * bflo(gg.y) + bflo(pp.y), a0[3] * bfhi(gg.y) + bfhi(pp.y));
                    w.z = cvtpk(a1[0] * bflo(gg.z) + bflo(pp.z), a1[1] * bfhi(gg.z) + bfhi(pp.z));
                    w.w = cvtpk(a1[2] * bflo(gg.w) + bflo(pp.w), a1[3] * bfhi(gg.w) + bfhi(pp.w));
                    *(u32x4*)(O + (size_t)row * D + col) = w;
                }
        }
    }
};
struct EpiRes {
    static constexpr bool PERM = true, AFTER_DRAIN = false;
    const void* res; bf16_t* xb; float* rss; int res32;
    __device__ __forceinline__ void operator()(const f32x4 (&acc)[2][2][4][2], const Unit& u, int wr, int wc, int fr, int fq) const {
        const int row0 = u.pm * BM + wr * 64 + fr, col0 = u.pn * BM + wc * 32 + 8 * fq;
#pragma unroll
        for (int ai = 0; ai < 2; ++ai) {
            f32x4 r[4][2][2];
            if (res32) {
#pragma unroll
                for (int m = 0; m < 4; ++m)
#pragma unroll
                    for (int bj = 0; bj < 2; ++bj) { const f32x4* p = (const f32x4*)((const float*)res + (size_t)(row0 + ai * HALF + m * 16) * D + col0 + bj * HALF); r[m][bj][0] = p[0]; r[m][bj][1] = p[1]; }
            } else {
                u32x4 q[4][2];
#pragma unroll
                for (int m = 0; m < 4; ++m)
#pragma unroll
                    for (int bj = 0; bj < 2; ++bj) q[m][bj] = *(const u32x4*)((const bf16_t*)res + (size_t)(row0 + ai * HALF + m * 16) * D + col0 + bj * HALF);
#pragma unroll
                for (int m = 0; m < 4; ++m)
#pragma unroll
                    for (int bj = 0; bj < 2; ++bj) { const u32x4 w = q[m][bj]; r[m][bj][0] = (f32x4){bflo(w.x), bfhi(w.x), bflo(w.y), bfhi(w.y)}; r[m][bj][1] = (f32x4){bflo(w.z), bfhi(w.z), bflo(w.w), bfhi(w.w)}; }
            }
#pragma unroll
            for (int m = 0; m < 4; ++m) {
                const int row = row0 + ai * HALF + m * 16; float ss = 0.f;
#pragma unroll
                for (int bj = 0; bj < 2; ++bj) {
                    const f32x4 v0 = acc[ai][bj][m][0] + r[m][bj][0], v1 = acc[ai][bj][m][1] + r[m][bj][1];
                    ss += ((v0[0] * v0[0] + v0[1] * v0[1]) + (v0[2] * v0[2] + v0[3] * v0[3])) + ((v1[0] * v1[0] + v1[1] * v1[1]) + (v1[2] * v1[2] + v1[3] * v1[3]));
                    u32x4 w; w.x = cvtpk(v0[0], v0[1]); w.y = cvtpk(v0[2], v0[3]); w.z = cvtpk(v1[0], v1[1]); w.w = cvtpk(v1[2], v1[3]);
                    *(u32x4*)(xb + (size_t)row * D + col0 + bj * HALF) = w;
                }
                ss += __shfl_xor(ss, 16); ss += __shfl_xor(ss, 32);
                if (fq == 0) rss[(size_t)row * 16 + u.pn * 4 + wc] = ss;
            }
        }
    }
};
struct EpiSwiGLU {
    static constexpr bool PERM = true, AFTER_DRAIN = false;
    bf16_t* H; const float* rstd;
    __device__ __forceinline__ void operator()(const f32x4 (&acc)[2][2][4][2], const Unit& u, int wr, int wc, int fr, int fq) const {
        const int row0 = u.pm * BM + wr * 64 + fr, col0 = u.pn * HALF + wc * 32 + 8 * fq;
        float rsv[2][4];
#pragma unroll
        for (int ai = 0; ai < 2; ++ai)
#pragma unroll
            for (int m = 0; m < 4; ++m) rsv[ai][m] = rstd[row0 + ai * HALF + m * 16];
#pragma unroll
        for (int ai = 0; ai < 2; ++ai)
#pragma unroll
            for (int m = 0; m < 4; ++m) {
                const int row = row0 + ai * HALF + m * 16;
                const float rs = rsv[ai][m];
                f32x4 h0, h1;
#pragma unroll
                for (int j = 0; j < 4; ++j) {
                    const float g0 = acc[ai][0][m][0][j] * rs, g1 = acc[ai][0][m][1][j] * rs;
                    h0[j] = g0 * sigmoidf_(g0) * (acc[ai][1][m][0][j] * rs);
                    h1[j] = g1 * sigmoidf_(g1) * (acc[ai][1][m][1][j] * rs);
                }
                u32x4 w; w.x = cvtpk(h0[0], h0[1]); w.y = cvtpk(h0[2], h0[3]); w.z = cvtpk(h1[0], h1[1]); w.w = cvtpk(h1[2], h1[3]);
                *(u32x4*)(H + (size_t)row * FFN + col0) = w;
            }
    }
};

template <class Epi, class Sched, bool ALIGN_EPI>
__device__ __forceinline__ void gemm_phase(PG8_LAS unsigned char* lds, const Gemm g, const Sched& S, const Epi& E, const int wv) {
    int tid_ = TID_NOW(wv); asm volatile("" : "+v"(tid_));
    const int tid = tid_, wid = __builtin_amdgcn_readfirstlane(tid >> 6), lane = tid & 63, wr = wid >> 2, wc = wid & 3, fr = lane & 15, fq = lane >> 4;
    unsigned voffA[2], voffB[2];
#pragma unroll
    for (int i = 0; i < 2; ++i) { int R, C; stage_rc(tid * 16 + i * 8192, R, C); const int Rb = Epi::PERM ? ((R & ~31) + perm32(R & 31)) : R;
        voffA[i] = (unsigned)(R * g.lda + C) * 2u; voffB[i] = (unsigned)(Rb * g.ldb + C) * 2u; }
    const size_t kstep = (size_t)(BK * 2);
    const size_t hstepA = (size_t)HALF * g.lda * 2, hstepB = (size_t)HALF * g.ldb * 2;
    const unsigned ldsw = (unsigned)wid * 1024u;
    const int aoff = lds_byte(wr * 64 + fr, fq * 8), boff = lds_byte(wc * 32 + fr, fq * 8);
#define PG8_SA(b, h) (((b) * 2 + (h)) * HTB)
#define PG8_SB(b, h) ((4 + (b) * 2 + (h)) * HTB)
#define PG8_STAGE(bufoff, gbase, voff) do { _Pragma("unroll") for (int _i = 0; _i < 2; ++_i) \
        __builtin_amdgcn_global_load_lds((const unsigned*)((const char*)(gbase) + (voff)[_i]), (PG8_LAS unsigned*)(lds + (bufoff) + ldsw + _i * 8192), 16, 0, 0); } while (0)
#define PG8_LDA(dst, b, h) do { _Pragma("unroll") for (int m = 0; m < 4; ++m) _Pragma("unroll") for (int k = 0; k < 2; ++k) dst[m][k] = *(const PG8_LAS bf16x8*)(lds + PG8_SA(b, h) + aoff + m * 2048 + k * 1024); } while (0)
#define PG8_LDB(dst, b, h) do { _Pragma("unroll") for (int n = 0; n < 2; ++n) _Pragma("unroll") for (int k = 0; k < 2; ++k) dst[n][k] = *(const PG8_LAS bf16x8*)(lds + PG8_SB(b, h) + boff + n * 2048 + k * 1024); } while (0)
#define PG8_MMA(ai, bj, At, Bt) do { __builtin_amdgcn_s_setprio(1); _Pragma("unroll") for (int m = 0; m < 4; ++m) _Pragma("unroll") for (int n = 0; n < 2; ++n) _Pragma("unroll") for (int k = 0; k < 2; ++k) \
        acc[ai][bj][m][n] = __builtin_amdgcn_mfma_f32_16x16x32_bf16(Bt[n][k], At[m][k], acc[ai][bj][m][n], 0, 0, 0); __builtin_amdgcn_s_setprio(0); } while (0)
#define PG8_WAIT_V(n) asm volatile("s_waitcnt vmcnt(" #n ")" ::: "memory")
#define PG8_WAIT_L(n) asm volatile("s_waitcnt lgkmcnt(" #n ")" ::: "memory")
#define PG8_BAR __builtin_amdgcn_s_barrier()
#define PG8_SCHED __builtin_amdgcn_sched_barrier(0)
    Unit cur, nxt; int ui = 0;
    if (!S.next(0, cur)) return;
    f32x4 acc[2][2][4][2];
#pragma unroll
    for (int a = 0; a < 2; ++a)
#pragma unroll
        for (int b = 0; b < 2; ++b)
#pragma unroll
            for (int m = 0; m < 4; ++m)
#pragma unroll
                for (int n = 0; n < 2; ++n) acc[a][b][m][n] = (f32x4){0.f, 0.f, 0.f, 0.f};
    bf16x8 At[4][2], B0[2][2], B1[2][2];
    const char* cA = S.abase(g, cur); const char* cB = S.bbase(g, cur);
    PG8_STAGE(PG8_SB(0, 0), cB, voffB); PG8_STAGE(PG8_SB(0, 1), cB + hstepB, voffB); PG8_STAGE(PG8_SA(0, 0), cA, voffA); PG8_STAGE(PG8_SA(0, 1), cA + hstepA, voffA);
    if (wr == 1) PG8_BAR;
    PG8_WAIT_V(2); PG8_BAR;
    PG8_STAGE(PG8_SB(1, 0), cB + kstep, voffB); PG8_STAGE(PG8_SA(1, 0), cA + kstep, voffA); PG8_STAGE(PG8_SB(1, 1), cB + hstepB + kstep, voffB);
    PG8_WAIT_V(6); PG8_BAR;
    for (;;) {
        const bool has_next = S.next(ui + 1, nxt);
        const int nt = S.nt(g, cur);
        const char* nA = has_next ? S.abase(g, nxt) : cA; const char* nB = has_next ? S.bbase(g, nxt) : cB;
        for (int t = 0; t < nt; t += 2) {
            const bool last = (t == nt - 2);
            const char* a1 = cA + (size_t)(t + 1) * kstep;
            const char* a2 = last ? nA : cA + (size_t)(t + 2) * kstep; const char* b2 = last ? nB : cB + (size_t)(t + 2) * kstep;
            const char* a3 = a2 + kstep; const char* b3 = b2 + kstep;
            PG8_LDB(B0, 0, 0); PG8_LDB(B1, 0, 1); PG8_SCHED; PG8_LDA(At, 0, 0); PG8_STAGE(PG8_SA(1, 1), a1 + hstepA, voffA);
            PG8_WAIT_V(8); PG8_WAIT_L(0); PG8_BAR; PG8_MMA(0, 0, At, B0); PG8_MMA(0, 1, At, B1); PG8_BAR; PG8_SCHED;
            PG8_LDA(At, 0, 1); PG8_STAGE(PG8_SB(0, 0), b2, voffB); PG8_STAGE(PG8_SB(0, 1), b2 + hstepB, voffB); PG8_STAGE(PG8_SA(0, 0), a2, voffA);
            PG8_WAIT_V(8); PG8_WAIT_L(0); PG8_BAR; PG8_MMA(1, 0, At, B0); PG8_MMA(1, 1, At, B1); PG8_BAR; PG8_SCHED;
            PG8_LDB(B0, 1, 0); PG8_LDB(B1, 1, 1); PG8_SCHED; PG8_LDA(At, 1, 0); PG8_STAGE(PG8_SA(0, 1), a2 + hstepA, voffA);
            PG8_WAIT_V(8); PG8_WAIT_L(0); PG8_BAR; PG8_MMA(0, 0, At, B0); PG8_MMA(0, 1, At, B1); PG8_BAR; PG8_SCHED;
            PG8_LDA(At, 1, 1); PG8_STAGE(PG8_SB(1, 0), b3, voffB); PG8_STAGE(PG8_SB(1, 1), b3 + hstepB, voffB); PG8_STAGE(PG8_SA(1, 0), a3, voffA);
            PG8_WAIT_V(8); PG8_WAIT_L(0); PG8_BAR; PG8_MMA(1, 0, At, B0); PG8_MMA(1, 1, At, B1); PG8_BAR; PG8_SCHED;
        }
        if constexpr (ALIGN_EPI) { if (wr == 0) PG8_BAR; }
        E(acc, cur, wr, wc, fr, fq);
        if (!has_next) break;
#pragma unroll
        for (int a = 0; a < 2; ++a)
#pragma unroll
            for (int b = 0; b < 2; ++b)
#pragma unroll
                for (int m = 0; m < 4; ++m)
#pragma unroll
                    for (int n = 0; n < 2; ++n) acc[a][b][m][n] = (f32x4){0.f, 0.f, 0.f, 0.f};
        cur = nxt; cA = nA; cB = nB; ++ui;
        if constexpr (ALIGN_EPI) { if (wr == 1) PG8_BAR; }
    }
    PG8_WAIT_V(0);
    if constexpr (!ALIGN_EPI) { if (wr == 0) PG8_BAR; }
    PG8_BAR;
#undef PG8_SA
#undef PG8_SB
#undef PG8_STAGE
#undef PG8_LDA
#undef PG8_LDB
#undef PG8_MMA
#undef PG8_WAIT_V
#undef PG8_WAIT_L
#undef PG8_BAR
#undef PG8_SCHED
}
}

#define XB_TMO      128
#define XB_XCNT(j)  (256  + 64 * (j))
#define XB_XSUB(j)  (1280 + 64 * (j))
#define XB_XGEN(j)  (2304 + 64 * (j))
#define XB_TOP      3328
#define XB_TOPGEN   3392
#define XCD_BAR_WORDS 3456
#define XB_SPIN_CAP (1u << 18)

__device__ __forceinline__ unsigned xb_ld(unsigned* p)              { return __hip_atomic_load(p, __ATOMIC_RELAXED, __HIP_MEMORY_SCOPE_AGENT); }
__device__ __forceinline__ unsigned xb_add(unsigned* p, unsigned v) { return __hip_atomic_fetch_add(p, v, __ATOMIC_RELAXED, __HIP_MEMORY_SCOPE_AGENT); }
__device__ __forceinline__ unsigned xb_xcc_id() { return (unsigned)__builtin_amdgcn_s_getreg((3 << 11) | 20) & 0xFu; }
#define XB_SPIN(cond, bar) do { unsigned _sp = 0; while (cond) { __builtin_amdgcn_s_sleep(1); \
    if ((++_sp & 255u) == 0u) { if (xb_ld(&(bar)[XB_TMO])) break; if (_sp > XB_SPIN_CAP) { atomicAdd(&(bar)[XB_TMO], 1u); break; } } } } while (0)

struct XcdBarrier { unsigned* bar; unsigned x; volatile LAS unsigned* st; int wave; };

__device__ __forceinline__ XcdBarrier xcd_barrier_post(unsigned* bar, volatile LAS unsigned* st, int wave) {
    XcdBarrier b; b.bar = bar; b.x = xb_xcc_id(); b.st = st; b.wave = wave;
    if (TID_NOW(wave) == 0) (void)xb_add(&bar[XB_XCNT(b.x)], 1u);
    return b;
}
__device__ __forceinline__ void xcd_barrier_complete(unsigned* bar, unsigned x, unsigned& nloc, unsigned& nx) {
    const unsigned G = gridDim.x * gridDim.y * gridDim.z;
    unsigned sum, cnt, mine, sp = 0u;
    for (;;) {
        sum = 0u; cnt = 0u; mine = 0u;
#pragma unroll
        for (unsigned j = 0; j < 16; ++j) { const unsigned c = xb_ld(&bar[XB_XCNT(j)]); sum += c; cnt += (c > 0u) ? 1u : 0u; mine = (j == x) ? c : mine; }
        if (sum == G) break;
        __builtin_amdgcn_s_sleep(1);
        if ((++sp & 255u) == 0u) { if (xb_ld(&bar[XB_TMO])) break; if (sp > XB_SPIN_CAP) { atomicAdd(&bar[XB_TMO], 1u); break; } }
    }
    nloc = mine > 0u ? mine : 1u; nx = cnt > 0u ? cnt : 1u;
}
__device__ __forceinline__ void xcd_barrier(const XcdBarrier& b) {
    asm volatile("s_waitcnt vmcnt(0)" ::: "memory");
    __syncthreads();
    if (TID_NOW(b.wave) == 0) {
        unsigned* bar = b.bar;
        __builtin_amdgcn_s_waitcnt(0);
        unsigned nloc = b.st[0], nx = b.st[1];
        if (nloc == 0u) { xcd_barrier_complete(bar, b.x, nloc, nx); b.st[0] = nloc; b.st[1] = nx; }
        const unsigned old = xb_add(&bar[XB_XSUB(b.x)], 1u);
        const unsigned gen = old / nloc;
        if (old + 1u == (gen + 1u) * nloc) {
            __builtin_amdgcn_fence(__ATOMIC_RELEASE, "agent");
            asm volatile("s_waitcnt vmcnt(0)" ::: "memory");
            const unsigned og = xb_add(&bar[XB_TOP], 1u);
            const unsigned tg = og / nx;
            if (og + 1u == (tg + 1u) * nx) xb_add(&bar[XB_TOPGEN], 1u);
            else XB_SPIN(xb_ld(&bar[XB_TOPGEN]) == tg, bar);
            __builtin_amdgcn_fence(__ATOMIC_ACQUIRE, "agent");
            xb_add(&bar[XB_XGEN(b.x)], 1u);
            asm volatile("s_waitcnt vmcnt(0)" ::: "memory");
        } else {
            XB_SPIN(xb_ld(&bar[XB_XGEN(b.x)]) == gen, bar);
            __builtin_amdgcn_fence(__ATOMIC_ACQUIRE, "agent");
            asm volatile("s_waitcnt vmcnt(0)" ::: "memory");
        }
    }
    __syncthreads();
}

struct Frame {
    LAS unsigned char* lds;
    volatile LAS unsigned* MISC;
    gu32* ctl;
    int wave;
    int vcu, G;
};

__device__ __forceinline__ int dst_row(int map, int n) {
    if (map == 1) { if (n < 1024) { const int d = n & 127; return (n & ~127) + 2 * (d & 63) + (d >> 6); } return n; }
    if (map == 2) return (n >> 7) * 256 + (n & 127);
    if (map == 3) return (n >> 7) * 256 + 128 + (n & 127);
    return n;
}
__device__ __forceinline__ void tr_item(const float* W, int N, bf16* WT, int ldw, int koff, int map, const float* gain, LAS float* scr, int item, int lane) {
    const int nblk = N / 32, kb = item / nblk, nb = item % nblk, k0 = 64 * kb, n0 = 32 * nb;
    float wv[32];
#pragma unroll
    for (int i = 0; i < 32; ++i) wv[i] = W[(size_t)(k0 + 2 * i + (lane >> 5)) * N + n0 + (lane & 31)];
    if (gain) {
#pragma unroll
        for (int i = 0; i < 32; ++i) wv[i] *= gain[k0 + 2 * i + (lane >> 5)];
    }
#pragma unroll
    for (int i = 0; i < 32; ++i) scr[(2 * i + (lane >> 5)) * 33 + (lane & 31)] = wv[i];
    LDS_WAIT(); asm volatile("" ::: "memory");
    const int c = lane & 7;
#pragma unroll
    for (int j = 0; j < 4; ++j) { const int n = (lane >> 3) + 8 * j; const LAS float* s = scr + (8 * c) * 33 + n;
        u32x4 o; o.x = pk2(s[0 * 33], s[1 * 33]); o.y = pk2(s[2 * 33], s[3 * 33]); o.z = pk2(s[4 * 33], s[5 * 33]); o.w = pk2(s[6 * 33], s[7 * 33]);
        *(u32x4*)(WT + (size_t)dst_row(map, n0 + n) * ldw + koff + k0 + 8 * c) = o; }
    LDS_WAIT(); asm volatile("" ::: "memory");
}

struct Args {
    const float* x; const float* w_in; const float* w_br_ret; const float* w_br_diff; const float* w_br_dil; const float* w_out;
    const float* norm_mix; const float* norm_ffn; const float* gn_gain; const float* diff_lambda; const float* subln; const float* rel_bias;
    const float* w_gate; const float* w_up; const float* w_down; const float* norm_final;
    float* out; unsigned char* ws; int ph_lo, ph_hi;
};

__device__ __forceinline__ void rstd_reduce(Frame& F, const float* rss, float* rstd) {
    int tid = TID_NOW(F.wave); asm volatile("" : "+v"(tid));
    for (int row = F.vcu * NWAVES * 64 + tid; row < M; row += F.G * NWAVES * 64) {
        const f32x4* rp = (const f32x4*)(rss + (size_t)row * 16);
        const f32x4 a = rp[0], b = rp[1], c = rp[2], d = rp[3];
        const float ss = (((a[0] + a[1]) + (a[2] + a[3])) + ((b[0] + b[1]) + (b[2] + b[3]))) + (((c[0] + c[1]) + (c[2] + c[3])) + ((d[0] + d[1]) + (d[2] + d[3])));
        rstd[row] = 1.0f / sqrtf(ss * (1.0f / 1024.0f) + 1e-6f);
    }
}
__device__ __forceinline__ void phase_convert(Frame& F, const Args& a, int l) {
    int tid = TID_NOW(F.wave); asm volatile("" : "+v"(tid));
    const int lane = tid & 63;
    LAS float* scr = (LAS float*)(F.lds + RING_OFF + F.wave * 16384);
    const int gw = F.vcu * NWAVES + F.wave, NGW = F.G * NWAVES;
    unsigned char* ws = a.ws;
    constexpr int I_IN = 16 * (IN_W / 32), I_BR = 16 * 32, I_BL = 8 * 32, I_O = 16 * 32, I_G = 16 * (FFN / 32), I_D = (FFN / 64) * 32;
    constexpr int NITEMS = I_IN + 2 * I_BR + I_BL + I_O + 2 * I_G + I_D;
    for (int it = gw; it < NITEMS; it += NGW) {
        int r = it; const float* W; int N; bf16* WT; int ldw, koff = 0, map = 0; const float* gain = nullptr;
        if (r < I_IN) { W = a.w_in + (size_t)l * D * IN_W; N = IN_W; WT = (bf16*)(ws + WS_WIN); ldw = D; map = 1; gain = a.norm_mix + l * D; }
        else if ((r -= I_IN) < I_BR) { W = a.w_br_ret + (size_t)l * 1024 * D; N = D; WT = (bf16*)(ws + WS_WBR); ldw = YW; }
        else if ((r -= I_BR) < I_BR) { W = a.w_br_diff + (size_t)l * 1024 * D; N = D; WT = (bf16*)(ws + WS_WBR); ldw = YW; koff = 1024; }
        else if ((r -= I_BR) < I_BL) { W = a.w_br_dil + (size_t)l * 512 * D; N = D; WT = (bf16*)(ws + WS_WBR); ldw = YW; koff = 2048; }
        else if ((r -= I_BL) < I_O) { W = a.w_out + (size_t)l * D * D; N = D; WT = (bf16*)(ws + WS_WOUT); ldw = D; }
        else if ((r -= I_O) < I_G) { W = a.w_gate + (size_t)l * D * FFN; N = FFN; WT = (bf16*)(ws + WS_WGU); ldw = D; map = 2; gain = a.norm_ffn + l * D; }
        else if ((r -= I_G) < I_G) { W = a.w_up + (size_t)l * D * FFN; N = FFN; WT = (bf16*)(ws + WS_WGU); ldw = D; map = 3; gain = a.norm_ffn + l * D; }
        else { r -= I_G; W = a.w_down + (size_t)l * FFN * D; N = D; WT = (bf16*)(ws + WS_WDN); ldw = FFN; }
        tr_item(W, N, WT, ldw, koff, map, gain, scr, r, lane);
    }
    if (l > 0) rstd_reduce(F, (const float*)(ws + WS_RSS), (float*)(ws + WS_RSTD));
    if (l == 0) {
        bf16* XB = (bf16*)(ws + WS_XB); float* rss = (float*)(ws + WS_RSS);
        for (int m = gw; m < M; m += NGW) {
            const f32x4* xr = (const f32x4*)(a.x + (size_t)m * D) + lane;
            u32x2* o8 = (u32x2*)(XB + (size_t)m * D) + lane;
            float s = 0.f;
#pragma unroll
            for (int j = 0; j < 4; ++j) { const f32x4 v = xr[64 * j]; s += (v[0] * v[0] + v[1] * v[1]) + (v[2] * v[2] + v[3] * v[3]); u32x2 w; w.x = pk2(v[0], v[1]); w.y = pk2(v[2], v[3]); o8[64 * j] = w; }
            s = wave_sum(s);
            if (lane == 0) ((float*)(ws + WS_RSTD))[m] = 1.0f / sqrtf(s * (1.0f / 1024.0f) + 1e-6f);
        }
        float* cs = (float*)(ws + WS_CS);
        const int gt = F.vcu * NWAVES * 64 + tid, NT = F.G * NWAVES * 64;
        for (int idx = gt; idx < SEQ * 64; idx += NT) {
            const int pos = idx >> 6, i = idx & 63;
            const double t = (double)pos * ROPE_INV[i] * 0.15915494309189535;
            const double fr = t - floor(t);
            const float f = (float)fr;
            cs[2 * idx] = __builtin_amdgcn_cosf(f); cs[2 * idx + 1] = __builtin_amdgcn_sinf(f);
        }
        float* blut = (float*)(ws + WS_BLUT);
        for (int idx = gt; idx < 20 * 128; idx += NT) { const int h = idx >> 7, dist = idx & 127; blut[idx] = a.rel_bias[REL_BUCKET[dist] * 20 + h]; }
    }
}

__device__ __forceinline__ float dot8(const u32x4 a, const u32x4 b, float acc) {
    acc += bflo(a.x) * bflo(b.x); acc += bfhi(a.x) * bfhi(b.x); acc += bflo(a.y) * bflo(b.y); acc += bfhi(a.y) * bfhi(b.y);
    acc += bflo(a.z) * bflo(b.z); acc += bfhi(a.z) * bfhi(b.z); acc += bflo(a.w) * bflo(b.w); acc += bfhi(a.w) * bfhi(b.w);
    return acc;
}

__device__ __forceinline__ void naive_ret(Frame& F, const bf16* R, const float* gn_gain, bf16* Y) {
    LAS unsigned* qs = (LAS unsigned*)(F.lds + RING_OFF + F.wave * 1024);
    int lane_ = lane_now(); asm volatile("" : "+v"(lane_));
    const int gw = F.vcu * NWAVES + F.wave, NGW = F.G * NWAVES, lane = lane_;
    for (int it = gw; it < M * 4; it += NGW) {
        const int bh = it & 63, t = it >> 6, b = bh >> 2, h = bh & 3;
        const size_t row = (size_t)b * SEQ + t;
        LDS_WAIT();
        qs[lane] = *(const unsigned*)(R + row * N_RET + h * 128 + 2 * lane);
        LDS_WAIT(); asm volatile("" ::: "memory");
        const float l2g = log2f(1.0f - exp2f(-5.0f - (float)h));
        float y0 = 0.f, y1 = 0.f, y2 = 0.f, y3 = 0.f;
        for (int s0 = 0; s0 <= t; s0 += 64) {
            const int s = s0 + lane; const bool valid = s <= t; const int sc = valid ? s : t;
            const u32x4* kr = (const u32x4*)(R + ((size_t)b * SEQ + sc) * N_RET + 512 + h * 128);
            float dot = 0.f;
#pragma unroll
            for (int d8 = 0; d8 < 16; ++d8) { const u32x4 q8 = *(const LAS u32x4*)(qs + d8 * 4); dot = dot8(q8, kr[d8], dot); }
            const float w = valid ? dot * exp2f((float)(t - s) * l2g) : 0.f;
            const int ns = (t - s0 + 1) < 64 ? (t - s0 + 1) : 64;
            const bf16* vb = R + ((size_t)b * SEQ + s0) * N_RET + 1024 + h * 256 + 4 * lane;
            for (int j = 0; j < ns; ++j) {
                const float wj = rdlane(w, j);
                const u32x2 v = *(const u32x2*)(vb + (size_t)j * N_RET);
                y0 += wj * bflo(v.x); y1 += wj * bfhi(v.x); y2 += wj * bflo(v.y); y3 += wj * bfhi(v.y);
            }
        }
        const float mean = wave_sum((y0 + y1) + (y2 + y3)) * (1.0f / 256.0f);
        const float d0 = y0 - mean, d1 = y1 - mean, d2 = y2 - mean, d3 = y3 - mean;
        const float var = wave_sum((d0 * d0 + d1 * d1) + (d2 * d2 + d3 * d3)) * (1.0f / 256.0f);
        const float rstd = 1.0f / sqrtf(var + 1e-5f);
        const f32x4 gg = *(const f32x4*)(gn_gain + h * 256 + 4 * lane);
        const u32x2 gv = *(const u32x2*)(R + row * N_RET + 2048 + h * 256 + 4 * lane);
        const float g0 = bflo(gv.x), g1 = bfhi(gv.x), g2 = bflo(gv.y), g3 = bfhi(gv.y);
        const float o0 = d0 * rstd * gg[0] * (g0 * sigmoidf_(g0)), o1 = d1 * rstd * gg[1] * (g1 * sigmoidf_(g1));
        const float o2 = d2 * rstd * gg[2] * (g2 * sigmoidf_(g2)), o3 = d3 * rstd * gg[3] * (g3 * sigmoidf_(g3));
        u32x2 w; w.x = pk2(o0, o1); w.y = pk2(o2, o3);
        *(u32x2*)(Y + row * YW + h * 256 + 4 * lane) = w;
    }
}

__device__ __forceinline__ void naive_diff(Frame& F, const bf16* Sd, const float* lamp, float lam_init, const float* subln, const float* blut, bf16* Y) {
    LAS unsigned* qs = (LAS unsigned*)(F.lds + RING_OFF + F.wave * 1024);
    int lane_ = lane_now(); asm volatile("" : "+v"(lane_));
    const int gw = F.vcu * NWAVES + F.wave, NGW = F.G * NWAVES, lane = lane_;
    const float lam = __expf(wave_sum(lamp[lane] * lamp[64 + lane])) - __expf(wave_sum(lamp[128 + lane] * lamp[192 + lane])) + lam_init;
    for (int it = gw; it < M * 8; it += NGW) {
        const int bh = it & 127, t = it >> 7, b = bh >> 3, h = bh & 7;
        const size_t row = (size_t)b * SEQ + t;
        LDS_WAIT();
        qs[lane] = *(const unsigned*)(Sd + row * N_DIFF + h * 128 + 2 * lane);
        LDS_WAIT(); asm volatile("" ::: "memory");
        float om0[2], om1[2];
#pragma unroll
        for (int mm = 0; mm < 2; ++mm) {
            float mrun = -3.0e38f, l = 0.f, o0 = 0.f, o1 = 0.f;
            for (int s0 = 0; s0 <= t; s0 += 64) {
                const int s = s0 + lane; const bool valid = s <= t; const int sc = valid ? s : t;
                const u32x4* kr = (const u32x4*)(Sd + ((size_t)b * SEQ + sc) * N_DIFF + 1024 + h * 128 + mm * 64);
                float dot = 0.f;
#pragma unroll
                for (int d8 = 0; d8 < 8; ++d8) { const u32x4 q8 = *(const LAS u32x4*)(qs + mm * 32 + d8 * 4); dot = dot8(q8, kr[d8], dot); }
                const int dist = (t - sc) < 127 ? (t - sc) : 127;
                const float scv = valid ? dot * 0.125f + blut[h * 128 + dist] : -3.0e38f;
                const float mnew = fmaxf(mrun, wave_max(scv));
                const float alpha = __expf(mrun - mnew);
                const float p = valid ? __expf(scv - mnew) : 0.f;
                l = l * alpha + wave_sum(p); o0 *= alpha; o1 *= alpha; mrun = mnew;
                const int ns = (t - s0 + 1) < 64 ? (t - s0 + 1) : 64;
                const bf16* vb = Sd + ((size_t)b * SEQ + s0) * N_DIFF + 2048 + h * 128 + 2 * lane;
                for (int j = 0; j < ns; ++j) {
                    const float pj = rdlane(p, j);
                    const unsigned v = *(const unsigned*)(vb + (size_t)j * N_DIFF);
                    o0 += pj * bflo(v); o1 += pj * bfhi(v);
                }
            }
            om0[mm] = o0 / l; om1[mm] = o1 / l;
        }
        const float a0 = om0[0] - lam * om0[1], a1 = om1[0] - lam * om1[1];
        const float ms = wave_sum(a0 * a0 + a1 * a1) * (1.0f / 128.0f);
        const float rs = (1.0f / sqrtf(ms + 1e-5f)) * (1.0f - lam_init);
        *(unsigned*)(Y + row * YW + 1024 + h * 128 + 2 * lane) = pk2(a0 * rs * subln[2 * lane], a1 * rs * subln[2 * lane + 1]);
    }
}

__device__ __forceinline__ void naive_dil(Frame& F, const bf16* Sl, int g, const float* blut, float* Pn, float* Ps, bf16* Y) {
    LAS unsigned* qs = (LAS unsigned*)(F.lds + RING_OFF + F.wave * 1024);
    int lane_ = lane_now(); asm volatile("" : "+v"(lane_));
    const int gw = F.vcu * NWAVES + F.wave, NGW = F.G * NWAVES, lane = lane_;
    const int dl = (g == 0) ? 1 : (g == 1 ? 4 : 16);
    for (int it = gw; it < M * 4; it += NGW) {
        const int bh = it & 63, t = it >> 6, b = bh >> 2, h = bh & 3;
        const size_t row = (size_t)b * SEQ + t;
        LDS_WAIT();
        qs[lane] = *(const unsigned*)(Sl + row * N_DILG + h * 128 + 2 * lane);
        LDS_WAIT(); asm volatile("" ::: "memory");
        float sc[3];
#pragma unroll
        for (int tl = 0; tl < 3; ++tl) {
            const int mi = tl * 64 + lane; const int kp = t - mi * dl; const bool valid = (mi <= 128) && (kp >= 0);
            const u32x4* kr = (const u32x4*)(Sl + ((size_t)b * SEQ + (valid ? kp : t)) * N_DILG + 512 + h * 128);
            float dot = 0.f;
#pragma unroll
            for (int d8 = 0; d8 < 16; ++d8) { const u32x4 q8 = *(const LAS u32x4*)(qs + d8 * 4); dot = dot8(q8, kr[d8], dot); }
            const int dist = (mi * dl) < 127 ? (mi * dl) : 127;
            sc[tl] = valid ? dot * 0.08838834764831845f + blut[(8 + g * 4 + h) * 128 + dist] : -3.0e38f;
        }
        float mx = wave_max(fmaxf(fmaxf(sc[0], sc[1]), sc[2]));
        float p[3], den = 0.f;
#pragma unroll
        for (int tl = 0; tl < 3; ++tl) { p[tl] = (sc[tl] > -1.0e38f) ? __expf(sc[tl] - mx) : 0.f; den += p[tl]; }
        den = wave_sum(den);
        float n0 = 0.f, n1 = 0.f;
#pragma unroll
        for (int tl = 0; tl < 3; ++tl) {
            for (int j = 0; j < 64; ++j) {
                const int mi = tl * 64 + j; const int kp = t - mi * dl;
                if (mi > 128 || kp < 0) break;
                const float pj = rdlane(p[tl], j);
                const unsigned v = *(const unsigned*)(Sl + ((size_t)b * SEQ + kp) * N_DILG + 1024 + h * 128 + 2 * lane);
                n0 += pj * bflo(v); n1 += pj * bfhi(v);
            }
        }
        float* pn = Pn + (row * 4 + h) * 128 + 2 * lane; float* ps = Ps + (row * 4 + h) * 2;
        if (g > 0) {
            const f32x2 q = *(const f32x2*)pn; const float pm = ps[0], pd = ps[1];
            const float mnew = fmaxf(mx, pm), ea = __expf(mx - mnew), eb = __expf(pm - mnew);
            n0 = ea * n0 + eb * q[0]; n1 = ea * n1 + eb * q[1]; den = ea * den + eb * pd; mx = mnew;
        }
        if (g < 2) { *(f32x2*)pn = (f32x2){n0, n1}; if (lane == 0) { ps[0] = mx; ps[1] = den; } }
        else { const float inv = 1.0f / den; *(unsigned*)(Y + row * YW + 2048 + h * 128 + 2 * lane) = pk2(n0 * inv, n1 * inv); }
    }
}


typedef short v4i16 __attribute__((ext_vector_type(4)));
__device__ __forceinline__ float fexp2(float x) { return __builtin_amdgcn_exp2f(x); }
__device__ __forceinline__ float hmax4(const f32x4 a) { return fmaxf(fmaxf(a[0], a[1]), fmaxf(a[2], a[3])); }
__device__ __forceinline__ bf16x8 pack_p(const f32x4 a, const f32x4 b) { u32x4 w; w.x = cvtpk(a[0], a[1]); w.y = cvtpk(a[2], a[3]); w.z = cvtpk(b[0], b[1]); w.w = cvtpk(b[2], b[3]); return __builtin_bit_cast(bf16x8, w); }
constexpr int AT_PITCH = 288, AT_TILE = 64 * AT_PITCH, AT_BUF = 2 * AT_TILE, AT_LUT = 2 * AT_BUF, AT_XP = 132;
__device__ __forceinline__ bf16x8 tr16x2(const LAS unsigned char* p0, const LAS unsigned char* p1) {
    const v4i16 a = __builtin_amdgcn_ds_read_tr16_b64_v4i16((LAS v4i16*)p0), b = __builtin_amdgcn_ds_read_tr16_b64_v4i16((LAS v4i16*)p1);
    return __builtin_shufflevector(a, b, 0, 1, 2, 3, 4, 5, 6, 7);
}
#define PIN_Q4(a, b, c, d) asm volatile("" : "+v"(a), "+v"(b), "+v"(c), "+v"(d))
constexpr int DR_TILE = 16384, DR_BUF = 32768, DR_Q = 98304, DR_LUT = 132096, DR_SUBLN = DR_LUT + 4096;
#define VMWAIT(n) asm volatile("s_waitcnt vmcnt(" #n ")" ::: "memory")
__device__ __forceinline__ void vm_wait_n(int n) { if (n <= 0) VMWAIT(0); else if (n <= 4) VMWAIT(4); else VMWAIT(8); }
#define WG_BARRIER() do { asm volatile("" ::: "memory"); __builtin_amdgcn_s_barrier(); asm volatile("" ::: "memory"); } while (0)
__device__ __forceinline__ void dma16(const bf16* gsrc, LAS unsigned char* ldst) {
    unsigned keep; const unsigned dst = (unsigned)__builtin_amdgcn_readfirstlane((int)(unsigned)(uintptr_t)ldst);
    asm volatile("s_mov_b32 %0, m0\n\ts_mov_b32 m0, %2\n\ts_nop 0\n\tglobal_load_lds_dwordx4 %1, off\n\ts_mov_b32 m0, %0" : "=&s"(keep) : "v"(gsrc), "s"(dst) : "memory");
}

__device__ __forceinline__ float hmax16(const f32x4 (&x)[4]) {
    const float a = fmaxf(fmaxf(x[0][0], x[0][1]), x[0][2]), b = fmaxf(fmaxf(x[0][3], x[1][0]), x[1][1]), c = fmaxf(fmaxf(x[1][2], x[1][3]), x[2][0]);
    const float d = fmaxf(fmaxf(x[2][1], x[2][2]), x[2][3]), e = fmaxf(fmaxf(x[3][0], x[3][1]), x[3][2]);
    return fmaxf(fmaxf(fmaxf(a, b), c), fmaxf(fmaxf(d, e), x[3][3]));
}
__device__ __forceinline__ void diff_tile(const LAS unsigned char* Kt, const LAS unsigned char* Vt, int k0, int qw, int l15, int kg, bool first, const bf16x8 (&qf)[2][2],
                                          f32x4 (&O)[2][8], float (&beta)[2], float (&lsum)[2], const LAS float* lut, float c31, const int vl) {
    const int sw = (2 * l15) & 15;
    const int kl = l15 * 256 + 16 * (kg ^ sw);
    const bool nearT = (qw - k0 - 63) < 113;
    f32x4 Sx[2][4];
#pragma unroll
    for (int m = 0; m < 2; ++m) {
        const float i0 = nearT ? -beta[m] : c31 - beta[m];
#pragma unroll
        for (int kb = 0; kb < 4; ++kb) Sx[m][kb] = (f32x4){i0, i0, i0, i0};
    }
#pragma unroll
    for (int m = 0; m < 2; ++m)
#pragma unroll
        for (int ks = 0; ks < 2; ++ks) {
            bf16x8 kf[4];
#pragma unroll
            for (int kb = 0; kb < 4; ++kb) kf[kb] = *(const LAS bf16x8*)(Kt + kb * 4096 + (kl ^ (128 * m + 64 * ks)));
            __builtin_amdgcn_sched_barrier(0);
#pragma unroll
            for (int kb = 0; kb < 4; ++kb) Sx[m][kb] = __builtin_amdgcn_mfma_f32_16x16x32_bf16(kf[kb], qf[m][ks], Sx[m][kb], 0, 0, 0);
        }
#define DIFF_VLOAD(dst, j) do { _Pragma("unroll") for (int e4 = 0; e4 < 4; ++e4) dst[e4] = tr16x2(Vt + (32 * ((j) >> 1)) * 256 + (vl ^ (32 * (4 * ((j) & 1) + e4))), Vt + (32 * ((j) >> 1) + 16) * 256 + (vl ^ (32 * (4 * ((j) & 1) + e4)))); } while (0)
#define DIFF_VMMA(src, j) do { _Pragma("unroll") for (int e4 = 0; e4 < 4; ++e4) _Pragma("unroll") for (int m = 0; m < 2; ++m) \
        O[m][4 * ((j) & 1) + e4] = __builtin_amdgcn_mfma_f32_16x16x32_bf16(src[e4], pf[m][(j) >> 1], O[m][4 * ((j) & 1) + e4], 0, 0, 0); } while (0)
    bf16x8 va[4], vc[4];
    DIFF_VLOAD(va, 0);
    __builtin_amdgcn_sched_barrier(0);
    bf16x8 pf[2][2];
    if (nearT) {
        float bv[4][4];
        const int dq = qw + l15 - k0 - 4 * kg;
#pragma unroll
        for (int kb = 0; kb < 4; ++kb)
#pragma unroll
            for (int r = 0; r < 4; ++r) { int di = dq - 16 * kb - r; di = di < 0 ? 0 : (di > 127 ? 127 : di); bv[kb][r] = lut[di]; }
#pragma unroll
        for (int m = 0; m < 2; ++m)
#pragma unroll
            for (int kb = 0; kb < 4; ++kb)
#pragma unroll
                for (int r = 0; r < 4; ++r) Sx[m][kb][r] = (dq - 16 * kb - r < 0) ? -1.0e30f : Sx[m][kb][r] + bv[kb][r];
    }
#pragma unroll
    for (int m = 0; m < 2; ++m) {
        float mx = hmax16(Sx[m]);
        mx = fmaxf(mx, __shfl_xor(mx, 16)); mx = fmaxf(mx, __shfl_xor(mx, 32));
        if (first || __builtin_amdgcn_ballot_w64(mx > 8.0f) != 0ull) {
            const float dlt = (first || mx > 0.f) ? mx : 0.f, sc = fexp2(-dlt);
            beta[m] += dlt; lsum[m] *= sc;
#pragma unroll
            for (int kb = 0; kb < 4; ++kb) Sx[m][kb] = Sx[m][kb] - dlt;
#pragma unroll
            for (int eb = 0; eb < 8; ++eb) O[m][eb] = O[m][eb] * sc;
        }
#pragma unroll
        for (int kb = 0; kb < 4; ++kb) Sx[m][kb] = (f32x4){fexp2(Sx[m][kb][0]), fexp2(Sx[m][kb][1]), fexp2(Sx[m][kb][2]), fexp2(Sx[m][kb][3])};
        const f32x4 pv4 = (Sx[m][0] + Sx[m][1]) + (Sx[m][2] + Sx[m][3]);
        lsum[m] += (pv4[0] + pv4[1]) + (pv4[2] + pv4[3]);
        pf[m][0] = pack_p(Sx[m][0], Sx[m][1]); pf[m][1] = pack_p(Sx[m][2], Sx[m][3]);
    }
    DIFF_VLOAD(vc, 1);
    __builtin_amdgcn_sched_barrier(0);
    DIFF_VMMA(va, 0);
    DIFF_VLOAD(va, 2);
    __builtin_amdgcn_sched_barrier(0);
    DIFF_VMMA(vc, 1);
    DIFF_VLOAD(vc, 3);
    __builtin_amdgcn_sched_barrier(0);
    DIFF_VMMA(va, 2);
    DIFF_VMMA(vc, 3);
#undef DIFF_VLOAD
#undef DIFF_VMMA
}
__device__ __forceinline__ void diff_attn_phase(Frame& F, const bf16* Sd, const float* lamp, float lam_init, const float* subln, const float* blut, bf16* Yo) {
    int tid_ = TID_NOW(F.wave); asm volatile("" : "+v"(tid_));
    const int tid = tid_, lane = tid & 63, wave = F.wave, l15 = lane & 15, kg = lane >> 4, G = F.G;
    LAS unsigned char* lds = F.lds;
    const float lam = __expf(wave_sum(lamp[lane] * lamp[64 + lane])) - __expf(wave_sum(lamp[128 + lane] * lamp[192 + lane])) + lam_init;
    for (int i = tid; i < 1024; i += NWAVES * 64) ((LAS float*)(lds + DR_LUT))[i] = blut[i] * 1.4426950408889634f;
    if (tid < 128) ((LAS float*)(lds + DR_SUBLN))[tid] = subln[tid] * (1.0f - lam_init);
    VMWAIT(0);
    __syncthreads();
    const int nun = ((int)blockIdx.x < 2048) ? (2048 - (int)blockIdx.x + G - 1) / G : 0;
#define DIFF_UNIT(j, b_, h_, qb_) do { int bh_; if (G == 256) { const int x_ = F.vcu >> 5, i_ = F.vcu & 31, cp_ = ((i_ & 15) + 4 * ((j) >> 1)) & 15; \
            bh_ = 16 * x_ + 2 * (j) + (i_ >> 4); qb_ = ((j) & 1) ? 15 - cp_ : cp_; } \
        else { const int u_ = (int)blockIdx.x + (j) * G; const int hf_ = u_ & 1, jj_ = u_ >> 8; bh_ = (u_ & 255) >> 1; qb_ = hf_ ? (14 - 2 * jj_ + (jj_ & 1)) : (15 - 2 * jj_ - (jj_ & 1)); } \
        b_ = bh_ >> 3; h_ = bh_ & 7; } while (0)
#define DIFF_LO(i) ((4 * (i) + (ln_ >> 4)) * 128 + ((((ln_ & 15) ^ (2 * (ln_ >> 4))) * 8) ^ (64 * ((i) & 1))))
    const int kvrow0 = 16 * (wave & 3), kvblk = 8 + (wave >> 2) * 8;
    LAS unsigned char* const kvdst = lds + (wave >> 2) * DR_TILE + (wave & 3) * 4096;
    LAS unsigned char* const qdst = lds + DR_Q + wave * 4096;
    int iu = 0, it = 0, ib = 0, i_nt = 0, i_b = 0, i_h = 0;
    if (nun > 0) { int qb_; DIFF_UNIT(0, i_b, i_h, qb_); i_nt = 2 * qb_ + 2; }
#define DIFF_ISSUE() do { int ln_ = lane; asm volatile("" : "+v"(ln_)); const bf16* src_ = Sd + ((size_t)(kvblk + i_h) * M + (size_t)i_b * SEQ + 64 * it + kvrow0) * 128; \
        _Pragma("unroll") for (int i = 0; i < 4; ++i) dma16(src_ + DIFF_LO(i), kvdst + ib * DR_BUF + i * 1024); \
        ib = (ib == 2) ? 0 : ib + 1; if (++it == i_nt) { it = 0; ++iu; if (iu < nun) { int qb_; DIFF_UNIT(iu, i_b, i_h, qb_); i_nt = 2 * qb_ + 2; } } } while (0)
#define DIFF_ISSUE_Q(b_, h_, Q0_) do { int ln_ = lane; asm volatile("" : "+v"(ln_)); const bf16* src_ = Sd + ((size_t)(h_) * M + (size_t)(b_) * SEQ + (Q0_) + 16 * wave) * 128; \
        _Pragma("unroll") for (int i = 0; i < 4; ++i) dma16(src_ + DIFF_LO(i), qdst + i * 1024); } while (0)
    if (nun > 0) {
        DIFF_ISSUE(); DIFF_ISSUE();
        { int b_, h_, qb_; DIFF_UNIT(0, b_, h_, qb_); DIFF_ISSUE_Q(b_, h_, qb_ * 128); }
    }
    int cb = 0;
    for (int ju = 0; ju < nun; ++ju) {
        int b, h, qb; DIFF_UNIT(ju, b, h, qb);
        const int Q0 = qb * 128, nt = 2 * qb + 2, qw = Q0 + 16 * wave;
        const LAS float* lut = (const LAS float*)(lds + DR_LUT) + h * 128;
        const float c31 = lut[127];
        bf16x8 qf[2][2];
        f32x4 O[2][8]; float mrun[2], lsum[2];
#pragma unroll
        for (int m = 0; m < 2; ++m) { mrun[m] = 0.f; lsum[m] = 0.f;
#pragma unroll
            for (int eb = 0; eb < 8; ++eb) O[m][eb] = (f32x4){0.f, 0.f, 0.f, 0.f}; }
        for (int t = 0; t < nt; ++t) {
            int ln2 = lane; asm volatile("" : "+v"(ln2));
            const int l15 = ln2 & 15, kg = ln2 >> 4;
            const int ql = (16 * wave + l15) * 256 + 16 * (kg ^ ((2 * l15) & 15));
            const int vl = (4 * kg + (l15 >> 2)) * 256 + 8 * (l15 & 3) + 16 * ((2 * (4 * kg + (l15 >> 2))) & 15);
            const bool has_next = !(ju == nun - 1 && t == nt - 1);
            if (t == 0) VMWAIT(0);
            else vm_wait_n((has_next ? 4 : 0) + (((t == 2 || t == 3) && ju + 1 < nun) ? 4 : 0));
            WG_BARRIER();
            if (iu < nun) DIFF_ISSUE();
            if (t == 1 && ju + 1 < nun) { int b_, h_, qb_; DIFF_UNIT(ju + 1, b_, h_, qb_); DIFF_ISSUE_Q(b_, h_, qb_ * 128); }
            if (t == 0) {
#pragma unroll
                for (int m = 0; m < 2; ++m)
#pragma unroll
                    for (int ks = 0; ks < 2; ++ks) qf[m][ks] = *(const LAS bf16x8*)(lds + DR_Q + (ql ^ (128 * m + 64 * ks)));
            }
            if (64 * t <= qw + 15) diff_tile(lds + cb * DR_BUF, lds + cb * DR_BUF + DR_TILE, 64 * t, qw, l15, kg, t == 0, qf, O, mrun, lsum, lut, c31, vl);
            cb = (cb == 2) ? 0 : cb + 1;
        }
        float inv[2];
#pragma unroll
        for (int m = 0; m < 2; ++m) { float l = lsum[m]; l += __shfl_xor(l, 16); l += __shfl_xor(l, 32); inv[m] = 1.0f / l; }
        const float i0 = inv[0], i1 = inv[1] * lam;
        float ss = 0.f;
#pragma unroll
        for (int eb = 0; eb < 8; ++eb) { const f32x4 a = O[0][eb] * i0 - O[1][eb] * i1; O[0][eb] = a; ss += (a[0] * a[0] + a[1] * a[1]) + (a[2] * a[2] + a[3] * a[3]); }
        ss += __shfl_xor(ss, 16); ss += __shfl_xor(ss, 32);
        const float rs = 1.0f / sqrtf(ss * (1.0f / 128.0f) + 1e-5f);
        bf16* orow = Yo + ((size_t)b * SEQ + qw + l15) * YW + 1024 + h * 128 + 4 * kg;
        const LAS float* sg = (const LAS float*)(lds + DR_SUBLN) + 4 * kg;
#pragma unroll
        for (int eb = 0; eb < 8; ++eb) { const f32x4 gq = *(const LAS f32x4*)(sg + 16 * eb); const f32x4 a = O[0][eb] * rs * gq;
            u32x2 w; w.x = cvtpk(a[0], a[1]); w.y = cvtpk(a[2], a[3]); *(u32x2*)(orow + 16 * eb) = w; }
    }
#undef DIFF_UNIT
#undef DIFF_ISSUE
#undef DIFF_ISSUE_Q
#undef DIFF_LO
    VMWAIT(0);
    __syncthreads();
}

__device__ __forceinline__ void dil_tile(const LAS unsigned char* Kt, const LAS unsigned char* Vt, int m0, int l15, int kg, bool first, const bf16x8 (&qf)[4],
                                         f32x4 (&O)[8], float& beta, float& lsum, const LAS float* lutm, const int (&voff)[8]) {
    const int sw = (2 * l15) & 15;
    const int kl = l15 * 256 + 16 * (kg ^ sw);
    f32x4 Sx[4];
    const float i0 = -beta;
#pragma unroll
    for (int kb = 0; kb < 4; ++kb) Sx[kb] = (f32x4){i0, i0, i0, i0};
#pragma unroll
    for (int h2 = 0; h2 < 2; ++h2) {
        bf16x8 kf[2][4];
#pragma unroll
        for (int ks = 0; ks < 2; ++ks)
#pragma unroll
            for (int kb = 0; kb < 4; ++kb) kf[ks][kb] = *(const LAS bf16x8*)(Kt + kb * 4096 + (kl ^ (64 * (2 * h2 + ks))));
        __builtin_amdgcn_sched_barrier(0);
#pragma unroll
        for (int ks = 0; ks < 2; ++ks)
#pragma unroll
            for (int kb = 0; kb < 4; ++kb) Sx[kb] = __builtin_amdgcn_mfma_f32_16x16x32_bf16(kf[ks][kb], qf[2 * h2 + ks], Sx[kb], 0, 0, 0);
    }
#define DIL_VLOAD(dst, j) do { _Pragma("unroll") for (int e4 = 0; e4 < 4; ++e4) dst[e4] = tr16x2(Vt + (32 * ((j) >> 1)) * 256 + voff[4 * ((j) & 1) + e4], Vt + (32 * ((j) >> 1) + 16) * 256 + voff[4 * ((j) & 1) + e4]); } while (0)
#define DIL_VMMA(src, j) do { _Pragma("unroll") for (int e4 = 0; e4 < 4; ++e4) O[4 * ((j) & 1) + e4] = __builtin_amdgcn_mfma_f32_16x16x32_bf16(src[e4], pf[(j) >> 1], O[4 * ((j) & 1) + e4], 0, 0, 0); } while (0)
    bf16x8 va[4], vc[4];
    DIL_VLOAD(va, 0);
    __builtin_amdgcn_sched_barrier(0);
    {
        const LAS float* lp = lutm + (m0 + 64);
#pragma unroll
        for (int kb = 0; kb < 4; ++kb) { const f32x4 bv = (f32x4){lp[-16 * kb], lp[-16 * kb - 1], lp[-16 * kb - 2], lp[-16 * kb - 3]}; Sx[kb] = Sx[kb] + bv; }
    }
    float mx = hmax16(Sx);
    mx = fmaxf(mx, __shfl_xor(mx, 16)); mx = fmaxf(mx, __shfl_xor(mx, 32));
    if (first || __builtin_amdgcn_ballot_w64(mx > 8.0f) != 0ull) {
        const float dlt = (first || mx > 0.f) ? mx : 0.f, sc = fexp2(-dlt);
        beta += dlt; lsum *= sc;
#pragma unroll
        for (int kb = 0; kb < 4; ++kb) Sx[kb] = Sx[kb] - dlt;
#pragma unroll
        for (int eb = 0; eb < 8; ++eb) O[eb] = O[eb] * sc;
    }
#pragma unroll
    for (int kb = 0; kb < 4; ++kb) Sx[kb] = (f32x4){fexp2(Sx[kb][0]), fexp2(Sx[kb][1]), fexp2(Sx[kb][2]), fexp2(Sx[kb][3])};
    const f32x4 pv4 = (Sx[0] + Sx[1]) + (Sx[2] + Sx[3]);
    lsum += (pv4[0] + pv4[1]) + (pv4[2] + pv4[3]);
    bf16x8 pf[2];
    pf[0] = pack_p(Sx[0], Sx[1]); pf[1] = pack_p(Sx[2], Sx[3]);
    DIL_VLOAD(vc, 1);
    __builtin_amdgcn_sched_barrier(0);
    DIL_VMMA(va, 0);
    DIL_VLOAD(va, 2);
    __builtin_amdgcn_sched_barrier(0);
    DIL_VMMA(vc, 1);
    DIL_VLOAD(vc, 3);
    __builtin_amdgcn_sched_barrier(0);
    DIL_VMMA(va, 2);
    DIL_VMMA(vc, 3);
#undef DIL_VLOAD
#undef DIL_VMMA
}
__device__ __forceinline__ void dil_attn_phase(Frame& F, const bf16* Sl, int g, const float* blut, float* Lse, bf16* Yo) {
    int tid_ = TID_NOW(F.wave); asm volatile("" : "+v"(tid_));
    const int tid = tid_, lane = tid & 63, wave = F.wave, l15 = lane & 15, kg = lane >> 4, G = F.G;
    const int dl = (g == 0) ? 1 : (g == 1 ? 4 : 16);
    LAS unsigned char* lds = F.lds;
    for (int i = tid; i < 1024; i += NWAVES * 64) {
        const int hh = i >> 8, m = (i & 255) - 64; int di = m * dl; di = di < 0 ? 0 : (di > 127 ? 127 : di);
        ((LAS float*)(lds + DR_LUT))[i] = (m >= 0 && m <= 128) ? blut[(8 + g * 4 + hh) * 128 + di] * 1.4426950408889634f : -1.0e30f;
    }
    VMWAIT(0);
    __syncthreads();
    const int nun = ((int)blockIdx.x < 1024) ? (1024 - (int)blockIdx.x + G - 1) / G : 0;
#define DIL_UNIT(j, b_, h_, r_, nbi_) do { const int u_ = (int)blockIdx.x + (j) * G; const int bh_ = u_ & 63, idx_ = u_ >> 6; b_ = bh_ >> 2; h_ = bh_ & 3; r_ = idx_ % dl; nbi_ = idx_ / dl; } while (0)
    int lo[4];
#pragma unroll
    for (int i = 0; i < 4; ++i) { const int ri = 4 * i + (lane >> 4); lo[i] = ri * dl * 128 + ((lane & 15) ^ ((2 * ri) & 15)) * 8; }
    const int kvrow0 = 16 * (wave & 3), kvblk = 4 + (wave >> 2) * 4;
    LAS unsigned char* const kvdst = lds + (wave >> 2) * DR_TILE + (wave & 3) * 4096;
    LAS unsigned char* const qdst = lds + DR_Q + wave * 4096;
    int iu = 0, it = 0, ib = 0, i_nt = 0, i_t0 = 0, i_b = 0, i_h = 0, i_r = 0, i_nbi = 0;
    if (nun > 0) { DIL_UNIT(0, i_b, i_h, i_r, i_nbi); i_t0 = (i_nbi == 0) ? 2 : 0; i_nt = 4 - i_t0; }
#define DIL_ISSUE() do { const bf16* src_ = Sl + ((size_t)(kvblk + i_h) * M + (size_t)i_b * SEQ + (size_t)(((i_nbi - 1) * 128 + 64 * (i_t0 + it) + kvrow0) * dl + i_r)) * 128; \
        _Pragma("unroll") for (int i = 0; i < 4; ++i) dma16(src_ + lo[i], kvdst + ib * DR_BUF + i * 1024); \
        ib = (ib == 2) ? 0 : ib + 1; if (++it == i_nt) { it = 0; ++iu; if (iu < nun) { DIL_UNIT(iu, i_b, i_h, i_r, i_nbi); i_t0 = (i_nbi == 0) ? 2 : 0; i_nt = 4 - i_t0; } } } while (0)
#define DIL_ISSUE_Q(b_, h_, r_, nbi_) do { const bf16* src_ = Sl + ((size_t)(h_) * M + (size_t)(b_) * SEQ + (size_t)(((nbi_) * 128 + 16 * wave) * dl + (r_))) * 128; \
        _Pragma("unroll") for (int i = 0; i < 4; ++i) dma16(src_ + lo[i], qdst + i * 1024); } while (0)
    if (nun > 0) {
        DIL_ISSUE(); DIL_ISSUE();
        { int b_, h_, r_, n_; DIL_UNIT(0, b_, h_, r_, n_); DIL_ISSUE_Q(b_, h_, r_, n_); }
    }
    int cb = 0;
    const int sw = (2 * l15) & 15;
    const int ql = (16 * wave + l15) * 256 + 16 * (kg ^ sw);
    int voff[8];
    { const int vq = 4 * kg + (l15 >> 2); const int vl = vq * 256 + 8 * (l15 & 3) + 16 * ((2 * vq) & 15);
#pragma unroll
      for (int eb = 0; eb < 8; ++eb) voff[eb] = vl ^ (32 * eb); }
    const int tlo = wave >> 2, thi = tlo + 2, qi = 16 * wave + l15;
    for (int ju = 0; ju < nun; ++ju) {
        int b, h, r, nbi; DIL_UNIT(ju, b, h, r, nbi);
        const int t0 = (nbi == 0) ? 2 : 0, nt = 4 - t0, tfirst = tlo > t0 ? tlo : t0;
        const LAS float* lutm = (const LAS float*)(lds + DR_LUT) + h * 256;
        const int qpos = (nbi * 128 + qi) * dl + r;
        const size_t row = (size_t)b * SEQ + qpos;
        bf16* orow = Yo + row * YW + 2048 + h * 128 + 4 * kg;
        bf16x8 qf[4];
        f32x4 O[8]; float beta = 0.f, lsum = 0.f;
#pragma unroll
        for (int eb = 0; eb < 8; ++eb) O[eb] = (f32x4){0.f, 0.f, 0.f, 0.f};
        u32x2 pv[8]; float lp = 0.f;
        for (int t = 0; t < nt; ++t) {
            const int tt = t0 + t;
            const bool has_next = !(ju == nun - 1 && t == nt - 1);
            if (t == 0) VMWAIT(0);
            else vm_wait_n((has_next ? 4 : 0) + (((t == 2 || t == 3) && ju + 1 < nun) ? 4 : 0));
            WG_BARRIER();
            if (iu < nun) DIL_ISSUE();
            if (t == 1 && ju + 1 < nun) { int b_, h_, r_, n_; DIL_UNIT(ju + 1, b_, h_, r_, n_); DIL_ISSUE_Q(b_, h_, r_, n_); }
            if (t == 0) {
#pragma unroll
                for (int ks = 0; ks < 4; ++ks) qf[ks] = *(const LAS bf16x8*)(lds + DR_Q + (ql ^ (64 * ks)));
            }
            if (t == nt - 1 && g > 0) {
#pragma unroll
                for (int eb = 0; eb < 8; ++eb) pv[eb] = *(const u32x2*)(orow + 16 * eb);
                lp = Lse[row * 4 + h];
            }
            if (tt >= tlo && tt <= thi) dil_tile(lds + cb * DR_BUF, lds + cb * DR_BUF + DR_TILE, qi + 128 - 64 * tt - 4 * kg, l15, kg, tt == tfirst, qf, O, beta, lsum, lutm, voff);
            cb = (cb == 2) ? 0 : cb + 1;
        }
        float l = lsum; l += __shfl_xor(l, 16); l += __shfl_xor(l, 32);
        float inv = 1.0f / l, lse = beta + log2f(l);
        float wa = inv, wb = 0.f;
        if (g > 0) {
            const float mm = fmaxf(lse, lp), ea = fexp2(lse - mm), eb_ = fexp2(lp - mm), tot = ea + eb_;
            wa = inv * ea / tot; wb = eb_ / tot; lse = mm + log2f(tot);
        }
#pragma unroll
        for (int eb = 0; eb < 8; ++eb) {
            f32x4 a = O[eb] * wa;
            if (g > 0) { a[0] += wb * bflo(pv[eb].x); a[1] += wb * bfhi(pv[eb].x); a[2] += wb * bflo(pv[eb].y); a[3] += wb * bfhi(pv[eb].y); }
            u32x2 w; w.x = cvtpk(a[0], a[1]); w.y = cvtpk(a[2], a[3]); *(u32x2*)(orow + 16 * eb) = w;
        }
        if (g < 2 && kg == 0) Lse[row * 4 + h] = lse;
    }
#undef DIL_UNIT
#undef DIL_ISSUE
#undef DIL_ISSUE_Q
    VMWAIT(0);
    __syncthreads();
}

constexpr int RS_VP = 160, RS_KT = 64 * AT_PITCH, RS_BUF = RS_KT + 64 * RS_VP;
constexpr size_t WS_ST = WS_S + 192 * MiB;
__device__ __forceinline__ void ret_state_phase(Frame& F, const bf16* R, bf16* ST) {
    constexpr int SB = 24576, SKT = 16384;
    int tid_ = TID_NOW(F.wave); asm volatile("" : "+v"(tid_));
    const int tid = tid_, lane = tid & 63, wave = F.wave, l15 = lane & 15, kg = lane >> 4;
    LAS unsigned char* lds = F.lds;
    __syncthreads();
    for (int u = F.vcu; u < 256; u += F.G) {
        const int bh = u >> 2, es = u & 3, b = bh >> 2, h = bh & 3;
        const float l2g = log2f(1.0f - exp2f(-5.0f - (float)h));
        const float g256 = fexp2(256.0f * l2g);
        float cw[2][8];
#pragma unroll
        for (int c = 0; c < 2; ++c)
#pragma unroll
            for (int j = 0; j < 8; ++j) cw[c][j] = fexp2((float)(63 - (32 * c + 16 * (j >> 2) + 4 * kg + (j & 3))) * l2g);
        const bf16* kblk = R + ((size_t)(4 + h) * M + (size_t)b * SEQ) * 128;
        const bf16* vblk = R + ((size_t)(8 + 2 * h + (es >> 1)) * M + (size_t)b * SEQ) * 128 + (es & 1) * 64;
        const bf16* ksrc0 = kblk + (size_t)(8 * wave + (lane >> 4)) * 128 + (((lane & 15) ^ (2 * (lane >> 4))) * 8);
        const bf16* ksrc1 = kblk + (size_t)(8 * wave + 4 + (lane >> 4)) * 128 + ((((lane & 15) ^ (2 * (lane >> 4))) * 8) ^ 64);
        const bf16* vsrc = vblk + (size_t)(8 * wave + (lane >> 3)) * 128 + (((lane & 7) ^ ((lane >> 3) & 6)) * 8);
        LAS unsigned char* const kd = lds + wave * 2048;
        LAS unsigned char* const vd = lds + SKT + wave * 1024;
#define RS_ISSUE(t_) do { const size_t ro_ = (size_t)(64 * (t_)) * 128; LAS unsigned char* bo_ = (LAS unsigned char*)0 + ((t_) & 3) * SB; \
        dma16(ksrc0 + ro_, kd + ((t_) & 3) * SB); dma16(ksrc1 + ro_, kd + ((t_) & 3) * SB + 1024); dma16(vsrc + ro_, vd + ((t_) & 3) * SB); (void)bo_; } while (0)
        RS_ISSUE(0); RS_ISSUE(1); RS_ISSUE(2);
        f32x4 acc[4];
#pragma unroll
        for (int eb = 0; eb < 4; ++eb) acc[eb] = (f32x4){0.f, 0.f, 0.f, 0.f};
        const int rl = 4 * kg + (l15 >> 2), pp = l15 & 3;
        const int kls = (rl * 256 + 8 * pp + 16 * ((2 * rl) & 15)) ^ (32 * wave);
        const int vls = rl * 128 + 8 * pp + 16 * (rl & 6);
        for (int t = 0; t < 28; ++t) {
            if (t < 26) VMWAIT(6); else if (t == 26) VMWAIT(3); else VMWAIT(0);
            WG_BARRIER();
            if (t + 3 < 28) RS_ISSUE(t + 3);
            const LAS unsigned char* Kt = lds + (t & 3) * SB;
            const LAS unsigned char* Vt = Kt + SKT;
            const float tf = fexp2((float)(192 - 64 * (t & 3)) * l2g);
            bf16x8 kf[2], vf[2][4];
#pragma unroll
            for (int c = 0; c < 2; ++c) {
                kf[c] = tr16x2(Kt + (32 * c) * 256 + kls, Kt + (32 * c + 16) * 256 + kls);
#pragma unroll
                for (int eb = 0; eb < 4; ++eb) vf[c][eb] = tr16x2(Vt + (32 * c) * 128 + (vls ^ (32 * eb)), Vt + (32 * c + 16) * 128 + (vls ^ (32 * eb)));
            }
#pragma unroll
            for (int c = 0; c < 2; ++c) {
                const u32x4 w = __builtin_bit_cast(u32x4, kf[c]);
                u32x4 o;
                o.x = cvtpk(bflo(w.x) * (cw[c][0] * tf), bfhi(w.x) * (cw[c][1] * tf)); o.y = cvtpk(bflo(w.y) * (cw[c][2] * tf), bfhi(w.y) * (cw[c][3] * tf));
                o.z = cvtpk(bflo(w.z) * (cw[c][4] * tf), bfhi(w.z) * (cw[c][5] * tf)); o.w = cvtpk(bflo(w.w) * (cw[c][6] * tf), bfhi(w.w) * (cw[c][7] * tf));
                kf[c] = __builtin_bit_cast(bf16x8, o);
            }
#pragma unroll
            for (int c = 0; c < 2; ++c)
#pragma unroll
                for (int eb = 0; eb < 4; ++eb) acc[eb] = __builtin_amdgcn_mfma_f32_16x16x32_bf16(vf[c][eb], kf[c], acc[eb], 0, 0, 0);
            if ((t & 3) == 3) {
                bf16* st = ST + ((size_t)(bh * 7 + (t >> 2)) * 128 + 16 * wave + l15) * 256 + es * 64 + 4 * kg;
#pragma unroll
                for (int eb = 0; eb < 4; ++eb) { u32x2 w; w.x = cvtpk(acc[eb][0], acc[eb][1]); w.y = cvtpk(acc[eb][2], acc[eb][3]); *(u32x2*)(st + 16 * eb) = w; acc[eb] = acc[eb] * g256; }
            }
        }
        VMWAIT(0);
        WG_BARRIER();
#undef RS_ISSUE
    }
    __syncthreads();
}
constexpr int RC_KT = 16384, RC_BUF = 49152, RC_GAIN = DR_LUT;
__device__ __forceinline__ void ret_phase(Frame& F, const bf16* R, const bf16* ST, const float* gn_gain, bf16* Yo) {
    int tid_ = TID_NOW(F.wave); asm volatile("" : "+v"(tid_));
    const int tid = tid_, lane = tid & 63, wave = F.wave, l15 = lane & 15, kg = lane >> 4, G = F.G;
    LAS unsigned char* lds = F.lds;
    for (int i = tid; i < 1024; i += NWAVES * 64) ((LAS float*)(lds + RC_GAIN))[i] = gn_gain[i];
    VMWAIT(0);
    __syncthreads();
    const int nun = ((int)blockIdx.x < 1024) ? (1024 - (int)blockIdx.x + G - 1) / G : 0;
#define RC_UNIT(j, b_, h_, qb_) do { const int u_ = (int)blockIdx.x + (j) * G; const int bh_ = (u_ & 255) >> 2, qt_ = u_ & 3, jj_ = u_ >> 8; qb_ = 4 * jj_ + ((qt_ + jj_) & 3); b_ = bh_ >> 2; h_ = bh_ & 3; } while (0)
#define RC_LOK(i) ((4 * (i) + (ln_ >> 4)) * 128 + ((((ln_ & 15) ^ (2 * (ln_ >> 4))) * 8) ^ (64 * ((i) & 1))))
#define RC_LOV(i, pitch) ((2 * (i) + (ln_ >> 5)) * (pitch) + ((((ln_ & 31) ^ (2 * (ln_ >> 5))) * 8) ^ (32 * (i))))
    LAS unsigned char* const kdst = lds + wave * 2048;
    LAS unsigned char* const vdst = lds + RC_KT + wave * 4096;
    LAS unsigned char* const qdst = lds + DR_Q + wave * 4096;
    int iu = 0, it = 0, ib = 0, i_n = 0, i_ns = 0, i_t0 = 0, i_b = 0, i_h = 0, i_sc = 0;
#define RC_SETUP(j) do { int qb_; RC_UNIT(j, i_b, i_h, qb_); i_sc = qb_ >> 1; i_ns = (i_sc > 0) ? 2 : 0; i_t0 = 4 * i_sc; i_n = i_ns + 2 * qb_ + 2 - i_t0; } while (0)
    if (nun > 0) RC_SETUP(0);
#define RC_ISSUE() do { int ln_ = lane; asm volatile("" : "+v"(ln_)); LAS unsigned char* kd_ = kdst + ib * RC_BUF; LAS unsigned char* vd_ = vdst + ib * RC_BUF; \
        if (it < i_ns) { const bf16* src_ = ST + ((size_t)((i_b * 4 + i_h) * 7 + i_sc - 1) * 128 + 64 * it + 8 * wave) * 256; \
            _Pragma("unroll") for (int i = 0; i < 4; ++i) dma16(src_ + RC_LOV(i, 256), vd_ + i * 1024); } \
        else { const size_t ro_ = ((size_t)i_b * SEQ + 64 * (i_t0 + it - i_ns) + 8 * wave) * 128; \
            _Pragma("unroll") for (int i = 0; i < 2; ++i) dma16(R + (size_t)(4 + i_h) * M * 128 + ro_ + RC_LOK(i), kd_ + i * 1024); \
              \
            _Pragma("unroll") for (int i = 0; i < 4; ++i) { const int ch_ = (ln_ & 31) ^ ((2 * (ln_ >> 5)) ^ (4 * i)); \
                dma16(R + (size_t)(8 + 2 * i_h + (ch_ >> 4)) * M * 128 + ro_ + (size_t)(2 * i + (ln_ >> 5)) * 128 + (ch_ & 15) * 8, vd_ + i * 1024); } } \
        ib ^= 1; if (++it == i_n) { it = 0; ++iu; if (iu < nun) RC_SETUP(iu); } } while (0)
#define RC_ISSUE_Q(b_, h_, Q0_) do { int ln_ = lane; asm volatile("" : "+v"(ln_)); const bf16* src_ = R + ((size_t)(h_) * M + (size_t)(b_) * SEQ + (Q0_) + 16 * wave) * 128; \
        _Pragma("unroll") for (int i = 0; i < 4; ++i) dma16(src_ + RC_LOK(i), qdst + i * 1024); } while (0)
    if (nun > 0) { RC_ISSUE(); { int b_, h_, qb_; RC_UNIT(0, b_, h_, qb_); RC_ISSUE_Q(b_, h_, qb_ * 128); } }
    int cb = 0;
#define RC_VLOAD(dst, Vt_, c_, q_) do { _Pragma("unroll") for (int e4 = 0; e4 < 4; ++e4) dst[e4] = tr16x2((Vt_) + (32 * (c_)) * 512 + (vl ^ (32 * (4 * (q_) + e4))), (Vt_) + (32 * (c_) + 16) * 512 + (vl ^ (32 * (4 * (q_) + e4)))); } while (0)
#define RC_VMMA(src, pb_, q_) do { _Pragma("unroll") for (int e4 = 0; e4 < 4; ++e4) O[4 * (q_) + e4] = __builtin_amdgcn_mfma_f32_16x16x32_bf16(src[e4], (pb_), O[4 * (q_) + e4], 0, 0, 0); } while (0)
#define RC_PV(Vt_, p0_, p1_) do { bf16x8 va[4], vc[4]; \
        RC_VLOAD(va, Vt_, 0, 0); RC_VLOAD(vc, Vt_, 0, 1); __builtin_amdgcn_sched_barrier(0); \
        RC_VMMA(va, p0_, 0); RC_VLOAD(va, Vt_, 0, 2); __builtin_amdgcn_sched_barrier(0); \
        RC_VMMA(vc, p0_, 1); RC_VLOAD(vc, Vt_, 0, 3); __builtin_amdgcn_sched_barrier(0); \
        RC_VMMA(va, p0_, 2); RC_VLOAD(va, Vt_, 1, 0); __builtin_amdgcn_sched_barrier(0); \
        RC_VMMA(vc, p0_, 3); RC_VLOAD(vc, Vt_, 1, 1); __builtin_amdgcn_sched_barrier(0); \
        RC_VMMA(va, p1_, 0); RC_VLOAD(va, Vt_, 1, 2); __builtin_amdgcn_sched_barrier(0); \
        RC_VMMA(vc, p1_, 1); RC_VLOAD(vc, Vt_, 1, 3); __builtin_amdgcn_sched_barrier(0); \
        RC_VMMA(va, p1_, 2); RC_VMMA(vc, p1_, 3); } while (0)
    for (int ju = 0; ju < nun; ++ju) {
        int b, h, qb; RC_UNIT(ju, b, h, qb);
        const int Q0 = qb * 128, scx = qb >> 1, ns = (scx > 0) ? 2 : 0, t0 = 4 * scx, n = ns + 2 * qb + 2 - t0;
        const int qw = Q0 + 16 * wave, tq = qw + l15;
        const float l2g = log2f(1.0f - exp2f(-5.0f - (float)h));
        const float lbase = fexp2((float)(63 - 4 * kg) * l2g);
        const float fr1 = __builtin_bit_cast(float, __builtin_amdgcn_readfirstlane(__builtin_bit_cast(int, fexp2(-l2g))));
        const float fr2 = __builtin_bit_cast(float, __builtin_amdgcn_readfirstlane(__builtin_bit_cast(int, fexp2(-2.0f * l2g))));
        const float fr3 = __builtin_bit_cast(float, __builtin_amdgcn_readfirstlane(__builtin_bit_cast(int, fexp2(-3.0f * l2g))));
        float fk[4];
#pragma unroll
        for (int kb = 0; kb < 4; ++kb) fk[kb] = __builtin_bit_cast(float, __builtin_amdgcn_readfirstlane(__builtin_bit_cast(int, fexp2(-16.0f * (float)kb * l2g))));
        const size_t row = (size_t)b * SEQ + tq;
        const bf16* grow = R + ((size_t)(16 + 2 * h) * M + row) * 128 + 4 * kg;
        bf16x8 qf[4];
        f32x4 O[16];
#pragma unroll
        for (int eb = 0; eb < 16; ++eb) O[eb] = (f32x4){0.f, 0.f, 0.f, 0.f};
        for (int it2 = 0; it2 < n; ++it2) {
            int ln2 = lane; asm volatile("" : "+v"(ln2));
            const int l15 = ln2 & 15, kg = ln2 >> 4, sw = (2 * l15) & 15;
            const int ql = (16 * wave + l15) * 256 + 16 * (kg ^ sw), kl = l15 * 256 + 16 * (kg ^ sw);
            const int vl = (4 * kg + (l15 >> 2)) * 512 + 8 * (l15 & 3) + 16 * ((2 * (4 * kg + (l15 >> 2))) & 15);
            VMWAIT(0);
            WG_BARRIER();
            if (iu < nun) RC_ISSUE();

            if (it2 == 0) {
#pragma unroll
                for (int ks = 0; ks < 4; ++ks) qf[ks] = *(const LAS bf16x8*)(lds + DR_Q + (ql ^ (64 * ks)));
            }
            const LAS unsigned char* Kt = lds + cb * RC_BUF;
            const LAS unsigned char* Vt = Kt + RC_KT;
            if (it2 < ns) {
                const float fq = fexp2((float)(tq - 256 * scx + 1) * l2g);
                bf16x8 pq[2];
#pragma unroll
                for (int c = 0; c < 2; ++c) {
                    const int ch = 8 * it2 + 4 * c + (kg >> 1);
                    const LAS unsigned char* qb_ = lds + DR_Q + (16 * wave + l15) * 256 + 8 * (kg & 1);
                    const u32x2 x0 = *(const LAS u32x2*)(qb_ + 16 * (ch ^ sw)), x1 = *(const LAS u32x2*)(qb_ + 16 * ((ch + 2) ^ sw));
                    u32x4 w; w.x = cvtpk(bflo(x0.x) * fq, bfhi(x0.x) * fq); w.y = cvtpk(bflo(x0.y) * fq, bfhi(x0.y) * fq);
                    w.z = cvtpk(bflo(x1.x) * fq, bfhi(x1.x) * fq); w.w = cvtpk(bflo(x1.y) * fq, bfhi(x1.y) * fq);
                    pq[c] = __builtin_bit_cast(bf16x8, w);
                }
                RC_PV(Vt, pq[0], pq[1]);
            } else {
                const int k0 = 64 * (t0 + it2 - ns);
                if (k0 <= qw + 15) {
                    f32x4 Sx[4];
#pragma unroll
                    for (int kb = 0; kb < 4; ++kb) Sx[kb] = (f32x4){0.f, 0.f, 0.f, 0.f};
#pragma unroll
                    for (int ks = 0; ks < 4; ++ks) {
                        bf16x8 kf[4];
#pragma unroll
                        for (int kb = 0; kb < 4; ++kb) kf[kb] = *(const LAS bf16x8*)(Kt + kb * 4096 + (kl ^ (64 * ks)));
                        __builtin_amdgcn_sched_barrier(0);
#pragma unroll
                        for (int kb = 0; kb < 4; ++kb) Sx[kb] = __builtin_amdgcn_mfma_f32_16x16x32_bf16(kf[kb], qf[ks], Sx[kb], 0, 0, 0);
                    }
                    const float at = fexp2((float)(tq - k0 - 63) * l2g) * lbase;
#pragma unroll
                    for (int kb = 0; kb < 4; ++kb) { const float a = at * fk[kb]; Sx[kb][0] *= a; Sx[kb][1] *= a * fr1; Sx[kb][2] *= a * fr2; Sx[kb][3] *= a * fr3; }
                    if (k0 + 63 > qw) {
                        const int d0 = tq - k0 - 4 * kg;
#pragma unroll
                        for (int kb = 0; kb < 4; ++kb)
#pragma unroll
                            for (int rr = 0; rr < 4; ++rr) Sx[kb][rr] = (d0 - 16 * kb - rr >= 0) ? Sx[kb][rr] : 0.f;
                    }
                    const bf16x8 p0 = pack_p(Sx[0], Sx[1]), p1 = pack_p(Sx[2], Sx[3]);
                    RC_PV(Vt, p0, p1);
                }
            }
            if (it2 == n - 1 && ju + 1 < nun) { int b_, h_, qb_; RC_UNIT(ju + 1, b_, h_, qb_); RC_ISSUE_Q(b_, h_, qb_ * 128); }
            cb ^= 1;
        }
        float sm = 0.f;
#pragma unroll
        for (int eb = 0; eb < 16; ++eb) sm += (O[eb][0] + O[eb][1]) + (O[eb][2] + O[eb][3]);
        sm += __shfl_xor(sm, 16); sm += __shfl_xor(sm, 32);
        const float mean = sm * (1.0f / 256.0f);
        float sq = 0.f;
#pragma unroll
        for (int eb = 0; eb < 16; ++eb) { O[eb] = O[eb] - mean; sq += (O[eb][0] * O[eb][0] + O[eb][1] * O[eb][1]) + (O[eb][2] * O[eb][2] + O[eb][3] * O[eb][3]); }
        sq += __shfl_xor(sq, 16); sq += __shfl_xor(sq, 32);
        const float rstd = 1.0f / sqrtf(sq * (1.0f / 256.0f) + 1e-5f);
        bf16* orow = Yo + row * YW + h * 256 + 4 * kg;
        const LAS float* gg = (const LAS float*)(lds + RC_GAIN) + h * 256 + 4 * kg;
#pragma unroll
        for (int half = 0; half < 2; ++half) {
            u32x2 gv[8];
#pragma unroll
            for (int e8 = 0; e8 < 8; ++e8) gv[e8] = *(const u32x2*)(grow + (size_t)half * M * 128 + 16 * e8);
#pragma unroll
            for (int e8 = 0; e8 < 8; ++e8) {
                const int eb = 8 * half + e8;
                const f32x4 gq = *(const LAS f32x4*)(gg + 16 * eb);
                const float g0 = bflo(gv[e8].x), g1 = bfhi(gv[e8].x), g2 = bflo(gv[e8].y), g3 = bfhi(gv[e8].y);
                const float o0 = O[eb][0] * rstd * gq[0] * (g0 * sigmoidf_(g0)), o1 = O[eb][1] * rstd * gq[1] * (g1 * sigmoidf_(g1));
                const float o2 = O[eb][2] * rstd * gq[2] * (g2 * sigmoidf_(g2)), o3 = O[eb][3] * rstd * gq[3] * (g3 * sigmoidf_(g3));
                u32x2 w; w.x = cvtpk(o0, o1); w.y = cvtpk(o2, o3);
                *(u32x2*)(orow + 16 * eb) = w;
            }
        }
    }
#undef RC_UNIT
#undef RC_SETUP
#undef RC_ISSUE
#undef RC_ISSUE_Q
#undef RC_LOK
#undef RC_LOV
#undef RC_VLOAD
#undef RC_VMMA
#undef RC_PV
    VMWAIT(0);
    __syncthreads();
}

__device__ __forceinline__ void phase_final(Frame& F, const bf16* xb, float* out, const float* gain) {
    int lane = lane_now(); asm volatile("" : "+v"(lane));
    const int gw = F.vcu * NWAVES + F.wave, NGW = F.G * NWAVES;
    for (int m = gw; m < M; m += NGW) {
        const u32x4* xr = (const u32x4*)(xb + (size_t)m * D) + lane;
        f32x4 v[2][2]; float s = 0.f;
#pragma unroll
        for (int j = 0; j < 2; ++j) { const u32x4 w = xr[64 * j]; v[j][0] = (f32x4){bflo(w.x), bfhi(w.x), bflo(w.y), bfhi(w.y)}; v[j][1] = (f32x4){bflo(w.z), bfhi(w.z), bflo(w.w), bfhi(w.w)};
            s += ((v[j][0][0] * v[j][0][0] + v[j][0][1] * v[j][0][1]) + (v[j][0][2] * v[j][0][2] + v[j][0][3] * v[j][0][3])) + ((v[j][1][0] * v[j][1][0] + v[j][1][1] * v[j][1][1]) + (v[j][1][2] * v[j][1][2] + v[j][1][3] * v[j][1][3])); }
        const float rs = 1.0f / sqrtf(wave_sum(s) * (1.0f / D) + 1e-6f);
#pragma unroll
        for (int j = 0; j < 2; ++j) { const f32x4* gq = (const f32x4*)(gain + 8 * lane + 512 * j); f32x4* o = (f32x4*)(out + (size_t)m * D + 8 * lane + 512 * j);
            o[0] = v[j][0] * rs * gq[0]; o[1] = v[j][1] * rs * gq[1]; }
    }
}

constexpr int PH_PER_LAYER = 18;
constexpr int N_PHASES = DEPTH * PH_PER_LAYER + 1;

__global__ void __launch_bounds__(NWAVES * 64, 2) mk_fwd(Args args) {
    extern __shared__ __attribute__((aligned(16))) unsigned char lds[];
    Frame F;
    F.lds = (LAS unsigned char*)lds;
    F.MISC = (volatile LAS unsigned*)(F.lds + MISC_OFF);
    F.wave = __builtin_amdgcn_readfirstlane((int)threadIdx.x >> 6);
    F.G = gridDim.x; { const int bx = blockIdx.x; F.vcu = (F.G % 8 == 0) ? (bx % 8) * (F.G / 8) + bx / 8 : bx; }
    unsigned char* ws = args.ws;
    F.ctl = (gu32*)(ws + WS_CTL);
    for (int u = threadIdx.x; u < (LDS_BYTES - LDSCTL_OFF) / 4; u += NWAVES * 64) ((LAS unsigned*)(F.lds + LDSCTL_OFF))[u] = 0u;
    __syncthreads();
#if MK_PER_PHASE
#define GRID_BAR() do { } while (0)
#else
    XcdBarrier bar = xcd_barrier_post((unsigned*)(F.ctl + CW_BAR), F.MISC + 8, F.wave);
#define GRID_BAR() xcd_barrier(bar)
#endif
    const int lo = args.ph_lo, hi = args.ph_hi;
    int ph = 0;
#define PHASE_BEGIN if (ph >= lo && ph < hi) {
#define PHASE_END   if (ph + 1 < hi) GRID_BAR(); } ++ph;

#define WIN ((bf16*)(ws + WS_WIN))
#define WBR ((bf16*)(ws + WS_WBR))
#define WOUT ((bf16*)(ws + WS_WOUT))
#define WGU ((bf16*)(ws + WS_WGU))
#define WDN ((bf16*)(ws + WS_WDN))
#define XB ((bf16*)(ws + WS_XB))
#define Y ((bf16*)(ws + WS_Y))
#define S ((bf16*)(ws + WS_S))
#define XB2 ((bf16*)(ws + WS_XB2))
#define HID ((bf16*)(ws + WS_HID))
#define RSS ((float*)(ws + WS_RSS))
#define RSTD ((float*)(ws + WS_RSTD))
#define CS ((const float*)(ws + WS_CS))
#define BLUT ((const float*)(ws + WS_BLUT))
#define DILP ((float*)(ws + WS_DILP))
#define DILS ((float*)(ws + WS_DILS))

    for (int l = 0; l < DEPTH; ++l) {
        PHASE_BEGIN if (EN_CONV) phase_convert(F, args, l); PHASE_END

        for (int sub = 0; sub < 6; ++sub) {
            const int coff = (sub == 0) ? C_RET : (sub == 1) ? C_DIFF : (sub <= 4) ? (C_DIL + (sub - 2) * N_DILG) : C_GATE;
            const int nsub = (sub >= 2 && sub <= 4) ? N_DILG : 3072;
            PHASE_BEGIN {
                pg8::Gemm g{XB, WIN + (size_t)coff * D, D, D, M, nsub, D}; pg8::StaticOrder So; So.init(M, nsub, F.G, (int)blockIdx.x);
                pg8::EpiIn E{S, nsub, RSTD, CS, (sub == 0) ? 1 : (sub == 5 ? 2 : ((sub == 1 && DIFF_MFMA) ? 3 : ((sub >= 2 && sub <= 4 && DIL_MFMA) ? 4 : 0)))};
                if (EN_IN) for (int rep = 0; rep < REP_IN; ++rep) pg8::gemm_phase<pg8::EpiIn, pg8::StaticOrder, true>(F.lds + RING_OFF, g, So, E, F.wave);
            } PHASE_END
            if (sub == 0) {
#if RET_MFMA
                PHASE_BEGIN if (EN_RET) ret_state_phase(F, S, (bf16*)(ws + WS_ST)); PHASE_END
                PHASE_BEGIN if (EN_RET) for (int rep = 0; rep < REP_RET; ++rep) ret_phase(F, S, (const bf16*)(ws + WS_ST), args.gn_gain + l * 1024, Y); PHASE_END
#else
                PHASE_BEGIN if (EN_RET) naive_ret(F, S, args.gn_gain + l * 1024, Y); PHASE_END
                PHASE_BEGIN PHASE_END
#endif
            } else if (sub == 1) {
                const float lam_init = __builtin_bit_cast(float, __builtin_amdgcn_readfirstlane(__builtin_bit_cast(int, (l == 0) ? 0.2f : 0.35550906759096934f)));
#if DIFF_MFMA
                PHASE_BEGIN if (EN_DIFF) for (int rep = 0; rep < REP_DIFF; ++rep) diff_attn_phase(F, S, args.diff_lambda + l * 256, lam_init, args.subln + l * 128, BLUT, Y); PHASE_END
#else
                PHASE_BEGIN if (EN_DIFF) naive_diff(F, S, args.diff_lambda + l * 256, lam_init, args.subln + l * 128, BLUT, Y); PHASE_END
#endif
            } else if (sub <= 4) {
#if DIL_MFMA
                PHASE_BEGIN if (EN_DIL) dil_attn_phase(F, S, sub - 2, BLUT, DILS, Y); PHASE_END
#else
                PHASE_BEGIN if (EN_DIL) naive_dil(F, S, sub - 2, BLUT, DILP, DILS, Y); PHASE_END
#endif
            }
        }
        PHASE_BEGIN {
            pg8::Gemm g{Y, WBR, YW, YW, M, D, D}; pg8::SegOrder So; So.init(M, D, F.G, (int)blockIdx.x);
            pg8::EpiMerge E{(bf16*)args.out, S};
            if (EN_MERGE) for (int rep = 0; rep < REP_MERGE; ++rep) pg8::gemm_phase<pg8::EpiMerge, pg8::SegOrder, true>(F.lds + RING_OFF, g, So, E, F.wave);
        } PHASE_END
        PHASE_BEGIN {
            pg8::Gemm g{(const bf16*)args.out, WOUT, D, D, M, D, D}; pg8::StaticOrder So; So.init(M, D, F.G, (int)blockIdx.x);
            pg8::EpiRes E{(l == 0) ? (const void*)args.x : (const void*)XB, XB2, RSS, (l == 0) ? 1 : 0};
            if (EN_OUT) pg8::gemm_phase<pg8::EpiRes, pg8::StaticOrder, true>(F.lds + RING_OFF, g, So, E, F.wave);
        } PHASE_END
        PHASE_BEGIN rstd_reduce(F, RSS, RSTD); PHASE_END
        PHASE_BEGIN {
            pg8::Gemm g{XB2, WGU, D, D, M, 2 * FFN, D}; pg8::StaticOrder So; So.init(M, 2 * FFN, F.G, (int)blockIdx.x);
            pg8::EpiSwiGLU E{HID, RSTD};
            if (EN_UP) for (int rep = 0; rep < REP_UP; ++rep) pg8::gemm_phase<pg8::EpiSwiGLU, pg8::StaticOrder, true>(F.lds + RING_OFF, g, So, E, F.wave);
        } PHASE_END
        PHASE_BEGIN {
            pg8::Gemm g{HID, WDN, FFN, FFN, M, D, FFN}; pg8::StaticOrder So; So.init(M, D, F.G, (int)blockIdx.x);
            pg8::EpiRes E{(const void*)XB2, XB, RSS, 0};
            if (EN_DOWN) pg8::gemm_phase<pg8::EpiRes, pg8::StaticOrder, true>(F.lds + RING_OFF, g, So, E, F.wave);
        } PHASE_END
    }
    PHASE_BEGIN if (EN_FIN) phase_final(F, XB, args.out, args.norm_final); PHASE_END
#undef PHASE_BEGIN
#undef PHASE_END
}

extern "C" void kernel_launch(void* const* d_in, const int* in_sizes, int n_in, void* d_out, int out_size, void* d_ws, size_t ws_size, hipStream_t stream) {
    static int grid = 0;
    if (grid == 0) {
        if (n_in != 16 || in_sizes[0] != M * D || out_size != M * D || ws_size < WS_END) { fprintf(stderr, "kernel_launch: unexpected shapes (n_in %d, ws %zu)\n", n_in, ws_size); grid = -1; return; }
        int dev = 0, cus = 0, per_cu = 0;
        if (hipGetDevice(&dev) != hipSuccess || hipDeviceGetAttribute(&cus, hipDeviceAttributeMultiprocessorCount, dev) != hipSuccess) { grid = -1; return; }
        if (hipFuncSetAttribute((const void*)mk_fwd, hipFuncAttributeMaxDynamicSharedMemorySize, LDS_BYTES) != hipSuccess) { grid = -1; return; }
        if (hipOccupancyMaxActiveBlocksPerMultiprocessor(&per_cu, (const void*)mk_fwd, NWAVES * 64, LDS_BYTES) != hipSuccess || per_cu < 1) { fprintf(stderr, "kernel_launch: occupancy query says %d\n", per_cu); }
        (void)hipGetLastError();
        grid = cus;
    }
    if (grid < 0) return;
    if (hipMemsetAsync((char*)d_ws + WS_CTL, 0, CTL_ZERO_BYTES, stream) != hipSuccess) return;
    Args a{};
    a.x = (const float*)d_in[0]; a.w_in = (const float*)d_in[1]; a.w_br_ret = (const float*)d_in[2]; a.w_br_diff = (const float*)d_in[3]; a.w_br_dil = (const float*)d_in[4];
    a.w_out = (const float*)d_in[5]; a.norm_mix = (const float*)d_in[6]; a.norm_ffn = (const float*)d_in[7]; a.gn_gain = (const float*)d_in[8]; a.diff_lambda = (const float*)d_in[9];
    a.subln = (const float*)d_in[10]; a.rel_bias = (const float*)d_in[11]; a.w_gate = (const float*)d_in[12]; a.w_up = (const float*)d_in[13]; a.w_down = (const float*)d_in[14];
    a.norm_final = (const float*)d_in[15];
    a.out = (float*)d_out; a.ws = (unsigned char*)d_ws;
#if MK_PER_PHASE
    for (int p = 0; p < N_PHASES; ++p) {
        a.ph_lo = p; a.ph_hi = p + 1;
        hipLaunchKernelGGL(mk_fwd, dim3(grid), dim3(NWAVES * 64), LDS_BYTES, stream, a);
    }
#else
    a.ph_lo = 0; a.ph_hi = N_PHASES;
    hipLaunchKernelGGL(mk_fwd, dim3(grid), dim3(NWAVES * 64), LDS_BYTES, stream, a);
#endif
}
```
